# Optimizing an MI355X kernel written in HIP

```python
import math
import jax, jax.numpy as jnp
from jax import lax
import numpy as np

D_MODEL = 2048
BATCH = 2
SEQ = 8192
DEPTH = 2
DEC_BATCH = 8
DEC_SEQ = 2048
PAST_LEN = 128

N_HEADS = 8
N_KV_HEADS = 2
HEAD_DIM = 128
Q_GROUP = N_HEADS // N_KV_HEADS
ATTN_WIDTH = N_HEADS * HEAD_DIM
KV_WIDTH = N_KV_HEADS * HEAD_DIM
WINDOW = 128
BLOCK = 128
N_BUCKETS = 32
MAX_DISTANCE = 128
CONV_WIDTH = D_MODEL // 4
CONV_K = 3
LRU_WIDTH = D_MODEL // 4
LRU_HEADS = 4
LRU_BLOCK = LRU_WIDTH // LRU_HEADS
LRU_CONV_K = 4
LRU_C = 8.0
MIX_WIDTH = ATTN_WIDTH + CONV_WIDTH + LRU_WIDTH
IN_SPLITS = (ATTN_WIDTH, KV_WIDTH, KV_WIDTH, ATTN_WIDTH,
             CONV_WIDTH, CONV_WIDTH, CONV_WIDTH, CONV_WIDTH,
             LRU_WIDTH, LRU_WIDTH)
IN_WIDTH = sum(IN_SPLITS)
PLE_DIM = 256
NORM_EPS = 1e-6
NEG_INF = -1e30

kernel_name = 'hybrid_bidir_parallel_heads_encoder'


def _rmsnorm(x, g):
    x32 = x.astype(jnp.float32)
    y = x32 * lax.rsqrt(jnp.mean(x32 * x32, axis=-1, keepdims=True) + NORM_EPS)
    return (y * g.astype(jnp.float32)).astype(x.dtype)


def _t5_bucket(rel):
    half = N_BUCKETS // 2
    max_exact = half // 2
    ret = jnp.where(rel > 0, half, 0).astype(jnp.int32)
    n = jnp.abs(rel)
    nf = jnp.maximum(n, 1).astype(jnp.float32)
    large = max_exact + (jnp.log(nf / max_exact) / math.log(MAX_DISTANCE / max_exact)
                         * (half - max_exact)).astype(jnp.int32)
    large = jnp.minimum(large, half - 1)
    return ret + jnp.where(n < max_exact, n, large)


def _depthwise_conv(x, w, pad):
    c = x.shape[-1]
    return lax.conv_general_dilated(
        x, w[:, None, :].astype(x.dtype), window_strides=(1,), padding=[pad],
        dimension_numbers=('NWC', 'WIO', 'NWC'), feature_group_count=c)


def _windowed_gqa(q, k, v, rel_table, sink):
    b, s = q.shape[0], q.shape[1]
    nb = s // BLOCK
    qb = q.reshape(b, nb, BLOCK, N_KV_HEADS, Q_GROUP, HEAD_DIM)

    def band(t):
        tp = jnp.pad(t, ((0, 0), (BLOCK, BLOCK), (0, 0)))
        tp = tp.reshape(b, nb + 2, BLOCK, N_KV_HEADS, HEAD_DIM)
        return jnp.concatenate([tp[:, :-2], tp[:, 1:-1], tp[:, 2:]], axis=2)

    kb, vb = band(k), band(v)
    scores = jnp.einsum('bnqkgd,bnckd->bnkgqc', qb, kb).astype(jnp.float32) * (HEAD_DIM ** -0.5)
    q_off = jnp.arange(BLOCK, dtype=jnp.int32)[:, None]
    c_off = jnp.arange(3 * BLOCK, dtype=jnp.int32)[None, :]
    rel = c_off - BLOCK - q_off
    bias = rel_table.astype(jnp.float32)[_t5_bucket(rel)]
    bias = jnp.transpose(bias, (2, 0, 1)).reshape(N_KV_HEADS, Q_GROUP, BLOCK, 3 * BLOCK)
    key_pos = jnp.arange(nb, dtype=jnp.int32)[:, None] * BLOCK - BLOCK + c_off
    valid = (jnp.abs(rel) <= WINDOW)[None] & ((key_pos >= 0) & (key_pos < s))[:, None, :]
    scores = jnp.where(valid[None, :, None, None], scores + bias, NEG_INF)
    sink32 = sink.astype(jnp.float32).reshape(N_KV_HEADS, Q_GROUP, 1, 1)
    m = jnp.maximum(jnp.max(scores, axis=-1, keepdims=True), sink32)
    e = jnp.exp(scores - m)
    den = jnp.sum(e, axis=-1, keepdims=True) + jnp.exp(sink32 - m)
    probs = (e / den).astype(v.dtype)
    out = jnp.einsum('bnkgqc,bnckd->bnqkgd', probs, vb)
    return out.reshape(b, s, ATTN_WIDTH)


def _lin_combine(left, right):
    a_l, b_l = left
    a_r, b_r = right
    return a_l * a_r, a_r * b_l + b_r


def _rglru_direction(x, conv_w, conv_b, w_a, b_a, w_i, b_i, lam, pad, reverse):
    b, s = x.shape[0], x.shape[1]
    xc = _depthwise_conv(x, conv_w, pad) + conv_b.astype(x.dtype)
    xh = xc.reshape(b, s, LRU_HEADS, LRU_BLOCK)
    r = jax.nn.sigmoid(jnp.einsum('bshi,hij->bshj', xh, w_a).reshape(b, s, LRU_WIDTH).astype(jnp.float32)
                       + b_a.astype(jnp.float32))
    i = jax.nn.sigmoid(jnp.einsum('bshi,hij->bshj', xh, w_i).reshape(b, s, LRU_WIDTH).astype(jnp.float32)
                       + b_i.astype(jnp.float32))
    log_a = -LRU_C * r * jax.nn.softplus(-lam.astype(jnp.float32))
    a = jnp.exp(log_a)
    u = jnp.sqrt(-jnp.expm1(2.0 * log_a)) * (i * xc.astype(jnp.float32))
    _, hs = lax.associative_scan(_lin_combine, (a, u), reverse=reverse, axis=1)
    return hs


def _layer(h, p, norm_g, w_in, w_out, rel_table, sink, conv_w, lru_conv_w, lru_conv_b,
           lru_w_a, lru_b_a, lru_w_i, lru_b_i, lru_L, ple_norm, ple_w_gate, ple_w_proj):
    u = _rmsnorm(h, norm_g)
    z = jnp.einsum('bsd,de->bse', u, w_in)
    idx = np.cumsum(IN_SPLITS)[:-1].tolist()
    q, k, v, g_attn, c_b, c_c, c_x, g_conv, x_lru, g_lru = jnp.split(z, idx, axis=-1)
    y_attn = _windowed_gqa(q, k, v, rel_table, sink) * jax.nn.silu(g_attn)
    y_conv = c_b * _depthwise_conv(c_c * c_x, conv_w, (1, 1)) * jax.nn.silu(g_conv)
    y_fwd = _rglru_direction(x_lru, lru_conv_w[0], lru_conv_b[0], lru_w_a[0], lru_b_a[0],
                             lru_w_i[0], lru_b_i[0], lru_L[0], (LRU_CONV_K - 1, 0), False)
    y_bwd = _rglru_direction(x_lru, lru_conv_w[1], lru_conv_b[1], lru_w_a[1], lru_b_a[1],
                             lru_w_i[1], lru_b_i[1], lru_L[1], (0, LRU_CONV_K - 1), True)
    y_lru = (y_fwd + y_bwd).astype(h.dtype) * jax.nn.silu(g_lru)
    mix = jnp.concatenate([y_attn, y_conv, y_lru], axis=-1)
    h = h + jnp.einsum('bse,ed->bsd', mix, w_out)
    gate = jax.nn.sigmoid(jnp.einsum('bsd,de->bse', _rmsnorm(h, ple_norm), ple_w_gate))
    return h + gate * jnp.einsum('bsp,pd->bsd', p, ple_w_proj)


def _trunk(x, p, norm_mix, w_in, w_out, rel_bias, attn_sink, conv_w, lru_conv_w, lru_conv_b,
           lru_w_a, lru_b_a, lru_w_i, lru_b_i, lru_L, ple_norm, ple_w_gate, ple_w_proj, final_norm):
    h = x
    for l in range(DEPTH):
        h = _layer(h, p[l], norm_mix[l], w_in[l], w_out[l], rel_bias, attn_sink[l], conv_w[l],
                   lru_conv_w[l], lru_conv_b[l], lru_w_a[l], lru_b_a[l], lru_w_i[l], lru_b_i[l],
                   lru_L[l], ple_norm[l], ple_w_gate[l], ple_w_proj[l])
    return _rmsnorm(h, final_norm)


def setup_inputs(seed: int = 0) -> dict:
    key = jax.random.key(seed)
    ks = jax.random.split(key, 24)
    f32 = jnp.float32

    def nrm(k, shape, scale):
        return scale * jax.random.normal(k, shape, f32)

    a0 = jax.random.uniform(ks[16], (DEPTH, 2, LRU_WIDTH), f32, 0.9, 0.999)
    s0 = a0 ** (1.0 / LRU_C)
    lru_L = jnp.log(s0) - jnp.log1p(-s0)
    return {
        'x_prompt': nrm(ks[0], (BATCH, SEQ, D_MODEL), 1.0),
        'x_sample': nrm(ks[1], (DEC_BATCH, DEC_SEQ, D_MODEL), 1.0),
        'p_prompt': nrm(ks[2], (DEPTH, BATCH, SEQ, PLE_DIM), 1.0),
        'p_sample': nrm(ks[3], (DEPTH, DEC_BATCH, DEC_SEQ, PLE_DIM), 1.0),
        'norm_mix': 1.0 + nrm(ks[4], (DEPTH, D_MODEL), 0.02),
        'w_in': nrm(ks[5], (DEPTH, D_MODEL, IN_WIDTH), D_MODEL ** -0.5),
        'w_out': nrm(ks[6], (DEPTH, MIX_WIDTH, D_MODEL), MIX_WIDTH ** -0.5),
        'rel_bias': nrm(ks[7], (N_BUCKETS, N_HEADS), 0.5),
        'attn_sink': nrm(ks[8], (DEPTH, N_HEADS), 0.5),
        'conv_w': nrm(ks[9], (DEPTH, CONV_K, CONV_WIDTH), CONV_K ** -0.5),
        'lru_conv_w': nrm(ks[10], (DEPTH, 2, LRU_CONV_K, LRU_WIDTH), LRU_CONV_K ** -0.5),
        'lru_conv_b': nrm(ks[11], (DEPTH, 2, LRU_WIDTH), 0.02),
        'lru_w_a': nrm(ks[12], (DEPTH, 2, LRU_HEADS, LRU_BLOCK, LRU_BLOCK), LRU_BLOCK ** -0.5),
        'lru_b_a': nrm(ks[13], (DEPTH, 2, LRU_WIDTH), 0.1),
        'lru_w_i': nrm(ks[14], (DEPTH, 2, LRU_HEADS, LRU_BLOCK, LRU_BLOCK), LRU_BLOCK ** -0.5),
        'lru_b_i': nrm(ks[15], (DEPTH, 2, LRU_WIDTH), 0.1),
        'lru_L': lru_L,
        'ple_norm': 1.0 + nrm(ks[17], (DEPTH, D_MODEL), 0.02),
        'ple_w_gate': nrm(ks[18], (DEPTH, D_MODEL, D_MODEL), D_MODEL ** -0.5),
        'ple_w_proj': nrm(ks[19], (DEPTH, PLE_DIM, D_MODEL), PLE_DIM ** -0.5),
        'final_norm': 1.0 + nrm(ks[20], (D_MODEL,), 0.02),
    }


def reference(x_prompt, x_sample, p_prompt, p_sample, norm_mix, w_in, w_out, rel_bias, attn_sink,
              conv_w, lru_conv_w, lru_conv_b, lru_w_a, lru_b_a, lru_w_i, lru_b_i, lru_L,
              ple_norm, ple_w_gate, ple_w_proj, final_norm):
    y_prompt = _trunk(x_prompt, p_prompt, norm_mix, w_in, w_out, rel_bias, attn_sink, conv_w,
                      lru_conv_w, lru_conv_b, lru_w_a, lru_b_a, lru_w_i, lru_b_i, lru_L,
                      ple_norm, ple_w_gate, ple_w_proj, final_norm)
    y_sample = _trunk(x_sample, p_sample, norm_mix, w_in, w_out, rel_bias, attn_sink, conv_w,
                      lru_conv_w, lru_conv_b, lru_w_a, lru_b_a, lru_w_i, lru_b_i, lru_L,
                      ple_norm, ple_w_gate, ple_w_proj, final_norm)
    return (y_prompt, y_sample)
```

```cpp
#include <hip/hip_runtime.h>
#include <hip/hip_cooperative_groups.h>
#include <cstdio>
#include <cstdint>
namespace cg = cooperative_groups;
namespace pg8 {
#define PG8_LAS __attribute__((address_space(3)))
typedef unsigned short bf16_t;
typedef short bf16x8 __attribute__((ext_vector_type(8)));
typedef float f32x4 __attribute__((ext_vector_type(4)));
typedef unsigned u32x4 __attribute__((ext_vector_type(4)));
constexpr int BM = 256, BK = 64, HALF = 128, HTB = HALF * BK * 2  , STAGE_BYTES = 8 * HTB, NXCD = 8, WGM = 8;

__host__ __device__ __forceinline__ int lds_byte(int r, int c) { const int st = (r >> 4) * 2 + (c >> 5), rr = r & 15, cc = c & 31, ob = rr * 64 + cc * 2; return st * 1024 + (ob ^ (((ob >> 9) & 1) << 5)); }
__host__ __device__ __forceinline__ void stage_rc(int b, int& R, int& C) { const int st = b / 1024, sb = b % 1024, swz = sb ^ (((sb >> 9) & 1) << 5); R = (st >> 1) * 16 + swz / 64; C = (st & 1) * 32 + (swz % 64) / 2; }
__host__ __device__ __forceinline__ int perm32(int rho) { const int n = rho >> 4, i = rho & 15; return 8 * (i >> 2) + 4 * n + (i & 3); }

struct Unit { int pm, pn; };
struct Gemm { const bf16_t* A; const bf16_t* Bt; int M, N, K; };

struct StaticOrder {
    int nM, nN, nwg, G, c;
    __host__ __device__ void init(int M, int N, int G_, int c_) { nM = M / BM; nN = N / BM; nwg = nM * nN; G = G_; c = c_; }
    __host__ __device__ bool next(int i, Unit& u) const {
        const long L = (long)i * G + c; if (L >= nwg) return false;
        int wgid = (int)L; { const int q = nwg / NXCD, r = nwg % NXCD, xcd = wgid % NXCD, off = wgid / NXCD; wgid = (xcd < r ? xcd * (q + 1) : r * (q + 1) + (xcd - r) * q) + off; }
        const int nig = WGM * nN, gid = wgid / nig, fm = gid * WGM, gsz = (nM - fm) < WGM ? (nM - fm) : WGM;
        u.pm = fm + ((wgid % nig) % gsz); u.pn = (wgid % nig) / gsz; return true;
    }
    __device__ __forceinline__ void a_ready(const Unit&) const {}
    __device__ __forceinline__ void done(const Unit&) const {}
};

__device__ __forceinline__ unsigned cvt_pk_bf16(float lo, float hi) { unsigned r; asm volatile("v_cvt_pk_bf16_f32 %0, %1, %2" : "=v"(r) : "v"(lo), "v"(hi)); return r; }
__device__ __forceinline__ float fast_sigmoid(float x) { return __builtin_amdgcn_rcpf(1.f + __expf(-x)); }
__device__ __forceinline__ float bf_lo(unsigned w) { return __builtin_bit_cast(float, w << 16); }
__device__ __forceinline__ float bf_hi(unsigned w) { return __builtin_bit_cast(float, w & 0xffff0000u); }
constexpr int DM = 2048;
constexpr float NEPS = 1e-6f;

struct EpiZ {
    static constexpr bool PERM = true, AFTER_DRAIN = false;
    bf16_t* O; int ldc; const float* ssq;
    __device__ __forceinline__ void operator()(const f32x4 (&acc)[2][2][4][2], const Unit& u, int wr, int wc, int fr, int fq) const {
        const int row0 = u.pm * BM + wr * 64 + fr, col0 = u.pn * BM + wc * 32 + 8 * fq;
#pragma unroll
        for (int ai = 0; ai < 2; ++ai)
#pragma unroll
            for (int m = 0; m < 4; ++m) { const int row = row0 + ai * HALF + m * 16;
                const float sc = ssq ? rsqrtf(ssq[row] * (1.f / DM) + NEPS) : 1.f;
                bf16_t* rowp = O + (size_t)row * ldc + col0;
#pragma unroll
                for (int bj = 0; bj < 2; ++bj) { const f32x4 v0 = acc[ai][bj][m][0] * sc, v1 = acc[ai][bj][m][1] * sc;
                    u32x4 w; w.x = cvt_pk_bf16(v0[0], v0[1]); w.y = cvt_pk_bf16(v0[2], v0[3]); w.z = cvt_pk_bf16(v1[0], v1[1]); w.w = cvt_pk_bf16(v1[2], v1[3]);
                    *(u32x4*)(rowp + bj * HALF) = w; } }
    }
};

struct EpiRes {
    static constexpr bool PERM = true, AFTER_DRAIN = false;
    const float* src0; const float* src1; float* out; bf16_t* hb; float* ssq;
    __device__ __forceinline__ void operator()(const f32x4 (&acc)[2][2][4][2], const Unit& u, int wr, int wc, int fr, int fq) const {
        const int row0 = u.pm * BM + wr * 64 + fr, col0 = u.pn * BM + wc * 32 + 8 * fq;
#pragma unroll
        for (int ai = 0; ai < 2; ++ai)
#pragma unroll
            for (int m = 0; m < 4; ++m) { const int row = row0 + ai * HALF + m * 16;
                const float* sp = (row < 16384 ? src0 + (size_t)row * DM : src1 + (size_t)(row - 16384) * DM) + col0;
                float* op = out + (size_t)row * DM + col0; bf16_t* hp = hb + (size_t)row * DM + col0; float s = 0.f;
#pragma unroll
                for (int bj = 0; bj < 2; ++bj) { const f32x4 r0 = *(const f32x4*)(sp + bj * HALF), r1 = *(const f32x4*)(sp + bj * HALF + 4);
                    const f32x4 v0 = acc[ai][bj][m][0] + r0, v1 = acc[ai][bj][m][1] + r1;
                    *(f32x4*)(op + bj * HALF) = v0; *(f32x4*)(op + bj * HALF + 4) = v1;
                    u32x4 w; w.x = cvt_pk_bf16(v0[0], v0[1]); w.y = cvt_pk_bf16(v0[2], v0[3]); w.z = cvt_pk_bf16(v1[0], v1[1]); w.w = cvt_pk_bf16(v1[2], v1[3]);
                    *(u32x4*)(hp + bj * HALF) = w;
                    s += v0[0] * v0[0] + v0[1] * v0[1] + v0[2] * v0[2] + v0[3] * v0[3] + v1[0] * v1[0] + v1[1] * v1[1] + v1[2] * v1[2] + v1[3] * v1[3]; }
                s += __shfl_xor(s, 16); s += __shfl_xor(s, 32);
                if (fq == 0) atomicAdd(ssq + row, s); }
    }
};

struct EpiGate {
    static constexpr bool PERM = true, AFTER_DRAIN = false;
    const float* ssq_in; float* out; const bf16_t* pp; bf16_t* hb; float* ssq_out;
    __device__ __forceinline__ void operator()(const f32x4 (&acc)[2][2][4][2], const Unit& u, int wr, int wc, int fr, int fq) const {
        const int row0 = u.pm * BM + wr * 64 + fr, col0 = u.pn * BM + wc * 32 + 8 * fq;
#pragma unroll
        for (int ai = 0; ai < 2; ++ai)
#pragma unroll
            for (int m = 0; m < 4; ++m) { const int row = row0 + ai * HALF + m * 16;
                const float sc = rsqrtf(ssq_in[row] * (1.f / DM) + NEPS);
                float* op = out + (size_t)row * DM + col0; bf16_t* hp = hb + (size_t)row * DM + col0; const bf16_t* ppp = pp + (size_t)row * DM + col0; float s = 0.f;
#pragma unroll
                for (int bj = 0; bj < 2; ++bj) { const f32x4 r0 = *(const f32x4*)(op + bj * HALF), r1 = *(const f32x4*)(op + bj * HALF + 4);
                    const u32x4 pw = *(const u32x4*)(ppp + bj * HALF);
                    const f32x4 a0 = acc[ai][bj][m][0] * sc, a1 = acc[ai][bj][m][1] * sc;
                    f32x4 v0, v1;
                    v0[0] = r0[0] + fast_sigmoid(a0[0]) * bf_lo(pw.x); v0[1] = r0[1] + fast_sigmoid(a0[1]) * bf_hi(pw.x);
                    v0[2] = r0[2] + fast_sigmoid(a0[2]) * bf_lo(pw.y); v0[3] = r0[3] + fast_sigmoid(a0[3]) * bf_hi(pw.y);
                    v1[0] = r1[0] + fast_sigmoid(a1[0]) * bf_lo(pw.z); v1[1] = r1[1] + fast_sigmoid(a1[1]) * bf_hi(pw.z);
                    v1[2] = r1[2] + fast_sigmoid(a1[2]) * bf_lo(pw.w); v1[3] = r1[3] + fast_sigmoid(a1[3]) * bf_hi(pw.w);
                    *(f32x4*)(op + bj * HALF) = v0; *(f32x4*)(op + bj * HALF + 4) = v1;
                    u32x4 w; w.x = cvt_pk_bf16(v0[0], v0[1]); w.y = cvt_pk_bf16(v0[2], v0[3]); w.z = cvt_pk_bf16(v1[0], v1[1]); w.w = cvt_pk_bf16(v1[2], v1[3]);
                    *(u32x4*)(hp + bj * HALF) = w;
                    s += v0[0] * v0[0] + v0[1] * v0[1] + v0[2] * v0[2] + v0[3] * v0[3] + v1[0] * v1[0] + v1[1] * v1[1] + v1[2] * v1[2] + v1[3] * v1[3]; }
                s += __shfl_xor(s, 16); s += __shfl_xor(s, 32);
                if (fq == 0) atomicAdd(ssq_out + row, s); }
    }
};
template <class Epi, class Sched, bool ALIGN_EPI = false, bool SP2 = false>
__device__ __forceinline__ void gemm_phase(PG8_LAS unsigned char* lds, const Gemm g, const Sched& S, const Epi& E) {
    int tid_ = threadIdx.x; asm volatile("" : "+v"(tid_));
    const int tid = tid_, wid = __builtin_amdgcn_readfirstlane(tid >> 6), lane = tid & 63, wr = wid >> 2, wc = wid & 3, fr = lane & 15, fq = lane >> 4;
    int K_ = g.K; asm volatile("" : "+s"(K_));
    const int K = K_, nt = K / BK;
    unsigned voffA[2], voffB[2];
#pragma unroll
    for (int i = 0; i < 2; ++i) { int R, C; stage_rc(tid * 16 + i * 8192, R, C); const int Rb = Epi::PERM ? ((R & ~31) + perm32(R & 31)) : R;
        voffA[i] = (unsigned)(R * K + C) * 2u; voffB[i] = (unsigned)(Rb * K + C) * 2u; }
    const size_t kstep = (size_t)(BK * 2);
    const size_t hstep = (size_t)HALF * K * 2;
    const size_t tstep = 2 * hstep;
    const unsigned ldsw = (unsigned)wid * 1024u;
    const int aoff = lds_byte(wr * 64 + fr, fq * 8), boff = lds_byte(wc * 32 + fr, fq * 8);
#define PG8_SA(b, h) (((b) * 2 + (h)) * HTB)
#define PG8_SB(b, h) ((4 + (b) * 2 + (h)) * HTB)
#define PG8_STAGE(bufoff, gbase, voff) do { _Pragma("unroll") for (int _i = 0; _i < 2; ++_i) \
        __builtin_amdgcn_global_load_lds((const unsigned*)((const char*)(gbase) + (voff)[_i]), (PG8_LAS unsigned*)(lds + (bufoff) + ldsw + _i * 8192), 16, 0, 0); } while (0)
#define PG8_LDA(dst, b, h) do { _Pragma("unroll") for (int m = 0; m < 4; ++m) _Pragma("unroll") for (int k = 0; k < 2; ++k) dst[m][k] = *(const PG8_LAS bf16x8*)(lds + PG8_SA(b, h) + aoff + m * 2048 + k * 1024); } while (0)
#define PG8_LDB(dst, b, h) do { _Pragma("unroll") for (int n = 0; n < 2; ++n) _Pragma("unroll") for (int k = 0; k < 2; ++k) dst[n][k] = *(const PG8_LAS bf16x8*)(lds + PG8_SB(b, h) + boff + n * 2048 + k * 1024); } while (0)
#define PG8_MMA(ai, bj, At, Bt) do { __builtin_amdgcn_s_setprio(1); _Pragma("unroll") for (int m = 0; m < 4; ++m) _Pragma("unroll") for (int n = 0; n < 2; ++n) _Pragma("unroll") for (int k = 0; k < 2; ++k) \
        acc[ai][bj][m][n] = __builtin_amdgcn_mfma_f32_16x16x32_bf16(Bt[n][k], At[m][k], acc[ai][bj][m][n], 0, 0, 0); __builtin_amdgcn_s_setprio(0); } while (0)
#define PG8_WAIT_V(n) asm volatile("s_waitcnt vmcnt(" #n ")" ::: "memory")
#define PG8_WAIT_L(n) asm volatile("s_waitcnt lgkmcnt(" #n ")" ::: "memory")
#define PG8_BAR __builtin_amdgcn_s_barrier()
#define PG8_SCHED __builtin_amdgcn_sched_barrier(0)
    Unit cur, nxt; int ui = 0;
    if (!S.next(0, cur)) return;
    f32x4 acc[2][2][4][2];
#pragma unroll
    for (int a = 0; a < 2; ++a)
#pragma unroll
        for (int b = 0; b < 2; ++b)
#pragma unroll
            for (int m = 0; m < 4; ++m)
#pragma unroll
                for (int n = 0; n < 2; ++n) acc[a][b][m][n] = (f32x4){0.f, 0.f, 0.f, 0.f};
    bf16x8 At[4][2], B0[2][2], B1[2][2];
    const char* cA = (const char*)g.A + (size_t)cur.pm * tstep; const char* cB = (const char*)g.Bt + (size_t)cur.pn * tstep;
    S.a_ready(cur);
    if constexpr (SP2) {
        PG8_STAGE(PG8_SB(0, 0), cB, voffB); PG8_STAGE(PG8_SB(0, 1), cB + hstep, voffB); PG8_STAGE(PG8_SA(0, 0), cA, voffA); PG8_STAGE(PG8_SA(0, 1), cA + hstep, voffA);
        if (wr == 1) PG8_BAR;
        PG8_WAIT_V(2); PG8_BAR;
        PG8_STAGE(PG8_SB(1, 0), cB + kstep, voffB); PG8_STAGE(PG8_SA(1, 0), cA + kstep, voffA); PG8_STAGE(PG8_SB(1, 1), cB + hstep + kstep, voffB);
        PG8_WAIT_V(6); PG8_BAR;
    } else {
        PG8_STAGE(PG8_SB(0, 0), cB, voffB); PG8_STAGE(PG8_SA(0, 0), cA, voffA); PG8_STAGE(PG8_SB(0, 1), cB + hstep, voffB); PG8_STAGE(PG8_SA(0, 1), cA + hstep, voffA);
        if (wr == 1) PG8_BAR;
        PG8_WAIT_V(4); PG8_BAR;
        PG8_STAGE(PG8_SB(1, 0), cB + kstep, voffB); PG8_STAGE(PG8_SA(1, 0), cA + kstep, voffA); PG8_STAGE(PG8_SB(1, 1), cB + hstep + kstep, voffB);
        PG8_WAIT_V(6); PG8_BAR;
    }
    for (;;) {
        const bool has_next = S.next(ui + 1, nxt);
        const char* nA = has_next ? (const char*)g.A + (size_t)nxt.pm * tstep : cA; const char* nB = has_next ? (const char*)g.Bt + (size_t)nxt.pn * tstep : cB;
        for (int t = 0; t < nt; t += 2) {
            const bool last = (t == nt - 2);
            const char* a1 = cA + (size_t)(t + 1) * kstep;
            const char* a2 = last ? nA : cA + (size_t)(t + 2) * kstep; const char* b2 = last ? nB : cB + (size_t)(t + 2) * kstep;
            const char* a3 = a2 + kstep; const char* b3 = b2 + kstep;
            if (last && has_next) S.a_ready(nxt);
            if constexpr (SP2) {
            PG8_LDB(B0, 0, 0); PG8_LDB(B1, 0, 1); PG8_SCHED; PG8_LDA(At, 0, 0); PG8_STAGE(PG8_SA(1, 1), a1 + hstep, voffA);
            PG8_WAIT_V(8); PG8_WAIT_L(0); PG8_BAR; PG8_MMA(0, 0, At, B0); PG8_MMA(0, 1, At, B1); PG8_BAR; PG8_SCHED;
            PG8_LDA(At, 0, 1); PG8_STAGE(PG8_SB(0, 0), b2, voffB); PG8_STAGE(PG8_SB(0, 1), b2 + hstep, voffB); PG8_STAGE(PG8_SA(0, 0), a2, voffA);
            PG8_WAIT_V(8); PG8_WAIT_L(0); PG8_BAR; PG8_MMA(1, 0, At, B0); PG8_MMA(1, 1, At, B1); PG8_BAR; PG8_SCHED;
            PG8_LDB(B0, 1, 0); PG8_LDB(B1, 1, 1); PG8_SCHED; PG8_LDA(At, 1, 0); PG8_STAGE(PG8_SA(0, 1), a2 + hstep, voffA);
            PG8_WAIT_V(8); PG8_WAIT_L(0); PG8_BAR; PG8_MMA(0, 0, At, B0); PG8_MMA(0, 1, At, B1); PG8_BAR; PG8_SCHED;
            PG8_LDA(At, 1, 1); PG8_STAGE(PG8_SB(1, 0), b3, voffB); PG8_STAGE(PG8_SB(1, 1), b3 + hstep, voffB); PG8_STAGE(PG8_SA(1, 0), a3, voffA);
            PG8_WAIT_V(8); PG8_WAIT_L(0); PG8_BAR; PG8_MMA(1, 0, At, B0); PG8_MMA(1, 1, At, B1); PG8_BAR; PG8_SCHED;
            } else {
            PG8_LDB(B0, 0, 0); PG8_SCHED; PG8_LDA(At, 0, 0); PG8_STAGE(PG8_SA(1, 1), a1 + hstep, voffA);
            PG8_WAIT_L(8); PG8_BAR; PG8_WAIT_L(0); PG8_MMA(0, 0, At, B0); PG8_BAR; PG8_SCHED;
            PG8_LDB(B1, 0, 1); PG8_STAGE(PG8_SB(0, 0), b2, voffB);
            PG8_BAR; PG8_WAIT_L(0); PG8_MMA(0, 1, At, B1); PG8_BAR;
            PG8_LDA(At, 0, 1); PG8_STAGE(PG8_SA(0, 0), a2, voffA);
            PG8_BAR; PG8_WAIT_L(0); PG8_MMA(1, 0, At, B0); PG8_BAR; PG8_SCHED;
            PG8_STAGE(PG8_SB(0, 1), b2 + hstep, voffB);
            PG8_WAIT_V(6); PG8_BAR; PG8_MMA(1, 1, At, B1); PG8_BAR;
            PG8_LDB(B0, 1, 0); PG8_SCHED; PG8_LDA(At, 1, 0); PG8_STAGE(PG8_SA(0, 1), a2 + hstep, voffA);
            PG8_WAIT_L(8); PG8_BAR; PG8_WAIT_L(0); PG8_MMA(0, 0, At, B0); PG8_BAR; PG8_SCHED;
            PG8_LDB(B1, 1, 1); PG8_STAGE(PG8_SB(1, 0), b3, voffB);
            PG8_BAR; PG8_WAIT_L(0); PG8_MMA(0, 1, At, B1); PG8_BAR;
            PG8_LDA(At, 1, 1); PG8_STAGE(PG8_SA(1, 0), a3, voffA);
            PG8_BAR; PG8_WAIT_L(0); PG8_MMA(1, 0, At, B0); PG8_BAR; PG8_SCHED;
            PG8_STAGE(PG8_SB(1, 1), b3 + hstep, voffB);
            PG8_WAIT_V(6); PG8_BAR; PG8_MMA(1, 1, At, B1); PG8_BAR;
            }
        }
        if constexpr (ALIGN_EPI) { if (wr == 0) PG8_BAR; }
        if constexpr (!Epi::AFTER_DRAIN) { E(acc, cur, wr, wc, fr, fq); S.done(cur); }
        if (!has_next) break;
#pragma unroll
        for (int a = 0; a < 2; ++a)
#pragma unroll
            for (int b = 0; b < 2; ++b)
#pragma unroll
                for (int m = 0; m < 4; ++m)
#pragma unroll
                    for (int n = 0; n < 2; ++n) acc[a][b][m][n] = (f32x4){0.f, 0.f, 0.f, 0.f};
        cur = nxt; cA = nA; cB = nB; ++ui;
        if constexpr (ALIGN_EPI) { if (wr == 1) PG8_BAR; }
    }
    PG8_WAIT_V(0);
    if constexpr (!ALIGN_EPI) { if (wr == 0) PG8_BAR; }
    PG8_BAR;
    if constexpr (Epi::AFTER_DRAIN) { E.fused(acc, cur, wr, wc, fr, fq, lds, wid, lane); S.done(cur); }
#undef PG8_SA
#undef PG8_SB
#undef PG8_STAGE
#undef PG8_LDA
#undef PG8_LDB
#undef PG8_MMA
#undef PG8_WAIT_V
#undef PG8_WAIT_L
#undef PG8_BAR
#undef PG8_SCHED
}
}
#define LAS __attribute__((address_space(3)))
typedef unsigned short bf16;
typedef unsigned v4u __attribute__((ext_vector_type(4)));
typedef unsigned v2u __attribute__((ext_vector_type(2)));
typedef float f32x4 __attribute__((ext_vector_type(4)));
typedef float f32x16 __attribute__((ext_vector_type(16)));
typedef short bf16x8 __attribute__((ext_vector_type(8)));
typedef short s16x4 __attribute__((ext_vector_type(4)));
constexpr int MTOK = 32768, DMOD = 2048, NZ = 5632, PLE = 256, NCHUNK = MTOK / 128;
constexpr int ZQ = 0, ZK = 1024, ZV = 1280, ZGA = 1536, ZCB = 2560, ZCC = 3072, ZCX = 3584, ZGC = 4096, ZXL = 4608, ZGL = 5120;
constexpr float LOG2E = 1.4426950408889634f;
constexpr int NWAVES = 8, NTHR = 512;
constexpr int LDS_BYTES = 147456;
constexpr size_t MiB = 1u << 20;
constexpr size_t WS_SSQ = 0;
constexpr size_t WS_AGG = 1 * MiB;
constexpr size_t WS_WL = 3 * MiB;
constexpr size_t WS_WPROJ = 4 * MiB;
constexpr size_t WS_WIN = 8 * MiB;
constexpr size_t WS_WOUT = 52 * MiB;
constexpr size_t WS_WGATE = 68 * MiB;
constexpr size_t WS_PB = 84 * MiB;
constexpr size_t WS_HBA = 116 * MiB;
constexpr size_t WS_HBB = 244 * MiB;
constexpr size_t WS_MIX = 372 * MiB;
constexpr size_t WS_PP = 500 * MiB;
constexpr size_t WS_Z = 628 * MiB;
constexpr size_t WS_END = 980 * MiB;

struct Params {
    const float *x_prompt, *x_sample, *p_prompt, *p_sample, *norm_mix, *w_in, *w_out, *rel_bias, *attn_sink, *conv_w, *lru_conv_w, *lru_conv_b,
                *lru_w_a, *lru_b_a, *lru_w_i, *lru_b_i, *lru_L, *ple_norm, *ple_w_gate, *ple_w_proj, *final_norm;
    float* out; unsigned char* ws;
};

__device__ __forceinline__ unsigned f2bf(float f) { unsigned u = __builtin_bit_cast(unsigned, f); return (u + 0x7fffu + ((u >> 16) & 1u)) >> 16; }
__device__ __forceinline__ unsigned pk2(float lo, float hi) { return f2bf(lo) | (f2bf(hi) << 16); }
__device__ __forceinline__ float bflo(unsigned w) { return __builtin_bit_cast(float, w << 16); }
__device__ __forceinline__ float bfhi(unsigned w) { return __builtin_bit_cast(float, w & 0xffff0000u); }
__device__ __forceinline__ float bf1(bf16 v) { return __builtin_bit_cast(float, (unsigned)v << 16); }
__device__ __forceinline__ float sigm(float x) { return __builtin_amdgcn_rcpf(1.f + __expf(-x)); }
__device__ __forceinline__ float silu(float x) { return x * sigm(x); }
__device__ __forceinline__ float wave_sum(float v) {
#pragma unroll
    for (int o = 1; o < 64; o <<= 1) v += __shfl_xor(v, o);
    return v;
}
__device__ __forceinline__ void seq_of_chunk(int c, int& s0, int& ns) { if (c < 128) { s0 = c & ~63; ns = 64; } else { s0 = c & ~15; ns = 16; } }

__device__ __forceinline__ void transpose_item(const float* W, int K, int N, bf16* WT, const float* kscale, LAS float* scr, int item, int lane) {
    const int nblk = N / 32, kb = item / nblk, nb = item % nblk, k0 = 64 * kb, n0 = 32 * nb;
#pragma unroll 8
    for (int i = 0; i < 32; ++i) { const int kk = 2 * i + (lane >> 5); float v = W[(size_t)(k0 + kk) * N + n0 + (lane & 31)]; if (kscale) v *= kscale[k0 + kk]; scr[kk * 33 + (lane & 31)] = v; }
    asm volatile("s_waitcnt lgkmcnt(0)" ::: "memory");
    const int c = lane & 7;
#pragma unroll
    for (int j = 0; j < 4; ++j) { const int n = (lane >> 3) + 8 * j; const LAS float* s = scr + (8 * c) * 33 + n;
        v4u o; o.x = pk2(s[0 * 33], s[1 * 33]); o.y = pk2(s[2 * 33], s[3 * 33]); o.z = pk2(s[4 * 33], s[5 * 33]); o.w = pk2(s[6 * 33], s[7 * 33]);
        *(v4u*)(WT + (size_t)(n0 + n) * K + k0 + 8 * c) = o; }
    asm volatile("s_waitcnt lgkmcnt(0)" ::: "memory");
}

__device__ __forceinline__ void p0_prologue(const Params& P, LAS unsigned char* lds, int tid, int G) {
    asm volatile("" : "+v"(tid));
    const int lane = tid & 63, wave = tid >> 6;
    const int gw = blockIdx.x * NWAVES + wave, NGW = G * NWAVES;
    const long gt = (long)blockIdx.x * NTHR + tid, NGT = (long)G * NTHR;
    unsigned char* ws = P.ws;
    { float* ssq = (float*)(ws + WS_SSQ); for (long i = gt; i < 4L * MTOK; i += NGT) ssq[MTOK + i] = 0.f; }
    LAS float* scr = (LAS float*)(lds + wave * 16384);
    constexpr int I_IN = (DMOD / 64) * (NZ / 32), I_SQ = (DMOD / 64) * (DMOD / 32), I_PR = (PLE / 64) * (DMOD / 32), I_L1 = (128 / 64) * (128 / 32), I_L = 16 * I_L1;
    constexpr int I_LAYER = I_IN + 2 * I_SQ + I_PR + I_L;
    for (int it = gw; it < 2 * I_LAYER; it += NGW) {
        const int l = it / I_LAYER; int r = it % I_LAYER;
        if (r < I_IN) { transpose_item(P.w_in + (size_t)l * DMOD * NZ, DMOD, NZ, (bf16*)(ws + WS_WIN) + (size_t)l * NZ * DMOD, P.norm_mix + l * DMOD, scr, r, lane); continue; } r -= I_IN;
        if (r < I_SQ) { transpose_item(P.w_out + (size_t)l * DMOD * DMOD, DMOD, DMOD, (bf16*)(ws + WS_WOUT) + (size_t)l * DMOD * DMOD, nullptr, scr, r, lane); continue; } r -= I_SQ;
        if (r < I_SQ) { transpose_item(P.ple_w_gate + (size_t)l * DMOD * DMOD, DMOD, DMOD, (bf16*)(ws + WS_WGATE) + (size_t)l * DMOD * DMOD, P.ple_norm + l * DMOD, scr, r, lane); continue; } r -= I_SQ;
        if (r < I_PR) { transpose_item(P.ple_w_proj + (size_t)l * PLE * DMOD, PLE, DMOD, (bf16*)(ws + WS_WPROJ) + (size_t)l * DMOD * PLE, nullptr, scr, r, lane); continue; } r -= I_PR;
        { const int mat = r / I_L1, sub = r % I_L1;
          const int dir = mat >> 3, which = (mat >> 2) & 1, h = mat & 3;
          const float* src = (which ? P.lru_w_i : P.lru_w_a) + ((size_t)((l * 2 + dir) * 4 + h)) * 128 * 128;
          bf16* dst = (bf16*)(ws + WS_WL) + ((size_t)(((l * 2 + dir) * 2 + which) * 4 + h)) * 128 * 128;
          transpose_item(src, 128, 128, dst, nullptr, scr, sub, lane); }
    }
    { bf16* hbA = (bf16*)(ws + WS_HBA); float* ssq = (float*)(ws + WS_SSQ);
      for (int row = gw; row < MTOK; row += NGW) {
          const float* xr = (row < 16384 ? P.x_prompt + (size_t)row * DMOD : P.x_sample + (size_t)(row - 16384) * DMOD);
          float s = 0.f;
#pragma unroll
          for (int j = 0; j < 8; ++j) { const f32x4 v = *(const f32x4*)(xr + 4 * lane + 256 * j); s += v[0] * v[0] + v[1] * v[1] + v[2] * v[2] + v[3] * v[3];
              v2u o; o.x = pk2(v[0], v[1]); o.y = pk2(v[2], v[3]); *(v2u*)(hbA + (size_t)row * DMOD + 4 * lane + 256 * j) = o; }
          s = wave_sum(s); if (lane == 0) ssq[row] = s; } }
    { bf16* pb = (bf16*)(ws + WS_PB);
      for (long i = gt; i < 2L * MTOK * PLE / 4; i += NGT) { const long e = i * 4; const int l = (int)(e / ((long)MTOK * PLE)); const long r = e % ((long)MTOK * PLE);
          const float* src = (r < 16384L * PLE) ? P.p_prompt + (size_t)l * 16384 * PLE + r : P.p_sample + (size_t)l * 16384 * PLE + (r - 16384L * PLE);
          const f32x4 v = *(const f32x4*)src; v2u o; o.x = pk2(v[0], v[1]); o.y = pk2(v[2], v[3]); *(v2u*)(pb + e) = o; } }
}

__device__ __forceinline__ int t5_bucket(int rel) {
    const int n = rel < 0 ? -rel : rel;
    int b = n < 8 ? n : 8 + (n >= 12) + (n >= 16) + (n >= 23) + (n >= 32) + (n >= 46) + (n >= 64) + (n >= 91);
    return b + (rel > 0 ? 16 : 0);
}
constexpr int AT_KP = 272, AT_VP = 320, AT_KB = 64 * AT_KP, AT_VB = 64 * AT_VP, AT_V0 = 2 * AT_KB, AT_TAB = AT_V0 + 2 * AT_VB;

__device__ __forceinline__ void attn_build_tab(LAS unsigned char* lds, const float* rel_bias, int tid) {
    asm volatile("" : "+v"(tid));
    LAS float* tab = (LAS float*)(lds + AT_TAB);
    for (int i = tid; i < 8 * 257; i += NTHR) { const int hd = i / 257, idx = i % 257; tab[hd * 260 + idx] = rel_bias[t5_bucket(idx - 128) * 8 + hd] * LOG2E; }
}

__device__ __forceinline__ void attn_item(LAS unsigned char* lds, int item, const bf16* z, bf16* mix, const float* sink, int tid) {
    asm volatile("" : "+v"(tid));
    const int c = item >> 2, kvh = (item >> 1) & 1, qhalf = item & 1;
    int s0, ns; seq_of_chunk(c, s0, ns);
    const int w = tid >> 6, lane = tid & 63, ql = lane & 31, h = lane >> 5;
    const int head = kvh * 4 + (w >> 1);
    const int tb = c * 128, tq = tb + qhalf * 64 + (w & 1) * 32 + ql;
    const int seq_lo = s0 * 128, seq_hi = (s0 + ns) * 128, kwin0 = tb - 128 + qhalf * 64;
    int j_lo = 0, j_hi = 4;
    while (kwin0 + 64 * j_lo < seq_lo) ++j_lo;
    while (kwin0 + 64 * j_hi + 64 > seq_hi) --j_hi;
    bf16x8 qf[8];
    { const bf16* qp = z + (size_t)tq * NZ + ZQ + head * 128 + 8 * h;
#pragma unroll
      for (int ks = 0; ks < 8; ++ks) qf[ks] = *(const bf16x8*)(qp + 16 * ks); }
    float m = sink[head] * LOG2E, lsum = (h == 0) ? 1.f : 0.f;
    f32x16 O[4];
#pragma unroll
    for (int dt = 0; dt < 4; ++dt)
#pragma unroll
        for (int i = 0; i < 16; ++i) O[dt][i] = 0.f;
    const LAS float* tabh = (const LAS float*)(lds + AT_TAB) + head * 260;
    const float c1 = 0.08838834764831845f * LOG2E;
    v4u stg[4];
    const int pkey = tid >> 4, pc = tid & 15;
    auto prefetch = [&](int j) {
        const bf16* base = z + (size_t)(kwin0 + 64 * j + pkey) * NZ + kvh * 128 + pc * 8;
        stg[0] = *(const v4u*)(base + ZK); stg[1] = *(const v4u*)(base + ZK + (size_t)32 * NZ);
        stg[2] = *(const v4u*)(base + ZV); stg[3] = *(const v4u*)(base + ZV + (size_t)32 * NZ);
    };
    prefetch(j_lo);
    const int g4 = lane >> 4, q4 = (lane & 15) >> 2, p4 = lane & 3;
    for (int j = j_lo; j <= j_hi; ++j) {
        LAS unsigned char* Kb = lds + (j & 1) * AT_KB; LAS unsigned char* Vb = lds + AT_V0 + (j & 1) * AT_VB;
        *(LAS v4u*)(Kb + pkey * AT_KP + pc * 16) = stg[0]; *(LAS v4u*)(Kb + (pkey + 32) * AT_KP + pc * 16) = stg[1];
        *(LAS v4u*)(Vb + pkey * AT_VP + pc * 16) = stg[2]; *(LAS v4u*)(Vb + (pkey + 32) * AT_VP + pc * 16) = stg[3];
        if (j < j_hi) prefetch(j + 1);
        __syncthreads();
        f32x16 s[2];
#pragma unroll
        for (int kt = 0; kt < 2; ++kt) {
#pragma unroll
            for (int i = 0; i < 16; ++i) s[kt][i] = 0.f;
#pragma unroll
            for (int ks = 0; ks < 8; ++ks) { const bf16x8 kf = *(const LAS bf16x8*)(Kb + (kt * 32 + ql) * AT_KP + (16 * ks + 8 * h) * 2);
                s[kt] = __builtin_amdgcn_mfma_f32_32x32x16_bf16(kf, qf[ks], s[kt], 0, 0, 0); }
        }
        float mx = -3.0e38f;
#pragma unroll
        for (int kt = 0; kt < 2; ++kt) { const int relb = (kwin0 + 64 * j + 32 * kt + 4 * h) - tq + 128;
#pragma unroll
            for (int i = 0; i < 16; ++i) { const int idx = relb + (i & 3) + 8 * (i >> 2); const bool ok = (unsigned)idx <= 256u;
                const float b = tabh[ok ? idx : 0]; const float t = ok ? s[kt][i] * c1 + b : -1.0e30f; s[kt][i] = t; mx = fmaxf(mx, t); } }
        mx = fmaxf(mx, __shfl_xor(mx, 32));
        const float mn = fmaxf(m, mx), alpha = __builtin_amdgcn_exp2f(m - mn); m = mn;
        float ps = 0.f;
#pragma unroll
        for (int kt = 0; kt < 2; ++kt)
#pragma unroll
            for (int i = 0; i < 16; ++i) { const float p = __builtin_amdgcn_exp2f(s[kt][i] - mn); s[kt][i] = p; ps += p; }
        lsum = lsum * alpha + ps;
#pragma unroll
        for (int dt = 0; dt < 4; ++dt)
#pragma unroll
            for (int i = 0; i < 16; ++i) O[dt][i] *= alpha;
#pragma unroll
        for (int kt = 0; kt < 2; ++kt)
#pragma unroll
            for (int s2 = 0; s2 < 2; ++s2) {
                v4u pw; pw.x = pk2(s[kt][8 * s2 + 0], s[kt][8 * s2 + 1]); pw.y = pk2(s[kt][8 * s2 + 2], s[kt][8 * s2 + 3]);
                pw.z = pk2(s[kt][8 * s2 + 4], s[kt][8 * s2 + 5]); pw.w = pk2(s[kt][8 * s2 + 6], s[kt][8 * s2 + 7]);
                const bf16x8 pf = __builtin_bit_cast(bf16x8, pw);
                const LAS unsigned char* vrow = Vb + (32 * kt + 16 * s2 + 4 * h + q4) * AT_VP + (16 * (g4 & 1) + 4 * p4) * 2;
#pragma unroll
                for (int dt = 0; dt < 4; ++dt) {
                    const s16x4 lo = __builtin_amdgcn_ds_read_tr16_b64_v4i16((LAS s16x4*)(vrow + dt * 64));
                    const s16x4 hi = __builtin_amdgcn_ds_read_tr16_b64_v4i16((LAS s16x4*)(vrow + dt * 64 + 8 * AT_VP));
                    const bf16x8 vf = __builtin_shufflevector(lo, hi, 0, 1, 2, 3, 4, 5, 6, 7);
                    O[dt] = __builtin_amdgcn_mfma_f32_32x32x16_bf16(vf, pf, O[dt], 0, 0, 0);
                }
            }
    }
    const float ltot = lsum + __shfl_xor(lsum, 32), inv = 1.f / ltot;
    const bf16* gp = z + (size_t)tq * NZ + ZGA + head * 128 + 4 * h; bf16* op = mix + (size_t)tq * DMOD + head * 128 + 4 * h;
#pragma unroll
    for (int dt = 0; dt < 4; ++dt)
#pragma unroll
        for (int rg = 0; rg < 4; ++rg) { const v2u gw = *(const v2u*)(gp + 32 * dt + 8 * rg);
            const float o0 = O[dt][4 * rg + 0] * inv * silu(bflo(gw.x)), o1 = O[dt][4 * rg + 1] * inv * silu(bfhi(gw.x));
            const float o2 = O[dt][4 * rg + 2] * inv * silu(bflo(gw.y)), o3 = O[dt][4 * rg + 3] * inv * silu(bfhi(gw.y));
            v2u ow; ow.x = pk2(o0, o1); ow.y = pk2(o2, o3); *(v2u*)(op + 32 * dt + 8 * rg) = ow; }
    __syncthreads();
}

__device__ __forceinline__ void conv_phase(const bf16* z, bf16* mix, const float* cw  , int G, int tid) {
    asm volatile("" : "+v"(tid));
    const long NW = (long)MTOK * 64;
    for (long i = (long)blockIdx.x * NTHR + tid; i < NW; i += (long)G * NTHR) {
        const int t = (int)(i >> 6), cg8 = (int)(i & 63) * 8;
        int s0, ns; seq_of_chunk(t >> 7, s0, ns);
        const bool hasp = t > s0 * 128, hasn = t + 1 < (s0 + ns) * 128;
        const bf16* zr = z + (size_t)t * NZ;
        const v4u cb = *(const v4u*)(zr + ZCB + cg8), gc = *(const v4u*)(zr + ZGC + cg8);
        const v4u c1 = *(const v4u*)(zr + ZCC + cg8), x1 = *(const v4u*)(zr + ZCX + cg8);
        v4u c0 = {0, 0, 0, 0}, x0 = {0, 0, 0, 0}, c2 = {0, 0, 0, 0}, x2 = {0, 0, 0, 0};
        if (hasp) { c0 = *(const v4u*)(zr - NZ + ZCC + cg8); x0 = *(const v4u*)(zr - NZ + ZCX + cg8); }
        if (hasn) { c2 = *(const v4u*)(zr + NZ + ZCC + cg8); x2 = *(const v4u*)(zr + NZ + ZCX + cg8); }
        float o[8];
#pragma unroll
        for (int e = 0; e < 4; ++e) {
#pragma unroll
            for (int hh = 0; hh < 2; ++hh) { const int ch = cg8 + 2 * e + hh;
                const float a0 = hh ? bfhi(c0[e]) * bfhi(x0[e]) : bflo(c0[e]) * bflo(x0[e]);
                const float a1 = hh ? bfhi(c1[e]) * bfhi(x1[e]) : bflo(c1[e]) * bflo(x1[e]);
                const float a2 = hh ? bfhi(c2[e]) * bfhi(x2[e]) : bflo(c2[e]) * bflo(x2[e]);
                const float cv = cw[ch] * a0 + cw[512 + ch] * a1 + cw[1024 + ch] * a2;
                const float b = hh ? bfhi(cb[e]) : bflo(cb[e]), g = hh ? bfhi(gc[e]) : bflo(gc[e]);
                o[2 * e + hh] = b * cv * silu(g); } }
        v4u ow; ow.x = pk2(o[0], o[1]); ow.y = pk2(o[2], o[3]); ow.z = pk2(o[4], o[5]); ow.w = pk2(o[6], o[7]);
        *(v4u*)(mix + (size_t)t * DMOD + 1024 + cg8) = ow;
    }
}

constexpr int LR_X = 0, LR_XC = 134 * 256, LR_XCP = 272, LR_Y = LR_XC + 128 * LR_XCP, LR_YP = 132;
struct LruLayer { const float *cw, *cb, *ba, *bi, *L; const bf16* WL; };
template <int PASS>
__device__ __forceinline__ void lru_item(LAS unsigned char* lds, int item, const bf16* z, bf16* mix, const LruLayer& LP, float* agg, int tid) {
    asm volatile("" : "+v"(tid));
    const int c = item >> 2, hh = item & 3;
    int s0, ns; seq_of_chunk(c, s0, ns);
    const int w = tid >> 6, lane = tid & 63, tb = c * 128, seq_lo = s0 * 128, seq_hi = (s0 + ns) * 128;
    for (int p = tid; p < 134 * 16; p += NTHR) { const int r = p >> 4, pc = p & 15, t = tb - 3 + r;
        v4u v = {0, 0, 0, 0}; if (t >= seq_lo && t < seq_hi) v = *(const v4u*)(z + (size_t)t * NZ + ZXL + hh * 128 + pc * 8);
        *(LAS v4u*)(lds + LR_X + r * 256 + pc * 16) = v; }
    __syncthreads();
    const int chl = 16 * w + (lane & 15), chg = hh * 128 + chl, q = lane >> 4;
    LAS float* Y = (LAS float*)(lds + LR_Y);
#pragma unroll 1
    for (int dir = 0; dir < 2; ++dir) {
        for (int p = tid; p < 128 * 16; p += NTHR) { const int t = p >> 4, pc = p & 15; const int r0 = dir ? t + 3 : t;
            float acc8[8]; const float* cb = LP.cb + dir * 512 + hh * 128 + pc * 8;
#pragma unroll
            for (int e = 0; e < 8; ++e) acc8[e] = cb[e];
#pragma unroll
            for (int k = 0; k < 4; ++k) { const v4u xv = *(const LAS v4u*)(lds + LR_X + (r0 + k) * 256 + pc * 16); const float* wk = LP.cw + (dir * 4 + k) * 512 + hh * 128 + pc * 8;
#pragma unroll
                for (int e = 0; e < 4; ++e) { acc8[2 * e] += wk[2 * e] * bflo(xv[e]); acc8[2 * e + 1] += wk[2 * e + 1] * bfhi(xv[e]); } }
            v4u o; o.x = pk2(acc8[0], acc8[1]); o.y = pk2(acc8[2], acc8[3]); o.z = pk2(acc8[4], acc8[5]); o.w = pk2(acc8[6], acc8[7]);
            const int s = dir ? 127 - t : t;
            *(LAS v4u*)(lds + LR_XC + s * LR_XCP + pc * 16) = o; }
        __syncthreads();
        f32x4 ar[8], ai[8];
#pragma unroll
        for (int mt = 0; mt < 8; ++mt) { ar[mt] = (f32x4){0.f, 0.f, 0.f, 0.f}; ai[mt] = (f32x4){0.f, 0.f, 0.f, 0.f}; }
        { const bf16* wa = LP.WL + ((size_t)((dir * 2 + 0) * 4 + hh)) * 16384 + (size_t)chl * 128 + 8 * q;
          const bf16* wi = LP.WL + ((size_t)((dir * 2 + 1) * 4 + hh)) * 16384 + (size_t)chl * 128 + 8 * q;
#pragma unroll
          for (int ks = 0; ks < 4; ++ks) { const bf16x8 bA = *(const bf16x8*)(wa + 32 * ks), bI = *(const bf16x8*)(wi + 32 * ks);
#pragma unroll
              for (int mt = 0; mt < 8; ++mt) { const bf16x8 af = *(const LAS bf16x8*)(lds + LR_XC + (16 * mt + (lane & 15)) * LR_XCP + (32 * ks + 8 * q) * 2);
                  ar[mt] = __builtin_amdgcn_mfma_f32_16x16x32_bf16(af, bA, ar[mt], 0, 0, 0);
                  ai[mt] = __builtin_amdgcn_mfma_f32_16x16x32_bf16(af, bI, ai[mt], 0, 0, 0); } } }
        const float b_a = LP.ba[dir * 512 + chg], b_i = LP.bi[dir * 512 + chg];
        const float c8 = 8.f * log1pf(__expf(-LP.L[dir * 512 + chg]));
        float Hrun = 0.f, Arun = 1.f;
        if (PASS == 1) {
            const float* ag = agg + (size_t)dir * 1024 + 2 * chg;
            if (dir == 0) { for (int cc = s0; cc < c; ++cc) { const float A = ag[(size_t)cc * 2048], B = ag[(size_t)cc * 2048 + 1]; Hrun = A * Hrun + B; } }
            else { for (int cc = s0 + ns - 1; cc > c; --cc) { const float A = ag[(size_t)cc * 2048], B = ag[(size_t)cc * 2048 + 1]; Hrun = A * Hrun + B; } }
        }
#pragma unroll
        for (int mt = 0; mt < 8; ++mt) {
            float a[4], u[4];
#pragma unroll
            for (int r = 0; r < 4; ++r) { const int s = 16 * mt + 4 * q + r;
                const float rr = sigm(ar[mt][r] + b_a), ii = sigm(ai[mt][r] + b_i);
                const float la = -c8 * rr; const float av = __expf(la);
                const float xcv = bf1(*(const LAS bf16*)(lds + LR_XC + s * LR_XCP + chl * 2));
                a[r] = av; u[r] = sqrtf(fmaxf(1.f - av * av, 0.f)) * ii * xcv; }
            float A4 = a[0] * a[1] * a[2] * a[3];
            float B4 = ((u[0] * a[1] + u[1]) * a[2] + u[2]) * a[3] + u[3];
            { const float Ap = __shfl_up(A4, 16), Bp = __shfl_up(B4, 16); if (q >= 1) { B4 = A4 * Bp + B4; A4 = A4 * Ap; } }
            { const float Ap = __shfl_up(A4, 32), Bp = __shfl_up(B4, 32); if (q >= 2) { B4 = A4 * Bp + B4; A4 = A4 * Ap; } }
            float Ae = __shfl_up(A4, 16), Be = __shfl_up(B4, 16); if (q == 0) { Ae = 1.f; Be = 0.f; }
            const float At = __shfl(A4, 48 + (lane & 15)), Bt = __shfl(B4, 48 + (lane & 15));
            if (PASS == 1) {
                float hcur = Ae * Hrun + Be;
#pragma unroll
                for (int r = 0; r < 4; ++r) { hcur = a[r] * hcur + u[r]; const int s = 16 * mt + 4 * q + r; const int t = dir ? 127 - s : s;
                    if (dir == 0) Y[t * LR_YP + chl] = hcur; else Y[t * LR_YP + chl] += hcur; }
            }
            Hrun = At * Hrun + Bt; Arun *= At;
        }
        if (PASS == 0) { if (q == 0) { float* ag = agg + (size_t)c * 2048 + (size_t)dir * 1024 + 2 * chg; ag[0] = Arun; ag[1] = Hrun; } }
        __syncthreads();
    }
    if (PASS == 1) {
        for (int p = tid; p < 128 * 16; p += NTHR) { const int t = p >> 4, pc = p & 15;
            const v4u gv = *(const v4u*)(z + (size_t)(tb + t) * NZ + ZGL + hh * 128 + pc * 8);
            const LAS float* yr = Y + t * LR_YP + pc * 8; float o[8];
#pragma unroll
            for (int e = 0; e < 4; ++e) { o[2 * e] = yr[2 * e] * silu(bflo(gv[e])); o[2 * e + 1] = yr[2 * e + 1] * silu(bfhi(gv[e])); }
            v4u ow; ow.x = pk2(o[0], o[1]); ow.y = pk2(o[2], o[3]); ow.z = pk2(o[4], o[5]); ow.w = pk2(o[6], o[7]);
            *(v4u*)(mix + (size_t)(tb + t) * DMOD + 1536 + hh * 128 + pc * 8) = ow; }
        __syncthreads();
    }
}

#ifndef PH_LO
#define PH_LO 0
#endif
__global__ void __launch_bounds__(NTHR, 2) fwd_megakernel(Params P) {
    extern __shared__ __attribute__((aligned(16))) unsigned char lds_raw[];
    LAS unsigned char* lds = (LAS unsigned char*)lds_raw;
    cg::grid_group grid = cg::this_grid();
    const int tid = threadIdx.x, G = gridDim.x;
    unsigned char* ws = P.ws;
    float* ssq = (float*)(ws + WS_SSQ); float* agg = (float*)(ws + WS_AGG);
    bf16* hbA = (bf16*)(ws + WS_HBA); bf16* hbB = (bf16*)(ws + WS_HBB); bf16* mix = (bf16*)(ws + WS_MIX); bf16* pp = (bf16*)(ws + WS_PP); bf16* z = (bf16*)(ws + WS_Z);

#ifndef NO_P0
    p0_prologue(P, lds, tid, G);
#endif
    grid.sync();
#pragma unroll 1
    for (int l = 0; l < 2; ++l) {
        { pg8::Gemm g{hbA, (const bf16*)(ws + WS_WIN) + (size_t)l * NZ * DMOD, MTOK, NZ, DMOD}; pg8::StaticOrder S; S.init(MTOK, NZ, G, (int)blockIdx.x);
          pg8::EpiZ E{z, NZ, ssq + (size_t)(2 * l) * MTOK};
#ifndef NO_GA
          pg8::gemm_phase<pg8::EpiZ, pg8::StaticOrder, true, true>(lds, g, S, E); }
#else
 }
#endif
        { pg8::Gemm g{(const bf16*)(ws + WS_PB) + (size_t)l * MTOK * PLE, (const bf16*)(ws + WS_WPROJ) + (size_t)l * DMOD * PLE, MTOK, DMOD, PLE}; pg8::StaticOrder S; S.init(MTOK, DMOD, G, (int)blockIdx.x);
          pg8::EpiZ E{pp, DMOD, nullptr};
#ifndef NO_GP
          pg8::gemm_phase<pg8::EpiZ, pg8::StaticOrder, true, true>(lds, g, S, E);
#endif
 }
        grid.sync();
        LruLayer LP{P.lru_conv_w + (size_t)l * 2 * 4 * 512, P.lru_conv_b + l * 1024, P.lru_b_a + l * 1024, P.lru_b_i + l * 1024, P.lru_L + l * 1024, (const bf16*)(ws + WS_WL) + (size_t)l * 16 * 16384};
#ifndef NO_LRU0
        for (int it = blockIdx.x; it < NCHUNK * 4; it += G) lru_item<0>(lds, it, z, mix, LP, agg, tid);
#endif
        grid.sync();
        attn_build_tab(lds, P.rel_bias, tid);
        __syncthreads();
#ifndef NO_ATTN
        for (int it = blockIdx.x; it < NCHUNK * 4; it += G) attn_item(lds, it, z, mix, P.attn_sink + l * 8, tid);
#endif
#ifndef NO_LRU1
        for (int it = blockIdx.x; it < NCHUNK * 4; it += G) lru_item<1>(lds, it, z, mix, LP, agg, tid);
#endif
#ifndef NO_CONV
        conv_phase(z, mix, P.conv_w + (size_t)l * 3 * 512, G, tid);
#endif
        grid.sync();
        { pg8::Gemm g{mix, (const bf16*)(ws + WS_WOUT) + (size_t)l * DMOD * DMOD, MTOK, DMOD, DMOD}; pg8::StaticOrder S; S.init(MTOK, DMOD, G, (int)blockIdx.x);
          pg8::EpiRes E{l == 0 ? P.x_prompt : P.out, l == 0 ? P.x_sample : P.out + (size_t)16384 * DMOD, P.out, hbB, ssq + (size_t)(2 * l + 1) * MTOK};
#ifndef NO_GC
          pg8::gemm_phase<pg8::EpiRes, pg8::StaticOrder, true, true>(lds, g, S, E);
#endif
 }
        grid.sync();
        { pg8::Gemm g{hbB, (const bf16*)(ws + WS_WGATE) + (size_t)l * DMOD * DMOD, MTOK, DMOD, DMOD}; pg8::StaticOrder S; S.init(MTOK, DMOD, G, (int)blockIdx.x);
          pg8::EpiGate E{ssq + (size_t)(2 * l + 1) * MTOK, P.out, pp, hbA, ssq + (size_t)(2 * l + 2) * MTOK};
#ifndef NO_GD
          pg8::gemm_phase<pg8::EpiGate, pg8::StaticOrder, true, true>(lds, g, S, E);
#endif
 }
        grid.sync();
    }
    { const int lane = tid & 63, gw = blockIdx.x * NWAVES + (tid >> 6), NGW = G * NWAVES; const float* sf = ssq + (size_t)4 * MTOK;
      for (int row = gw; row < MTOK; row += NGW) { const float rs = rsqrtf(sf[row] * (1.f / DMOD) + 1e-6f); float* orow = P.out + (size_t)row * DMOD;
#pragma unroll
          for (int j = 0; j < 8; ++j) { const int cidx = 4 * lane + 256 * j; f32x4 v = *(const f32x4*)(orow + cidx); const f32x4 gv = *(const f32x4*)(P.final_norm + cidx);
              v[0] *= rs * gv[0]; v[1] *= rs * gv[1]; v[2] *= rs * gv[2]; v[3] *= rs * gv[3]; *(f32x4*)(orow + cidx) = v; } } }
}

extern "C" void kernel_launch(void* const* d_in, const int* in_sizes, int n_in, void* d_out, int out_size, void* d_ws, size_t ws_size, hipStream_t stream) {
    static int grid_blocks = 0;
    if (!grid_blocks) {
        if (n_in != 21 || ws_size < WS_END) { fprintf(stderr, "kernel_launch: unexpected n_in %d / ws_size %zu\n", n_in, ws_size); grid_blocks = -1; return; }
        int dev = 0, cus = 0, per_cu = 0;
        (void)hipGetDevice(&dev);
        (void)hipDeviceGetAttribute(&cus, hipDeviceAttributeMultiprocessorCount, dev);
        (void)hipFuncSetAttribute((const void*)fwd_megakernel, hipFuncAttributeMaxDynamicSharedMemorySize, LDS_BYTES);
        (void)hipOccupancyMaxActiveBlocksPerMultiprocessor(&per_cu, (const void*)fwd_megakernel, NTHR, LDS_BYTES);
        if (per_cu < 1) { fprintf(stderr, "kernel_launch: occupancy query says %d blocks/CU\n", per_cu); per_cu = 1; }
        grid_blocks = cus;
    }
    if (grid_blocks < 0) return;
    Params p{};
    const float** pf = (const float**)&p;
    for (int i = 0; i < 21; ++i) pf[i] = (const float*)d_in[i];
    p.out = (float*)d_out; p.ws = (unsigned char*)d_ws;
    void* args[] = {&p};
    hipError_t e = hipLaunchCooperativeKernel((void*)fwd_megakernel, dim3(grid_blocks), dim3(NTHR), args, LDS_BYTES, stream);
    if (e != hipSuccess) fprintf(stderr, "cooperative launch failed: %s (grid %d)\n", hipGetErrorString(e), grid_blocks);
}
```

```cpp
#include <hip/hip_runtime.h>
#include <hip/hip_cooperative_groups.h>
#include <cstdio>
#include <cstdint>
namespace cg = cooperative_groups;
namespace pg8 {
#define PG8_LAS __attribute__((address_space(3)))
typedef unsigned short bf16_t;
typedef short bf16x8 __attribute__((ext_vector_type(8)));
typedef float f32x4 __attribute__((ext_vector_type(4)));
typedef unsigned u32x4 __attribute__((ext_vector_type(4)));
constexpr int BM = 256, BK = 64, HALF = 128, HTB = HALF * BK * 2  , STAGE_BYTES = 8 * HTB, NXCD = 8, WGM = 8;

__host__ __device__ __forceinline__ int lds_byte(int r, int c) { const int st = (r >> 4) * 2 + (c >> 5), rr = r & 15, cc = c & 31, ob = rr * 64 + cc * 2; return st * 1024 + (ob ^ (((ob >> 9) & 1) << 5)); }
__host__ __device__ __forceinline__ void stage_rc(int b, int& R, int& C) { const int st = b / 1024, sb = b % 1024, swz = sb ^ (((sb >> 9) & 1) << 5); R = (st >> 1) * 16 + swz / 64; C = (st & 1) * 32 + (swz % 64) / 2; }
__host__ __device__ __forceinline__ int perm32(int rho) { const int n = rho >> 4, i = rho & 15; return 8 * (i >> 2) + 4 * n + (i & 3); }

struct Unit { int pm, pn; };
struct Gemm { const bf16_t* A; const bf16_t* Bt; int M, N, K; };

struct StaticOrder {
    int nM, nN, nwg, G, c;
    __host__ __device__ void init(int M, int N, int G_, int c_) { nM = M / BM; nN = N / BM; nwg = nM * nN; G = G_; c = c_; }
    __host__ __device__ bool next(int i, Unit& u) const {
        const long L = (long)i * G + c; if (L >= nwg) return false;
        int wgid = (int)L; { const int q = nwg / NXCD, r = nwg % NXCD, xcd = wgid % NXCD, off = wgid / NXCD; wgid = (xcd < r ? xcd * (q + 1) : r * (q + 1) + (xcd - r) * q) + off; }
        const int nig = WGM * nN, gid = wgid / nig, fm = gid * WGM, gsz = (nM - fm) < WGM ? (nM - fm) : WGM;
        u.pm = fm + ((wgid % nig) % gsz); u.pn = (wgid % nig) / gsz; return true;
    }
    __device__ __forceinline__ void a_ready(const Unit&) const {}
    __device__ __forceinline__ void done(const Unit&) const {}
};

__device__ __forceinline__ unsigned cvt_pk_bf16(float lo, float hi) { unsigned r; asm volatile("v_cvt_pk_bf16_f32 %0, %1, %2" : "=v"(r) : "v"(lo), "v"(hi)); return r; }
__device__ __forceinline__ float fast_sigmoid(float x) { return __builtin_amdgcn_rcpf(1.f + __expf(-x)); }
__device__ __forceinline__ float bf_lo(unsigned w) { return __builtin_bit_cast(float, w << 16); }
__device__ __forceinline__ float bf_hi(unsigned w) { return __builtin_bit_cast(float, w & 0xffff0000u); }
constexpr int DM = 2048;
constexpr float NEPS = 1e-6f;

struct EpiZ {
    static constexpr bool PERM = true, AFTER_DRAIN = false;
    bf16_t* O; int ldc; const float* ssq;
    __device__ __forceinline__ void operator()(const f32x4 (&acc)[2][2][4][2], const Unit& u, int wr, int wc, int fr, int fq) const {
        const int row0 = u.pm * BM + wr * 64 + fr, col0 = u.pn * BM + wc * 32 + 8 * fq;
#pragma unroll
        for (int ai = 0; ai < 2; ++ai)
#pragma unroll
            for (int m = 0; m < 4; ++m) { const int row = row0 + ai * HALF + m * 16;
                const float sc = ssq ? rsqrtf(ssq[row] * (1.f / DM) + NEPS) : 1.f;
                bf16_t* rowp = O + (size_t)row * ldc + col0;
#pragma unroll
                for (int bj = 0; bj < 2; ++bj) { const f32x4 v0 = acc[ai][bj][m][0] * sc, v1 = acc[ai][bj][m][1] * sc;
                    u32x4 w; w.x = cvt_pk_bf16(v0[0], v0[1]); w.y = cvt_pk_bf16(v0[2], v0[3]); w.z = cvt_pk_bf16(v1[0], v1[1]); w.w = cvt_pk_bf16(v1[2], v1[3]);
                    *(u32x4*)(rowp + bj * HALF) = w; } }
    }
};

struct EpiRes {
    static constexpr bool PERM = true, AFTER_DRAIN = false;
    const bf16_t* res; bf16_t* hb; float* ssq;
    __device__ __forceinline__ void operator()(const f32x4 (&acc)[2][2][4][2], const Unit& u, int wr, int wc, int fr, int fq) const {
        const int row0 = u.pm * BM + wr * 64 + fr, col0 = u.pn * BM + wc * 32 + 8 * fq;
#pragma unroll
        for (int ai = 0; ai < 2; ++ai)
#pragma unroll
            for (int m = 0; m < 4; ++m) { const int row = row0 + ai * HALF + m * 16;
                const bf16_t* sp = res + (size_t)row * DM + col0; bf16_t* hp = hb + (size_t)row * DM + col0; float s = 0.f;
#pragma unroll
                for (int bj = 0; bj < 2; ++bj) { const u32x4 rw = *(const u32x4*)(sp + bj * HALF);
                    f32x4 v0 = acc[ai][bj][m][0], v1 = acc[ai][bj][m][1];
                    v0[0] += bf_lo(rw.x); v0[1] += bf_hi(rw.x); v0[2] += bf_lo(rw.y); v0[3] += bf_hi(rw.y);
                    v1[0] += bf_lo(rw.z); v1[1] += bf_hi(rw.z); v1[2] += bf_lo(rw.w); v1[3] += bf_hi(rw.w);
                    u32x4 w; w.x = cvt_pk_bf16(v0[0], v0[1]); w.y = cvt_pk_bf16(v0[2], v0[3]); w.z = cvt_pk_bf16(v1[0], v1[1]); w.w = cvt_pk_bf16(v1[2], v1[3]);
                    *(u32x4*)(hp + bj * HALF) = w;
                    s += v0[0] * v0[0] + v0[1] * v0[1] + v0[2] * v0[2] + v0[3] * v0[3] + v1[0] * v1[0] + v1[1] * v1[1] + v1[2] * v1[2] + v1[3] * v1[3]; }
                s += __shfl_xor(s, 16); s += __shfl_xor(s, 32);
                if (fq == 0) atomicAdd(ssq + row, s); }
    }
};

struct EpiGate {
    static constexpr bool PERM = true, AFTER_DRAIN = false;
    const float* ssq_in; const bf16_t* res; const bf16_t* pp; bf16_t* hb; float* ssq_out;
    __device__ __forceinline__ void operator()(const f32x4 (&acc)[2][2][4][2], const Unit& u, int wr, int wc, int fr, int fq) const {
        const int row0 = u.pm * BM + wr * 64 + fr, col0 = u.pn * BM + wc * 32 + 8 * fq;
#pragma unroll
        for (int ai = 0; ai < 2; ++ai)
#pragma unroll
            for (int m = 0; m < 4; ++m) { const int row = row0 + ai * HALF + m * 16;
                const float sc = rsqrtf(ssq_in[row] * (1.f / DM) + NEPS);
                const bf16_t* sp = res + (size_t)row * DM + col0; bf16_t* hp = hb + (size_t)row * DM + col0; const bf16_t* ppp = pp + (size_t)row * DM + col0; float s = 0.f;
#pragma unroll
                for (int bj = 0; bj < 2; ++bj) { const u32x4 rw = *(const u32x4*)(sp + bj * HALF); const u32x4 pw = *(const u32x4*)(ppp + bj * HALF);
                    const f32x4 a0 = acc[ai][bj][m][0] * sc, a1 = acc[ai][bj][m][1] * sc;
                    f32x4 v0, v1;
                    v0[0] = bf_lo(rw.x) + fast_sigmoid(a0[0]) * bf_lo(pw.x); v0[1] = bf_hi(rw.x) + fast_sigmoid(a0[1]) * bf_hi(pw.x);
                    v0[2] = bf_lo(rw.y) + fast_sigmoid(a0[2]) * bf_lo(pw.y); v0[3] = bf_hi(rw.y) + fast_sigmoid(a0[3]) * bf_hi(pw.y);
                    v1[0] = bf_lo(rw.z) + fast_sigmoid(a1[0]) * bf_lo(pw.z); v1[1] = bf_hi(rw.z) + fast_sigmoid(a1[1]) * bf_hi(pw.z);
                    v1[2] = bf_lo(rw.w) + fast_sigmoid(a1[2]) * bf_lo(pw.w); v1[3] = bf_hi(rw.w) + fast_sigmoid(a1[3]) * bf_hi(pw.w);
                    u32x4 w; w.x = cvt_pk_bf16(v0[0], v0[1]); w.y = cvt_pk_bf16(v0[2], v0[3]); w.z = cvt_pk_bf16(v1[0], v1[1]); w.w = cvt_pk_bf16(v1[2], v1[3]);
                    *(u32x4*)(hp + bj * HALF) = w;
                    s += v0[0] * v0[0] + v0[1] * v0[1] + v0[2] * v0[2] + v0[3] * v0[3] + v1[0] * v1[0] + v1[1] * v1[1] + v1[2] * v1[2] + v1[3] * v1[3]; }
                s += __shfl_xor(s, 16); s += __shfl_xor(s, 32);
                if (fq == 0) atomicAdd(ssq_out + row, s); }
    }
};
template <class Epi, class Sched, bool ALIGN_EPI = false, bool SP2 = false>
__device__ __forceinline__ void gemm_phase(PG8_LAS unsigned char* lds, const Gemm g, const Sched& S, const Epi& E) {
    int tid_ = threadIdx.x; asm volatile("" : "+v"(tid_));
    const int tid = tid_, wid = __builtin_amdgcn_readfirstlane(tid >> 6), lane = tid & 63, wr = wid >> 2, wc = wid & 3, fr = lane & 15, fq = lane >> 4;
    int K_ = g.K; asm volatile("" : "+s"(K_));
    const int K = K_, nt = K / BK;
    unsigned voffA[2], voffB[2];
#pragma unroll
    for (int i = 0; i < 2; ++i) { int R, C; stage_rc(tid * 16 + i * 8192, R, C); const int Rb = Epi::PERM ? ((R & ~31) + perm32(R & 31)) : R;
        voffA[i] = (unsigned)(R * K + C) * 2u; voffB[i] = (unsigned)(Rb * K + C) * 2u; }
    const size_t kstep = (size_t)(BK * 2);
    const size_t hstep = (size_t)HALF * K * 2;
    const size_t tstep = 2 * hstep;
    const unsigned ldsw = (unsigned)wid * 1024u;
    const int aoff = lds_byte(wr * 64 + fr, fq * 8), boff = lds_byte(wc * 32 + fr, fq * 8);
#define PG8_SA(b, h) (((b) * 2 + (h)) * HTB)
#define PG8_SB(b, h) ((4 + (b) * 2 + (h)) * HTB)
#define PG8_STAGE(bufoff, gbase, voff) do { _Pragma("unroll") for (int _i = 0; _i < 2; ++_i) \
        __builtin_amdgcn_global_load_lds((const unsigned*)((const char*)(gbase) + (voff)[_i]), (PG8_LAS unsigned*)(lds + (bufoff) + ldsw + _i * 8192), 16, 0, 0); } while (0)
#define PG8_LDA(dst, b, h) do { _Pragma("unroll") for (int m = 0; m < 4; ++m) _Pragma("unroll") for (int k = 0; k < 2; ++k) dst[m][k] = *(const PG8_LAS bf16x8*)(lds + PG8_SA(b, h) + aoff + m * 2048 + k * 1024); } while (0)
#define PG8_LDB(dst, b, h) do { _Pragma("unroll") for (int n = 0; n < 2; ++n) _Pragma("unroll") for (int k = 0; k < 2; ++k) dst[n][k] = *(const PG8_LAS bf16x8*)(lds + PG8_SB(b, h) + boff + n * 2048 + k * 1024); } while (0)
#define PG8_MMA(ai, bj, At, Bt) do { __builtin_amdgcn_s_setprio(1); _Pragma("unroll") for (int m = 0; m < 4; ++m) _Pragma("unroll") for (int n = 0; n < 2; ++n) _Pragma("unroll") for (int k = 0; k < 2; ++k) \
        acc[ai][bj][m][n] = __builtin_amdgcn_mfma_f32_16x16x32_bf16(Bt[n][k], At[m][k], acc[ai][bj][m][n], 0, 0, 0); __builtin_amdgcn_s_setprio(0); } while (0)
#define PG8_WAIT_V(n) asm volatile("s_waitcnt vmcnt(" #n ")" ::: "memory")
#define PG8_WAIT_L(n) asm volatile("s_waitcnt lgkmcnt(" #n ")" ::: "memory")
#define PG8_BAR __builtin_amdgcn_s_barrier()
#define PG8_SCHED __builtin_amdgcn_sched_barrier(0)
    Unit cur, nxt; int ui = 0;
    if (!S.next(0, cur)) return;
    f32x4 acc[2][2][4][2];
#pragma unroll
    for (int a = 0; a < 2; ++a)
#pragma unroll
        for (int b = 0; b < 2; ++b)
#pragma unroll
            for (int m = 0; m < 4; ++m)
#pragma unroll
                for (int n = 0; n < 2; ++n) acc[a][b][m][n] = (f32x4){0.f, 0.f, 0.f, 0.f};
    bf16x8 At[4][2], B0[2][2], B1[2][2];
    const char* cA = (const char*)g.A + (size_t)cur.pm * tstep; const char* cB = (const char*)g.Bt + (size_t)cur.pn * tstep;
    S.a_ready(cur);
    if constexpr (SP2) {
        PG8_STAGE(PG8_SB(0, 0), cB, voffB); PG8_STAGE(PG8_SB(0, 1), cB + hstep, voffB); PG8_STAGE(PG8_SA(0, 0), cA, voffA); PG8_STAGE(PG8_SA(0, 1), cA + hstep, voffA);
        if (wr == 1) PG8_BAR;
        PG8_WAIT_V(2); PG8_BAR;
        PG8_STAGE(PG8_SB(1, 0), cB + kstep, voffB); PG8_STAGE(PG8_SA(1, 0), cA + kstep, voffA); PG8_STAGE(PG8_SB(1, 1), cB + hstep + kstep, voffB);
        PG8_WAIT_V(6); PG8_BAR;
    } else {
        PG8_STAGE(PG8_SB(0, 0), cB, voffB); PG8_STAGE(PG8_SA(0, 0), cA, voffA); PG8_STAGE(PG8_SB(0, 1), cB + hstep, voffB); PG8_STAGE(PG8_SA(0, 1), cA + hstep, voffA);
        if (wr == 1) PG8_BAR;
        PG8_WAIT_V(4); PG8_BAR;
        PG8_STAGE(PG8_SB(1, 0), cB + kstep, voffB); PG8_STAGE(PG8_SA(1, 0), cA + kstep, voffA); PG8_STAGE(PG8_SB(1, 1), cB + hstep + kstep, voffB);
        PG8_WAIT_V(6); PG8_BAR;
    }
    for (;;) {
        const bool has_next = S.next(ui + 1, nxt);
        const char* nA = has_next ? (const char*)g.A + (size_t)nxt.pm * tstep : cA; const char* nB = has_next ? (const char*)g.Bt + (size_t)nxt.pn * tstep : cB;
        for (int t = 0; t < nt; t += 2) {
            const bool last = (t == nt - 2);
            const char* a1 = cA + (size_t)(t + 1) * kstep;
            const char* a2 = last ? nA : cA + (size_t)(t + 2) * kstep; const char* b2 = last ? nB : cB + (size_t)(t + 2) * kstep;
            const char* a3 = a2 + kstep; const char* b3 = b2 + kstep;
            if (last && has_next) S.a_ready(nxt);
            if constexpr (SP2) {
            PG8_LDB(B0, 0, 0); PG8_LDB(B1, 0, 1); PG8_SCHED; PG8_LDA(At, 0, 0); PG8_STAGE(PG8_SA(1, 1), a1 + hstep, voffA);
            PG8_WAIT_V(8); PG8_WAIT_L(0); PG8_BAR; PG8_MMA(0, 0, At, B0); PG8_MMA(0, 1, At, B1); PG8_BAR; PG8_SCHED;
            PG8_LDA(At, 0, 1); PG8_STAGE(PG8_SB(0, 0), b2, voffB); PG8_STAGE(PG8_SB(0, 1), b2 + hstep, voffB); PG8_STAGE(PG8_SA(0, 0), a2, voffA);
            PG8_WAIT_V(8); PG8_WAIT_L(0); PG8_BAR; PG8_MMA(1, 0, At, B0); PG8_MMA(1, 1, At, B1); PG8_BAR; PG8_SCHED;
            PG8_LDB(B0, 1, 0); PG8_LDB(B1, 1, 1); PG8_SCHED; PG8_LDA(At, 1, 0); PG8_STAGE(PG8_SA(0, 1), a2 + hstep, voffA);
            PG8_WAIT_V(8); PG8_WAIT_L(0); PG8_BAR; PG8_MMA(0, 0, At, B0); PG8_MMA(0, 1, At, B1); PG8_BAR; PG8_SCHED;
            PG8_LDA(At, 1, 1); PG8_STAGE(PG8_SB(1, 0), b3, voffB); PG8_STAGE(PG8_SB(1, 1), b3 + hstep, voffB); PG8_STAGE(PG8_SA(1, 0), a3, voffA);
            PG8_WAIT_V(8); PG8_WAIT_L(0); PG8_BAR; PG8_MMA(1, 0, At, B0); PG8_MMA(1, 1, At, B1); PG8_BAR; PG8_SCHED;
            } else {
            PG8_LDB(B0, 0, 0); PG8_SCHED; PG8_LDA(At, 0, 0); PG8_STAGE(PG8_SA(1, 1), a1 + hstep, voffA);
            PG8_WAIT_L(8); PG8_BAR; PG8_WAIT_L(0); PG8_MMA(0, 0, At, B0); PG8_BAR; PG8_SCHED;
            PG8_LDB(B1, 0, 1); PG8_STAGE(PG8_SB(0, 0), b2, voffB);
            PG8_BAR; PG8_WAIT_L(0); PG8_MMA(0, 1, At, B1); PG8_BAR;
            PG8_LDA(At, 0, 1); PG8_STAGE(PG8_SA(0, 0), a2, voffA);
            PG8_BAR; PG8_WAIT_L(0); PG8_MMA(1, 0, At, B0); PG8_BAR; PG8_SCHED;
            PG8_STAGE(PG8_SB(0, 1), b2 + hstep, voffB);
            PG8_WAIT_V(6); PG8_BAR; PG8_MMA(1, 1, At, B1); PG8_BAR;
            PG8_LDB(B0, 1, 0); PG8_SCHED; PG8_LDA(At, 1, 0); PG8_STAGE(PG8_SA(0, 1), a2 + hstep, voffA);
            PG8_WAIT_L(8); PG8_BAR; PG8_WAIT_L(0); PG8_MMA(0, 0, At, B0); PG8_BAR; PG8_SCHED;
            PG8_LDB(B1, 1, 1); PG8_STAGE(PG8_SB(1, 0), b3, voffB);
            PG8_BAR; PG8_WAIT_L(0); PG8_MMA(0, 1, At, B1); PG8_BAR;
            PG8_LDA(At, 1, 1); PG8_STAGE(PG8_SA(1, 0), a3, voffA);
            PG8_BAR; PG8_WAIT_L(0); PG8_MMA(1, 0, At, B0); PG8_BAR; PG8_SCHED;
            PG8_STAGE(PG8_SB(1, 1), b3 + hstep, voffB);
            PG8_WAIT_V(6); PG8_BAR; PG8_MMA(1, 1, At, B1); PG8_BAR;
            }
        }
        if constexpr (ALIGN_EPI) { if (wr == 0) PG8_BAR; }
        if constexpr (!Epi::AFTER_DRAIN) { E(acc, cur, wr, wc, fr, fq); S.done(cur); }
        if (!has_next) break;
#pragma unroll
        for (int a = 0; a < 2; ++a)
#pragma unroll
            for (int b = 0; b < 2; ++b)
#pragma unroll
                for (int m = 0; m < 4; ++m)
#pragma unroll
                    for (int n = 0; n < 2; ++n) acc[a][b][m][n] = (f32x4){0.f, 0.f, 0.f, 0.f};
        cur = nxt; cA = nA; cB = nB; ++ui;
        if constexpr (ALIGN_EPI) { if (wr == 1) PG8_BAR; }
    }
    PG8_WAIT_V(0);
    if constexpr (!ALIGN_EPI) { if (wr == 0) PG8_BAR; }
    PG8_BAR;
    if constexpr (Epi::AFTER_DRAIN) { E.fused(acc, cur, wr, wc, fr, fq, lds, wid, lane); S.done(cur); }
#undef PG8_SA
#undef PG8_SB
#undef PG8_STAGE
#undef PG8_LDA
#undef PG8_LDB
#undef PG8_MMA
#undef PG8_WAIT_V
#undef PG8_WAIT_L
#undef PG8_BAR
#undef PG8_SCHED
}
}
#define LAS __attribute__((address_space(3)))
typedef unsigned short bf16;
typedef unsigned v4u __attribute__((ext_vector_type(4)));
typedef unsigned v2u __attribute__((ext_vector_type(2)));
typedef float v2f __attribute__((ext_vector_type(2)));
typedef float f32x4 __attribute__((ext_vector_type(4)));
typedef float f32x16 __attribute__((ext_vector_type(16)));
typedef short bf16x8 __attribute__((ext_vector_type(8)));
typedef short s16x4 __attribute__((ext_vector_type(4)));
constexpr int MTOK = 32768, DMOD = 2048, NZ = 5632, PLE = 256, NCHUNK = MTOK / 128;
constexpr int ZQ = 0, ZK = 1024, ZV = 1280, ZGA = 1536, ZCB = 2560, ZCC = 3072, ZCX = 3584, ZGC = 4096, ZXL = 4608, ZGL = 5120;
constexpr float LOG2E = 1.4426950408889634f;
constexpr int NWAVES = 8, NTHR = 512;
constexpr int LDS_BYTES = 147456;
constexpr size_t MiB = 1u << 20;
constexpr size_t WS_SSQ = 0;
constexpr size_t WS_AGG = 1 * MiB;
constexpr size_t WS_WL = 3 * MiB;
constexpr size_t WS_WPROJ = 4 * MiB;
constexpr size_t WS_WIN = 8 * MiB;
constexpr size_t WS_WOUT = 52 * MiB;
constexpr size_t WS_WGATE = 68 * MiB;
constexpr size_t WS_PB = 84 * MiB;
constexpr size_t WS_HBA = 116 * MiB;
constexpr size_t WS_HBB = 244 * MiB;
constexpr size_t WS_MIX = 372 * MiB;
constexpr size_t WS_PP = 500 * MiB;
constexpr size_t WS_Z = 628 * MiB;
constexpr size_t WS_END = 980 * MiB;

struct Params {
    const float *x_prompt, *x_sample, *p_prompt, *p_sample, *norm_mix, *w_in, *w_out, *rel_bias, *attn_sink, *conv_w, *lru_conv_w, *lru_conv_b,
                *lru_w_a, *lru_b_a, *lru_w_i, *lru_b_i, *lru_L, *ple_norm, *ple_w_gate, *ple_w_proj, *final_norm;
    float* out; unsigned char* ws;
};

__device__ __forceinline__ unsigned f2bf(float f) { unsigned u = __builtin_bit_cast(unsigned, f); return (u + 0x7fffu + ((u >> 16) & 1u)) >> 16; }
__device__ __forceinline__ unsigned pk2(float lo, float hi) { unsigned r; asm("v_cvt_pk_bf16_f32 %0, %1, %2" : "=v"(r) : "v"(lo), "v"(hi)); return r; }
__device__ __forceinline__ float bflo(unsigned w) { return __builtin_bit_cast(float, w << 16); }
__device__ __forceinline__ float bfhi(unsigned w) { return __builtin_bit_cast(float, w & 0xffff0000u); }
__device__ __forceinline__ float bf1(bf16 v) { return __builtin_bit_cast(float, (unsigned)v << 16); }
__device__ __forceinline__ float sigm(float x) { return __builtin_amdgcn_rcpf(1.f + __expf(-x)); }
__device__ __forceinline__ float silu(float x) { return x * sigm(x); }
__device__ __forceinline__ float wave_sum(float v) {
#pragma unroll
    for (int o = 1; o < 64; o <<= 1) v += __shfl_xor(v, o);
    return v;
}
__device__ __forceinline__ void seq_of_chunk(int c, int& s0, int& ns) { if (c < 128) { s0 = c & ~63; ns = 64; } else { s0 = c & ~15; ns = 16; } }

__device__ __forceinline__ void transpose_item(const float* W, int K, int N, bf16* WT, const float* kscale, LAS float* scr, int item, int lane) {
    const int nblk = N / 32, kb = item / nblk, nb = item % nblk, k0 = 64 * kb, n0 = 32 * nb;
#pragma unroll 8
    for (int i = 0; i < 32; ++i) { const int kk = 2 * i + (lane >> 5); float v = W[(size_t)(k0 + kk) * N + n0 + (lane & 31)]; if (kscale) v *= kscale[k0 + kk]; scr[kk * 33 + (lane & 31)] = v; }
    asm volatile("s_waitcnt lgkmcnt(0)" ::: "memory");
    const int c = lane & 7;
#pragma unroll
    for (int j = 0; j < 4; ++j) { const int n = (lane >> 3) + 8 * j; const LAS float* s = scr + (8 * c) * 33 + n;
        v4u o; o.x = pk2(s[0 * 33], s[1 * 33]); o.y = pk2(s[2 * 33], s[3 * 33]); o.z = pk2(s[4 * 33], s[5 * 33]); o.w = pk2(s[6 * 33], s[7 * 33]);
        *(v4u*)(WT + (size_t)(n0 + n) * K + k0 + 8 * c) = o; }
    asm volatile("s_waitcnt lgkmcnt(0)" ::: "memory");
}

__device__ __forceinline__ void p0_prologue(const Params& P, LAS unsigned char* lds, int tid, int G) {
    asm volatile("" : "+v"(tid));
    const int lane = tid & 63, wave = tid >> 6;
    const int gw = blockIdx.x * NWAVES + wave, NGW = G * NWAVES;
    const long gt = (long)blockIdx.x * NTHR + tid, NGT = (long)G * NTHR;
    unsigned char* ws = P.ws;
    { float* ssq = (float*)(ws + WS_SSQ); for (long i = gt; i < 4L * MTOK; i += NGT) ssq[MTOK + i] = 0.f; }
    LAS float* scr = (LAS float*)(lds + wave * 16384);
    constexpr int I_IN = (DMOD / 64) * (NZ / 32), I_SQ = (DMOD / 64) * (DMOD / 32), I_PR = (PLE / 64) * (DMOD / 32), I_L1 = (128 / 64) * (128 / 32), I_L = 16 * I_L1;
    constexpr int I_LAYER = I_IN + 2 * I_SQ + I_PR + I_L;
    for (int it = gw; it < 2 * I_LAYER; it += NGW) {
        const int l = it / I_LAYER; int r = it % I_LAYER;
        if (r < I_IN) { transpose_item(P.w_in + (size_t)l * DMOD * NZ, DMOD, NZ, (bf16*)(ws + WS_WIN) + (size_t)l * NZ * DMOD, P.norm_mix + l * DMOD, scr, r, lane); continue; } r -= I_IN;
        if (r < I_SQ) { transpose_item(P.w_out + (size_t)l * DMOD * DMOD, DMOD, DMOD, (bf16*)(ws + WS_WOUT) + (size_t)l * DMOD * DMOD, nullptr, scr, r, lane); continue; } r -= I_SQ;
        if (r < I_SQ) { transpose_item(P.ple_w_gate + (size_t)l * DMOD * DMOD, DMOD, DMOD, (bf16*)(ws + WS_WGATE) + (size_t)l * DMOD * DMOD, P.ple_norm + l * DMOD, scr, r, lane); continue; } r -= I_SQ;
        if (r < I_PR) { transpose_item(P.ple_w_proj + (size_t)l * PLE * DMOD, PLE, DMOD, (bf16*)(ws + WS_WPROJ) + (size_t)l * DMOD * PLE, nullptr, scr, r, lane); continue; } r -= I_PR;
        { const int mat = r / I_L1, sub = r % I_L1;
          const int dir = mat >> 3, which = (mat >> 2) & 1, h = mat & 3;
          const float* src = (which ? P.lru_w_i : P.lru_w_a) + ((size_t)((l * 2 + dir) * 4 + h)) * 128 * 128;
          bf16* dst = (bf16*)(ws + WS_WL) + ((size_t)(((l * 2 + dir) * 2 + which) * 4 + h)) * 128 * 128;
          transpose_item(src, 128, 128, dst, nullptr, scr, sub, lane); }
    }
    { bf16* hbA = (bf16*)(ws + WS_HBA); float* ssq = (float*)(ws + WS_SSQ);
      for (int row = gw; row < MTOK; row += NGW) {
          const float* xr = (row < 16384 ? P.x_prompt + (size_t)row * DMOD : P.x_sample + (size_t)(row - 16384) * DMOD);
          float s = 0.f;
#pragma unroll
          for (int j = 0; j < 8; ++j) { const f32x4 v = *(const f32x4*)(xr + 4 * lane + 256 * j); s += v[0] * v[0] + v[1] * v[1] + v[2] * v[2] + v[3] * v[3];
              v2u o; o.x = pk2(v[0], v[1]); o.y = pk2(v[2], v[3]); *(v2u*)(hbA + (size_t)row * DMOD + 4 * lane + 256 * j) = o; }
          s = wave_sum(s); if (lane == 0) ssq[row] = s; } }
    { bf16* pb = (bf16*)(ws + WS_PB);
      for (long i = gt; i < 2L * MTOK * PLE / 4; i += NGT) { const long e = i * 4; const int l = (int)(e / ((long)MTOK * PLE)); const long r = e % ((long)MTOK * PLE);
          const float* src = (r < 16384L * PLE) ? P.p_prompt + (size_t)l * 16384 * PLE + r : P.p_sample + (size_t)l * 16384 * PLE + (r - 16384L * PLE);
          const f32x4 v = *(const f32x4*)src; v2u o; o.x = pk2(v[0], v[1]); o.y = pk2(v[2], v[3]); *(v2u*)(pb + e) = o; } }
}

__device__ __forceinline__ int t5_bucket(int rel) {
    const int n = rel < 0 ? -rel : rel;
    int b = n < 8 ? n : 8 + (n >= 12) + (n >= 16) + (n >= 23) + (n >= 32) + (n >= 46) + (n >= 64) + (n >= 91);
    return b + (rel > 0 ? 16 : 0);
}
constexpr int AT_KP = 272, AT_VP = 320, AT_KB = 64 * AT_KP, AT_VB = 64 * AT_VP, AT_V0 = 2 * AT_KB, AT_TAB = AT_V0 + 2 * AT_VB, AT_TW = 384;

__device__ __forceinline__ void attn_build_tab(LAS unsigned char* lds, const float* rel_bias, int tid) {
    asm volatile("" : "+v"(tid));
    LAS float* tab = (LAS float*)(lds + AT_TAB);
    for (int i = tid; i < 8 * AT_TW; i += NTHR) { const int hd = i / AT_TW, rel = i % AT_TW - 192;
        tab[i] = (rel >= -128 && rel <= 128) ? rel_bias[t5_bucket(rel) * 8 + hd] * LOG2E : -1.0e30f; }
}

__device__ __forceinline__ void attn_item(LAS unsigned char* lds, int item, const bf16* z, bf16* mix, const float* sink, int tid) {
    asm volatile("" : "+v"(tid));
    const int c = item >> 2, kvh = (item >> 1) & 1, qhalf = item & 1;
    int s0, ns; seq_of_chunk(c, s0, ns);
    const int w = tid >> 6, lane = tid & 63, ql = lane & 31, h = lane >> 5;
    const int head = kvh * 4 + (w >> 1);
    const int tb = c * 128, tq = tb + qhalf * 64 + (w & 1) * 32 + ql;
    const int seq_lo = s0 * 128, seq_hi = (s0 + ns) * 128, kwin0 = tb - 128 + qhalf * 64;
    int j_lo = 0, j_hi = 4;
    while (kwin0 + 64 * j_lo < seq_lo) ++j_lo;
    while (kwin0 + 64 * j_hi + 64 > seq_hi) --j_hi;
    bf16x8 qf[8];
    { const bf16* qp = z + (size_t)tq * NZ + ZQ + head * 128 + 8 * h;
#pragma unroll
      for (int ks = 0; ks < 8; ++ks) qf[ks] = *(const bf16x8*)(qp + 16 * ks); }
    float m = sink[head] * LOG2E, lsum = (h == 0) ? 1.f : 0.f;
    f32x16 O[4];
#pragma unroll
    for (int dt = 0; dt < 4; ++dt)
#pragma unroll
        for (int i = 0; i < 16; ++i) O[dt][i] = 0.f;
    const LAS float* tabh = (const LAS float*)(lds + AT_TAB) + head * AT_TW;
    const float c1 = 0.08838834764831845f * LOG2E;
    v4u stg[4];
    const int pkey = tid >> 4, pc = tid & 15;
    auto prefetch = [&](int j) {
        const bf16* base = z + (size_t)(kwin0 + 64 * j + pkey) * NZ + kvh * 128 + pc * 8;
        stg[0] = *(const v4u*)(base + ZK); stg[1] = *(const v4u*)(base + ZK + (size_t)32 * NZ);
        stg[2] = *(const v4u*)(base + ZV); stg[3] = *(const v4u*)(base + ZV + (size_t)32 * NZ);
    };
    prefetch(j_lo);
    const int g4 = lane >> 4, q4 = (lane & 15) >> 2, p4 = lane & 3;
    for (int j = j_lo; j <= j_hi; ++j) {
        LAS unsigned char* Kb = lds + (j & 1) * AT_KB; LAS unsigned char* Vb = lds + AT_V0 + (j & 1) * AT_VB;
        *(LAS v4u*)(Kb + pkey * AT_KP + pc * 16) = stg[0]; *(LAS v4u*)(Kb + (pkey + 32) * AT_KP + pc * 16) = stg[1];
        *(LAS v4u*)(Vb + pkey * AT_VP + pc * 16) = stg[2]; *(LAS v4u*)(Vb + (pkey + 32) * AT_VP + pc * 16) = stg[3];
        if (j < j_hi) prefetch(j + 1);
        __syncthreads();
        f32x16 s[2];
#pragma unroll
        for (int kt = 0; kt < 2; ++kt) {
#pragma unroll
            for (int i = 0; i < 16; ++i) s[kt][i] = 0.f;
#pragma unroll
            for (int ks = 0; ks < 8; ++ks) { const bf16x8 kf = *(const LAS bf16x8*)(Kb + (kt * 32 + ql) * AT_KP + (16 * ks + 8 * h) * 2);
                s[kt] = __builtin_amdgcn_mfma_f32_32x32x16_bf16(kf, qf[ks], s[kt], 0, 0, 0); }
        }
        float mx = -3.0e38f;
#pragma unroll
        for (int kt = 0; kt < 2; ++kt) { const LAS float* tp = tabh + ((kwin0 + 64 * j + 32 * kt + 4 * h) - tq + 192);
#pragma unroll
            for (int i = 0; i < 16; ++i) { const float t = s[kt][i] * c1 + tp[(i & 3) + 8 * (i >> 2)]; s[kt][i] = t; mx = fmaxf(mx, t); } }
        mx = fmaxf(mx, __shfl_xor(mx, 32));
        const float mn = fmaxf(m, mx), alpha = __builtin_amdgcn_exp2f(m - mn); m = mn;
        float ps = 0.f;
#pragma unroll
        for (int kt = 0; kt < 2; ++kt)
#pragma unroll
            for (int i = 0; i < 16; ++i) { const float p = __builtin_amdgcn_exp2f(s[kt][i] - mn); s[kt][i] = p; ps += p; }
        lsum = lsum * alpha + ps;
        if (__any(alpha != 1.f)) {
#pragma unroll
            for (int dt = 0; dt < 4; ++dt)
#pragma unroll
                for (int i = 0; i < 16; ++i) O[dt][i] *= alpha;
        }
#pragma unroll
        for (int kt = 0; kt < 2; ++kt)
#pragma unroll
            for (int s2 = 0; s2 < 2; ++s2) {
                v4u pw; pw.x = pk2(s[kt][8 * s2 + 0], s[kt][8 * s2 + 1]); pw.y = pk2(s[kt][8 * s2 + 2], s[kt][8 * s2 + 3]);
                pw.z = pk2(s[kt][8 * s2 + 4], s[kt][8 * s2 + 5]); pw.w = pk2(s[kt][8 * s2 + 6], s[kt][8 * s2 + 7]);
                const bf16x8 pf = __builtin_bit_cast(bf16x8, pw);
                const LAS unsigned char* vrow = Vb + (32 * kt + 16 * s2 + 4 * h + q4) * AT_VP + (16 * (g4 & 1) + 4 * p4) * 2;
#pragma unroll
                for (int dt = 0; dt < 4; ++dt) {
                    const s16x4 lo = __builtin_amdgcn_ds_read_tr16_b64_v4i16((LAS s16x4*)(vrow + dt * 64));
                    const s16x4 hi = __builtin_amdgcn_ds_read_tr16_b64_v4i16((LAS s16x4*)(vrow + dt * 64 + 8 * AT_VP));
                    const bf16x8 vf = __builtin_shufflevector(lo, hi, 0, 1, 2, 3, 4, 5, 6, 7);
                    O[dt] = __builtin_amdgcn_mfma_f32_32x32x16_bf16(vf, pf, O[dt], 0, 0, 0);
                }
            }
    }
    const float ltot = lsum + __shfl_xor(lsum, 32), inv = 1.f / ltot;
    const bf16* gp = z + (size_t)tq * NZ + ZGA + head * 128 + 4 * h; bf16* op = mix + (size_t)tq * DMOD + head * 128 + 4 * h;
#pragma unroll
    for (int dt = 0; dt < 4; ++dt)
#pragma unroll
        for (int rg = 0; rg < 4; ++rg) { const v2u gw = *(const v2u*)(gp + 32 * dt + 8 * rg);
            const float o0 = O[dt][4 * rg + 0] * inv * silu(bflo(gw.x)), o1 = O[dt][4 * rg + 1] * inv * silu(bfhi(gw.x));
            const float o2 = O[dt][4 * rg + 2] * inv * silu(bflo(gw.y)), o3 = O[dt][4 * rg + 3] * inv * silu(bfhi(gw.y));
            v2u ow; ow.x = pk2(o0, o1); ow.y = pk2(o2, o3); *(v2u*)(op + 32 * dt + 8 * rg) = ow; }
    __syncthreads();
}

__device__ __forceinline__ void conv_phase(const bf16* z, bf16* mix, const float* cw  , int G, int tid) {
    asm volatile("" : "+v"(tid));
    const long NW = (long)MTOK * 64;
    for (long i = (long)blockIdx.x * NTHR + tid; i < NW; i += (long)G * NTHR) {
        const int t = (int)(i >> 6), cg8 = (int)(i & 63) * 8;
        int s0, ns; seq_of_chunk(t >> 7, s0, ns);
        const bool hasp = t > s0 * 128, hasn = t + 1 < (s0 + ns) * 128;
        const bf16* zr = z + (size_t)t * NZ;
        const v4u cb = *(const v4u*)(zr + ZCB + cg8), gc = *(const v4u*)(zr + ZGC + cg8);
        const v4u c1 = *(const v4u*)(zr + ZCC + cg8), x1 = *(const v4u*)(zr + ZCX + cg8);
        v4u c0 = {0, 0, 0, 0}, x0 = {0, 0, 0, 0}, c2 = {0, 0, 0, 0}, x2 = {0, 0, 0, 0};
        if (hasp) { c0 = *(const v4u*)(zr - NZ + ZCC + cg8); x0 = *(const v4u*)(zr - NZ + ZCX + cg8); }
        if (hasn) { c2 = *(const v4u*)(zr + NZ + ZCC + cg8); x2 = *(const v4u*)(zr + NZ + ZCX + cg8); }
        float o[8];
#pragma unroll
        for (int e = 0; e < 4; ++e) {
#pragma unroll
            for (int hh = 0; hh < 2; ++hh) { const int ch = cg8 + 2 * e + hh;
                const float a0 = hh ? bfhi(c0[e]) * bfhi(x0[e]) : bflo(c0[e]) * bflo(x0[e]);
                const float a1 = hh ? bfhi(c1[e]) * bfhi(x1[e]) : bflo(c1[e]) * bflo(x1[e]);
                const float a2 = hh ? bfhi(c2[e]) * bfhi(x2[e]) : bflo(c2[e]) * bflo(x2[e]);
                const float cv = cw[ch] * a0 + cw[512 + ch] * a1 + cw[1024 + ch] * a2;
                const float b = hh ? bfhi(cb[e]) : bflo(cb[e]), g = hh ? bfhi(gc[e]) : bflo(gc[e]);
                o[2 * e + hh] = b * cv * silu(g); } }
        v4u ow; ow.x = pk2(o[0], o[1]); ow.y = pk2(o[2], o[3]); ow.z = pk2(o[4], o[5]); ow.w = pk2(o[6], o[7]);
        *(v4u*)(mix + (size_t)t * DMOD + 1024 + cg8) = ow;
    }
}

constexpr int LR_XC = 0, LR_XCP = 272, LR_PB = 128 * LR_XCP, LR_Y = 2 * 128 * LR_XCP, LR_YP = 132;
struct LruLayer { const float *cw, *cb, *ba, *bi, *L; const bf16* WL; };
__device__ __forceinline__ void lru_heavy(LAS unsigned char* lds, int item, const bf16* z, const LruLayer& LP, float* agg, bf16* LL, bf16* PFB  , int tid) {
    asm volatile("" : "+v"(tid));
    const int c = item >> 2, hh = item & 3;
    int s0, ns; seq_of_chunk(c, s0, ns);
    const int w = tid >> 6, lane = tid & 63, tb = c * 128, seq_lo = s0 * 128, seq_hi = (s0 + ns) * 128;
    const int chl = 16 * w + (lane & 15), chg = hh * 128 + chl, q = lane >> 4;
    LAS float* Y = (LAS float*)(lds + LR_Y);
#pragma unroll 1
    for (int dir = 0; dir < 2; ++dir) {
        for (int p = tid; p < 128 * 16; p += NTHR) { const int t = p >> 4, pc = p & 15; const int tok0 = tb + t + (dir ? 0 : -3);
            const float* cb = LP.cb + dir * 512 + hh * 128 + pc * 8;
            f32x4 a0 = *(const f32x4*)cb, a1 = *(const f32x4*)(cb + 4);
#pragma unroll
            for (int k = 0; k < 4; ++k) { const int tok = tok0 + k; v4u xv = {0, 0, 0, 0};
                if (tok >= seq_lo && tok < seq_hi) xv = *(const v4u*)(z + (size_t)tok * NZ + ZXL + hh * 128 + pc * 8);
                const float* wk = LP.cw + (dir * 4 + k) * 512 + hh * 128 + pc * 8; const f32x4 w0 = *(const f32x4*)wk, w1 = *(const f32x4*)(wk + 4);
                a0[0] += w0[0] * bflo(xv[0]); a0[1] += w0[1] * bfhi(xv[0]); a0[2] += w0[2] * bflo(xv[1]); a0[3] += w0[3] * bfhi(xv[1]);
                a1[0] += w1[0] * bflo(xv[2]); a1[1] += w1[1] * bfhi(xv[2]); a1[2] += w1[2] * bflo(xv[3]); a1[3] += w1[3] * bfhi(xv[3]); }
            v4u o; o.x = pk2(a0[0], a0[1]); o.y = pk2(a0[2], a0[3]); o.z = pk2(a1[0], a1[1]); o.w = pk2(a1[2], a1[3]);
            const int s = dir ? 127 - t : t;
            *(LAS v4u*)(lds + LR_XC + s * LR_XCP + pc * 16) = o; }
        __syncthreads();
        f32x4 ar[8], ai[8];
#pragma unroll
        for (int mt = 0; mt < 8; ++mt) { ar[mt] = (f32x4){0.f, 0.f, 0.f, 0.f}; ai[mt] = (f32x4){0.f, 0.f, 0.f, 0.f}; }
        { const bf16* wa = LP.WL + ((size_t)((dir * 2 + 0) * 4 + hh)) * 16384 + (size_t)chl * 128 + 8 * q;
          const bf16* wi = LP.WL + ((size_t)((dir * 2 + 1) * 4 + hh)) * 16384 + (size_t)chl * 128 + 8 * q;
#pragma unroll
          for (int ks = 0; ks < 4; ++ks) { const bf16x8 bA = *(const bf16x8*)(wa + 32 * ks), bI = *(const bf16x8*)(wi + 32 * ks);
#pragma unroll
              for (int mt = 0; mt < 8; ++mt) { const bf16x8 af = *(const LAS bf16x8*)(lds + LR_XC + (16 * mt + (lane & 15)) * LR_XCP + (32 * ks + 8 * q) * 2);
                  ar[mt] = __builtin_amdgcn_mfma_f32_16x16x32_bf16(af, bA, ar[mt], 0, 0, 0);
                  ai[mt] = __builtin_amdgcn_mfma_f32_16x16x32_bf16(af, bI, ai[mt], 0, 0, 0); } } }
        const float b_a = LP.ba[dir * 512 + chg], b_i = LP.bi[dir * 512 + chg];
        const float c8 = 8.f * LOG2E * log1pf(__expf(-LP.L[dir * 512 + chg]));
        float Hrun = 0.f, Arun = 1.f;
#pragma unroll
        for (int mt = 0; mt < 8; ++mt) {
            float a[4], u[4];
#pragma unroll
            for (int r = 0; r < 4; ++r) { const int s = 16 * mt + 4 * q + r;
                const float er = __builtin_amdgcn_exp2f(-LOG2E * (ar[mt][r] + b_a)), ei = __builtin_amdgcn_exp2f(-LOG2E * (ai[mt][r] + b_i));
                const float dr = 1.f + er, di = 1.f + ei, R = __builtin_amdgcn_rcpf(dr * di);
                const float rr = R * di, ii = R * dr;
                const float av = __builtin_amdgcn_exp2f(-c8 * rr);
                const float xcv = bf1(*(const LAS bf16*)(lds + LR_XC + s * LR_XCP + chl * 2));
                a[r] = av; u[r] = __builtin_amdgcn_sqrtf(fmaxf(1.f - av * av, 0.f)) * ii * xcv; }
            float A4 = a[0] * a[1] * a[2] * a[3];
            float B4 = ((u[0] * a[1] + u[1]) * a[2] + u[2]) * a[3] + u[3];
            { const float Ap = __shfl_up(A4, 16), Bp = __shfl_up(B4, 16); if (q >= 1) { B4 = A4 * Bp + B4; A4 = A4 * Ap; } }
            { const float Ap = __shfl_up(A4, 32), Bp = __shfl_up(B4, 32); if (q >= 2) { B4 = A4 * Bp + B4; A4 = A4 * Ap; } }
            float Ae = __shfl_up(A4, 16), Be = __shfl_up(B4, 16); if (q == 0) { Ae = 1.f; Be = 0.f; }
            const float At = __shfl(A4, 48 + (lane & 15)), Bt = __shfl(B4, 48 + (lane & 15));
            float hcur = Ae * Hrun + Be, pcur = Arun * Ae;
#pragma unroll
            for (int r = 0; r < 4; ++r) { hcur = a[r] * hcur + u[r]; pcur *= a[r]; const int s = 16 * mt + 4 * q + r; const int t = dir ? 127 - s : s;
                if (dir == 0) Y[t * LR_YP + chl] = hcur; else Y[t * LR_YP + chl] += hcur;
                *(LAS bf16*)(lds + LR_PB + t * LR_XCP + chl * 2) = (bf16)(pk2(pcur, 0.f) & 0xffffu); }
            Hrun = At * Hrun + Bt; Arun *= At;
        }
        if (q == 0) { float* ag = agg + (size_t)c * 2048 + (size_t)dir * 1024 + 2 * chg; ag[0] = Arun; ag[1] = Hrun; }
        __syncthreads();
        { bf16* dst = PFB + (size_t)dir * MTOK * 512;
          for (int p = tid; p < 128 * 16; p += NTHR) { const int t = p >> 4, pc = p & 15;
              *(v4u*)(dst + (size_t)(tb + t) * 512 + hh * 128 + pc * 8) = *(const LAS v4u*)(lds + LR_PB + t * LR_XCP + pc * 16); } }
    }
    for (int p = tid; p < 128 * 16; p += NTHR) { const int t = p >> 4, pc = p & 15; const LAS float* yr = Y + t * LR_YP + pc * 8;
        v4u ow; ow.x = pk2(yr[0], yr[1]); ow.y = pk2(yr[2], yr[3]); ow.z = pk2(yr[4], yr[5]); ow.w = pk2(yr[6], yr[7]);
        *(v4u*)(LL + (size_t)(tb + t) * 512 + hh * 128 + pc * 8) = ow; }
    __syncthreads();
}

__device__ __forceinline__ void lru_light(LAS unsigned char* lds, int c, const bf16* z, bf16* mix, const float* agg, const bf16* LL, const bf16* PFB, int tid) {
    asm volatile("" : "+v"(tid));
    int s0, ns; seq_of_chunk(c, s0, ns);
    LAS float* car = (LAS float*)lds;
    {
      const float* ag0 = agg + 2 * tid; const float* ag1 = agg + 1024 + 2 * tid;
      float H0 = 0.f, H1 = 0.f; int cc = s0, cd = s0 + ns - 1;
      for (; cc + 8 <= c; cc += 8) { v2f v[8];
#pragma unroll
          for (int k = 0; k < 8; ++k) v[k] = *(const v2f*)(ag0 + (size_t)(cc + k) * 2048);
#pragma unroll
          for (int k = 0; k < 8; ++k) H0 = v[k][0] * H0 + v[k][1]; }
      for (; cc < c; ++cc) { const v2f v = *(const v2f*)(ag0 + (size_t)cc * 2048); H0 = v[0] * H0 + v[1]; }
      for (; cd - 8 >= c; cd -= 8) { v2f v[8];
#pragma unroll
          for (int k = 0; k < 8; ++k) v[k] = *(const v2f*)(ag1 + (size_t)(cd - k) * 2048);
#pragma unroll
          for (int k = 0; k < 8; ++k) H1 = v[k][0] * H1 + v[k][1]; }
      for (; cd > c; --cd) { const v2f v = *(const v2f*)(ag1 + (size_t)cd * 2048); H1 = v[0] * H1 + v[1]; }
      car[tid] = H0; car[512 + tid] = H1; }
    __syncthreads();
    const int tb = c * 128;
    for (int p = tid; p < 128 * 64; p += NTHR) { const int t = p >> 6, c8 = (p & 63) * 8; const size_t ro = (size_t)(tb + t) * 512 + c8;
        const v4u lv = *(const v4u*)(LL + ro), fv = *(const v4u*)(PFB + ro), bv = *(const v4u*)(PFB + (size_t)MTOK * 512 + ro);
        const v4u gv = *(const v4u*)(z + (size_t)(tb + t) * NZ + ZGL + c8);
        float o[8];
#pragma unroll
        for (int e = 0; e < 4; ++e) {
            o[2 * e] = (bflo(lv[e]) + bflo(fv[e]) * car[c8 + 2 * e] + bflo(bv[e]) * car[512 + c8 + 2 * e]) * silu(bflo(gv[e]));
            o[2 * e + 1] = (bfhi(lv[e]) + bfhi(fv[e]) * car[c8 + 2 * e + 1] + bfhi(bv[e]) * car[512 + c8 + 2 * e + 1]) * silu(bfhi(gv[e])); }
        v4u ow; ow.x = pk2(o[0], o[1]); ow.y = pk2(o[2], o[3]); ow.z = pk2(o[4], o[5]); ow.w = pk2(o[6], o[7]);
        *(v4u*)(mix + (size_t)(tb + t) * DMOD + 1536 + c8) = ow; }
    __syncthreads();
}

#ifndef PH_LO
#define PH_LO 0
#endif
__global__ void __launch_bounds__(NTHR, 2) fwd_megakernel(Params P) {
    extern __shared__ __attribute__((aligned(16))) unsigned char lds_raw[];
    LAS unsigned char* lds = (LAS unsigned char*)lds_raw;
    cg::grid_group grid = cg::this_grid();
    const int tid = threadIdx.x, G = gridDim.x;
    unsigned char* ws = P.ws;
    float* ssq = (float*)(ws + WS_SSQ); float* agg = (float*)(ws + WS_AGG);
    bf16* hbA = (bf16*)(ws + WS_HBA); bf16* hbB = (bf16*)(ws + WS_HBB); bf16* mix = (bf16*)(ws + WS_MIX); bf16* pp = (bf16*)(ws + WS_PP); bf16* z = (bf16*)(ws + WS_Z);

#ifndef NO_P0
    p0_prologue(P, lds, tid, G);
#ifdef DUP_P0
    __syncthreads(); p0_prologue(P, lds, tid, G);
#endif
#endif
    grid.sync();
#pragma unroll 1
    for (int l = 0; l < 2; ++l) {
        { pg8::Gemm g{hbA, (const bf16*)(ws + WS_WIN) + (size_t)l * NZ * DMOD, MTOK, NZ, DMOD}; pg8::StaticOrder S; S.init(MTOK, NZ, G, (int)blockIdx.x);
          pg8::EpiZ E{z, NZ, ssq + (size_t)(2 * l) * MTOK};
          pg8::gemm_phase<pg8::EpiZ, pg8::StaticOrder, true, true>(lds, g, S, E);
#ifdef DUP_A
          pg8::gemm_phase<pg8::EpiZ, pg8::StaticOrder, true, true>(lds, g, S, E);
#endif
 }
        { pg8::Gemm g{(const bf16*)(ws + WS_PB) + (size_t)l * MTOK * PLE, (const bf16*)(ws + WS_WPROJ) + (size_t)l * DMOD * PLE, MTOK, DMOD, PLE}; pg8::StaticOrder S; S.init(MTOK, DMOD, G, (int)blockIdx.x);
          pg8::EpiZ E{pp, DMOD, nullptr};
#ifndef NO_GP
          pg8::gemm_phase<pg8::EpiZ, pg8::StaticOrder, true, true>(lds, g, S, E);
#endif
 }
        grid.sync();
#ifdef DUP_MIX
        for (int rep = 0; rep < 2; ++rep) {
#endif
        LruLayer LP{P.lru_conv_w + (size_t)l * 2 * 4 * 512, P.lru_conv_b + l * 1024, P.lru_b_a + l * 1024, P.lru_b_i + l * 1024, P.lru_L + l * 1024, (const bf16*)(ws + WS_WL) + (size_t)l * 16 * 16384};
        bf16* LL = hbB; bf16* PFB = hbB + (size_t)MTOK * 512;
        for (int it = blockIdx.x; it < NCHUNK * 4; it += G) lru_heavy(lds, it, z, LP, agg, LL, PFB, tid);
        grid.sync();
        attn_build_tab(lds, P.rel_bias, tid);
        __syncthreads();
#ifndef NO_ATTN
        for (int it = blockIdx.x; it < NCHUNK * 4; it += G) attn_item(lds, it, z, mix, P.attn_sink + l * 8, tid);
#ifdef DUP_ATTN
        for (int it = blockIdx.x; it < NCHUNK * 4; it += G) attn_item(lds, it, z, mix, P.attn_sink + l * 8, tid);
#endif
#endif
        for (int it = blockIdx.x; it < NCHUNK; it += G) lru_light(lds, it, z, mix, agg, LL, PFB, tid);
#ifndef NO_CONV
        conv_phase(z, mix, P.conv_w + (size_t)l * 3 * 512, G, tid);
#ifdef DUP_CONV
        conv_phase(z, mix, P.conv_w + (size_t)l * 3 * 512, G, tid);
#endif
#endif
        grid.sync();
#ifdef DUP_MIX
        }
#endif
        { pg8::Gemm g{mix, (const bf16*)(ws + WS_WOUT) + (size_t)l * DMOD * DMOD, MTOK, DMOD, DMOD}; pg8::StaticOrder S; S.init(MTOK, DMOD, G, (int)blockIdx.x);
          pg8::EpiRes E{hbA, hbB, ssq + (size_t)(2 * l + 1) * MTOK};
#ifndef NO_GC
          pg8::gemm_phase<pg8::EpiRes, pg8::StaticOrder, true, true>(lds, g, S, E);
#endif
 }
        grid.sync();
        { pg8::Gemm g{hbB, (const bf16*)(ws + WS_WGATE) + (size_t)l * DMOD * DMOD, MTOK, DMOD, DMOD}; pg8::StaticOrder S; S.init(MTOK, DMOD, G, (int)blockIdx.x);
          pg8::EpiGate E{ssq + (size_t)(2 * l + 1) * MTOK, hbB, pp, hbA, ssq + (size_t)(2 * l + 2) * MTOK};
#ifndef NO_GD
          pg8::gemm_phase<pg8::EpiGate, pg8::StaticOrder, true, true>(lds, g, S, E);
#endif
 }
        grid.sync();
    }
    { const int lane = tid & 63, gw = blockIdx.x * NWAVES + (tid >> 6), NGW = G * NWAVES; const float* sf = ssq + (size_t)4 * MTOK;
      for (int row = gw; row < MTOK; row += NGW) { const float rs = rsqrtf(sf[row] * (1.f / DMOD) + 1e-6f); float* orow = P.out + (size_t)row * DMOD; const bf16* hrow = hbA + (size_t)row * DMOD;
#pragma unroll
          for (int j = 0; j < 4; ++j) { const int cidx = 8 * lane + 512 * j; const v4u hv = *(const v4u*)(hrow + cidx); const f32x4 g0 = *(const f32x4*)(P.final_norm + cidx), g1 = *(const f32x4*)(P.final_norm + cidx + 4);
              f32x4 v0, v1; v0[0] = bflo(hv.x) * rs * g0[0]; v0[1] = bfhi(hv.x) * rs * g0[1]; v0[2] = bflo(hv.y) * rs * g0[2]; v0[3] = bfhi(hv.y) * rs * g0[3];
              v1[0] = bflo(hv.z) * rs * g1[0]; v1[1] = bfhi(hv.z) * rs * g1[1]; v1[2] = bflo(hv.w) * rs * g1[2]; v1[3] = bfhi(hv.w) * rs * g1[3];
              *(f32x4*)(orow + cidx) = v0; *(f32x4*)(orow + cidx + 4) = v1; } } }
}

extern "C" void kernel_launch(void* const* d_in, const int* in_sizes, int n_in, void* d_out, int out_size, void* d_ws, size_t ws_size, hipStream_t stream) {
    static int grid_blocks = 0;
    if (!grid_blocks) {
        if (n_in != 21 || ws_size < WS_END) { fprintf(stderr, "kernel_launch: unexpected n_in %d / ws_size %zu\n", n_in, ws_size); grid_blocks = -1; return; }
        int dev = 0, cus = 0, per_cu = 0;
        (void)hipGetDevice(&dev);
        (void)hipDeviceGetAttribute(&cus, hipDeviceAttributeMultiprocessorCount, dev);
        (void)hipFuncSetAttribute((const void*)fwd_megakernel, hipFuncAttributeMaxDynamicSharedMemorySize, LDS_BYTES);
        (void)hipOccupancyMaxActiveBlocksPerMultiprocessor(&per_cu, (const void*)fwd_megakernel, NTHR, LDS_BYTES);
        if (per_cu < 1) { fprintf(stderr, "kernel_launch: occupancy query says %d blocks/CU\n", per_cu); per_cu = 1; }
        grid_blocks = cus;
    }
    if (grid_blocks < 0) return;
    Params p{};
    const float** pf = (const float**)&p;
    for (int i = 0; i < 21; ++i) pf[i] = (const float*)d_in[i];
    p.out = (float*)d_out; p.ws = (unsigned char*)d_ws;
    void* args[] = {&p};
    hipError_t e = hipLaunchCooperativeKernel((void*)fwd_megakernel, dim3(grid_blocks), dim3(NTHR), args, LDS_BYTES, stream);
    if (e != hipSuccess) fprintf(stderr, "cooperative launch failed: %s (grid %d)\n", hipGetErrorString(e), grid_blocks);
}
```

```cpp
#include <hip/hip_runtime.h>
#include <hip/hip_cooperative_groups.h>
#include <cstdio>
#include <cstdint>
namespace cg = cooperative_groups;
namespace pg8 {
#define PG8_LAS __attribute__((address_space(3)))
typedef unsigned short bf16_t;
typedef short bf16x8 __attribute__((ext_vector_type(8)));
typedef float f32x4 __attribute__((ext_vector_type(4)));
typedef unsigned u32x4 __attribute__((ext_vector_type(4)));
constexpr int BM = 256, BK = 64, HALF = 128, HTB = HALF * BK * 2  , STAGE_BYTES = 8 * HTB, NXCD = 8, WGM = 8;

__host__ __device__ __forceinline__ int lds_byte(int r, int c) { const int st = (r >> 4) * 2 + (c >> 5), rr = r & 15, cc = c & 31, ob = rr * 64 + cc * 2; return st * 1024 + (ob ^ (((ob >> 9) & 1) << 5)); }
__host__ __device__ __forceinline__ void stage_rc(int b, int& R, int& C) { const int st = b / 1024, sb = b % 1024, swz = sb ^ (((sb >> 9) & 1) << 5); R = (st >> 1) * 16 + swz / 64; C = (st & 1) * 32 + (swz % 64) / 2; }
__host__ __device__ __forceinline__ int perm32(int rho) { const int n = rho >> 4, i = rho & 15; return 8 * (i >> 2) + 4 * n + (i & 3); }

struct Unit { int pm, pn; };
struct Gemm { const bf16_t* A; const bf16_t* Bt; int M, N, K; };

struct StaticOrder {
    int nM, nN, nwg, G, c;
    __host__ __device__ void init(int M, int N, int G_, int c_) { nM = M / BM; nN = N / BM; nwg = nM * nN; G = G_; c = c_; }
    __host__ __device__ bool next(int i, Unit& u) const {
        const long L = (long)i * G + c; if (L >= nwg) return false;
        int wgid = (int)L; { const int q = nwg / NXCD, r = nwg % NXCD, xcd = wgid % NXCD, off = wgid / NXCD; wgid = (xcd < r ? xcd * (q + 1) : r * (q + 1) + (xcd - r) * q) + off; }
        const int nig = WGM * nN, gid = wgid / nig, fm = gid * WGM, gsz = (nM - fm) < WGM ? (nM - fm) : WGM;
        u.pm = fm + ((wgid % nig) % gsz); u.pn = (wgid % nig) / gsz; return true;
    }
    __device__ __forceinline__ void a_ready(const Unit&) const {}
    __device__ __forceinline__ void done(const Unit&) const {}
};

__device__ __forceinline__ unsigned cvt_pk_bf16(float lo, float hi) { unsigned r; asm volatile("v_cvt_pk_bf16_f32 %0, %1, %2" : "=v"(r) : "v"(lo), "v"(hi)); return r; }
__device__ __forceinline__ float fast_sigmoid(float x) { return __builtin_amdgcn_rcpf(1.f + __expf(-x)); }
__device__ __forceinline__ float bf_lo(unsigned w) { return __builtin_bit_cast(float, w << 16); }
__device__ __forceinline__ float bf_hi(unsigned w) { return __builtin_bit_cast(float, w & 0xffff0000u); }
constexpr int DM = 2048;
constexpr float NEPS = 1e-6f;

struct EpiZ {
    static constexpr bool PERM = true, AFTER_DRAIN = false;
    bf16_t* O; int ldc; const float* ssq;
    __device__ __forceinline__ void operator()(const f32x4 (&acc)[2][2][4][2], const Unit& u, int wr, int wc, int fr, int fq) const {
        const int row0 = u.pm * BM + wr * 64 + fr, col0 = u.pn * BM + wc * 32 + 8 * fq;
#pragma unroll
        for (int ai = 0; ai < 2; ++ai)
#pragma unroll
            for (int m = 0; m < 4; ++m) { const int row = row0 + ai * HALF + m * 16;
                const float sc = ssq ? rsqrtf(ssq[row] * (1.f / DM) + NEPS) : 1.f;
                bf16_t* rowp = O + (size_t)row * ldc + col0;
#pragma unroll
                for (int bj = 0; bj < 2; ++bj) { const f32x4 v0 = acc[ai][bj][m][0] * sc, v1 = acc[ai][bj][m][1] * sc;
                    u32x4 w; w.x = cvt_pk_bf16(v0[0], v0[1]); w.y = cvt_pk_bf16(v0[2], v0[3]); w.z = cvt_pk_bf16(v1[0], v1[1]); w.w = cvt_pk_bf16(v1[2], v1[3]);
                    *(u32x4*)(rowp + bj * HALF) = w; } }
    }
};

struct EpiRes {
    static constexpr bool PERM = true, AFTER_DRAIN = false;
    const bf16_t* res; bf16_t* hb; float* ssq;
    __device__ __forceinline__ void operator()(const f32x4 (&acc)[2][2][4][2], const Unit& u, int wr, int wc, int fr, int fq) const {
        const int row0 = u.pm * BM + wr * 64 + fr, col0 = u.pn * BM + wc * 32 + 8 * fq;
#pragma unroll
        for (int ai = 0; ai < 2; ++ai)
#pragma unroll
            for (int m = 0; m < 4; ++m) { const int row = row0 + ai * HALF + m * 16;
                const bf16_t* sp = res + (size_t)row * DM + col0; bf16_t* hp = hb + (size_t)row * DM + col0; float s = 0.f;
#pragma unroll
                for (int bj = 0; bj < 2; ++bj) { const u32x4 rw = *(const u32x4*)(sp + bj * HALF);
                    f32x4 v0 = acc[ai][bj][m][0], v1 = acc[ai][bj][m][1];
                    v0[0] += bf_lo(rw.x); v0[1] += bf_hi(rw.x); v0[2] += bf_lo(rw.y); v0[3] += bf_hi(rw.y);
                    v1[0] += bf_lo(rw.z); v1[1] += bf_hi(rw.z); v1[2] += bf_lo(rw.w); v1[3] += bf_hi(rw.w);
                    u32x4 w; w.x = cvt_pk_bf16(v0[0], v0[1]); w.y = cvt_pk_bf16(v0[2], v0[3]); w.z = cvt_pk_bf16(v1[0], v1[1]); w.w = cvt_pk_bf16(v1[2], v1[3]);
                    *(u32x4*)(hp + bj * HALF) = w;
                    s += v0[0] * v0[0] + v0[1] * v0[1] + v0[2] * v0[2] + v0[3] * v0[3] + v1[0] * v1[0] + v1[1] * v1[1] + v1[2] * v1[2] + v1[3] * v1[3]; }
                s += __shfl_xor(s, 16); s += __shfl_xor(s, 32);
                if (fq == 0) atomicAdd(ssq + row, s); }
    }
};

struct EpiGate {
    static constexpr bool PERM = true, AFTER_DRAIN = false;
    const float* ssq_in; const bf16_t* res; const bf16_t* pp; bf16_t* hb; float* ssq_out;
    __device__ __forceinline__ void operator()(const f32x4 (&acc)[2][2][4][2], const Unit& u, int wr, int wc, int fr, int fq) const {
        const int row0 = u.pm * BM + wr * 64 + fr, col0 = u.pn * BM + wc * 32 + 8 * fq;
#pragma unroll
        for (int ai = 0; ai < 2; ++ai)
#pragma unroll
            for (int m = 0; m < 4; ++m) { const int row = row0 + ai * HALF + m * 16;
                const float sc = rsqrtf(ssq_in[row] * (1.f / DM) + NEPS);
                const bf16_t* sp = res + (size_t)row * DM + col0; bf16_t* hp = hb + (size_t)row * DM + col0; const bf16_t* ppp = pp + (size_t)row * DM + col0; float s = 0.f;
#pragma unroll
                for (int bj = 0; bj < 2; ++bj) { const u32x4 rw = *(const u32x4*)(sp + bj * HALF); const u32x4 pw = *(const u32x4*)(ppp + bj * HALF);
                    const f32x4 a0 = acc[ai][bj][m][0] * sc, a1 = acc[ai][bj][m][1] * sc;
                    f32x4 v0, v1;
                    v0[0] = bf_lo(rw.x) + fast_sigmoid(a0[0]) * bf_lo(pw.x); v0[1] = bf_hi(rw.x) + fast_sigmoid(a0[1]) * bf_hi(pw.x);
                    v0[2] = bf_lo(rw.y) + fast_sigmoid(a0[2]) * bf_lo(pw.y); v0[3] = bf_hi(rw.y) + fast_sigmoid(a0[3]) * bf_hi(pw.y);
                    v1[0] = bf_lo(rw.z) + fast_sigmoid(a1[0]) * bf_lo(pw.z); v1[1] = bf_hi(rw.z) + fast_sigmoid(a1[1]) * bf_hi(pw.z);
                    v1[2] = bf_lo(rw.w) + fast_sigmoid(a1[2]) * bf_lo(pw.w); v1[3] = bf_hi(rw.w) + fast_sigmoid(a1[3]) * bf_hi(pw.w);
                    u32x4 w; w.x = cvt_pk_bf16(v0[0], v0[1]); w.y = cvt_pk_bf16(v0[2], v0[3]); w.z = cvt_pk_bf16(v1[0], v1[1]); w.w = cvt_pk_bf16(v1[2], v1[3]);
                    *(u32x4*)(hp + bj * HALF) = w;
                    s += v0[0] * v0[0] + v0[1] * v0[1] + v0[2] * v0[2] + v0[3] * v0[3] + v1[0] * v1[0] + v1[1] * v1[1] + v1[2] * v1[2] + v1[3] * v1[3]; }
                s += __shfl_xor(s, 16); s += __shfl_xor(s, 32);
                if (fq == 0) atomicAdd(ssq_out + row, s); }
    }
};
template <class Epi, class Sched, bool ALIGN_EPI = false, bool SP2 = false>
__device__ __forceinline__ void gemm_phase(PG8_LAS unsigned char* lds, const Gemm g, const Sched& S, const Epi& E) {
    int tid_ = threadIdx.x; asm volatile("" : "+v"(tid_));
    const int tid = tid_, wid = __builtin_amdgcn_readfirstlane(tid >> 6), lane = tid & 63, wr = wid >> 2, wc = wid & 3, fr = lane & 15, fq = lane >> 4;
    int K_ = g.K; asm volatile("" : "+s"(K_));
    const int K = K_, nt = K / BK;
    unsigned voffA[2], voffB[2];
#pragma unroll
    for (int i = 0; i < 2; ++i) { int R, C; stage_rc(tid * 16 + i * 8192, R, C); const int Rb = Epi::PERM ? ((R & ~31) + perm32(R & 31)) : R;
        voffA[i] = (unsigned)(R * K + C) * 2u; voffB[i] = (unsigned)(Rb * K + C) * 2u; }
    const size_t kstep = (size_t)(BK * 2);
    const size_t hstep = (size_t)HALF * K * 2;
    const size_t tstep = 2 * hstep;
    const unsigned ldsw = (unsigned)wid * 1024u;
    const int aoff = lds_byte(wr * 64 + fr, fq * 8), boff = lds_byte(wc * 32 + fr, fq * 8);
#define PG8_SA(b, h) (((b) * 2 + (h)) * HTB)
#define PG8_SB(b, h) ((4 + (b) * 2 + (h)) * HTB)
#define PG8_STAGE(bufoff, gbase, voff) do { _Pragma("unroll") for (int _i = 0; _i < 2; ++_i) \
        __builtin_amdgcn_global_load_lds((const unsigned*)((const char*)(gbase) + (voff)[_i]), (PG8_LAS unsigned*)(lds + (bufoff) + ldsw + _i * 8192), 16, 0, 0); } while (0)
#define PG8_LDA(dst, b, h) do { _Pragma("unroll") for (int m = 0; m < 4; ++m) _Pragma("unroll") for (int k = 0; k < 2; ++k) dst[m][k] = *(const PG8_LAS bf16x8*)(lds + PG8_SA(b, h) + aoff + m * 2048 + k * 1024); } while (0)
#define PG8_LDB(dst, b, h) do { _Pragma("unroll") for (int n = 0; n < 2; ++n) _Pragma("unroll") for (int k = 0; k < 2; ++k) dst[n][k] = *(const PG8_LAS bf16x8*)(lds + PG8_SB(b, h) + boff + n * 2048 + k * 1024); } while (0)
#define PG8_MMA(ai, bj, At, Bt) do { __builtin_amdgcn_s_setprio(1); _Pragma("unroll") for (int m = 0; m < 4; ++m) _Pragma("unroll") for (int n = 0; n < 2; ++n) _Pragma("unroll") for (int k = 0; k < 2; ++k) \
        acc[ai][bj][m][n] = __builtin_amdgcn_mfma_f32_16x16x32_bf16(Bt[n][k], At[m][k], acc[ai][bj][m][n], 0, 0, 0); __builtin_amdgcn_s_setprio(0); } while (0)
#define PG8_WAIT_V(n) asm volatile("s_waitcnt vmcnt(" #n ")" ::: "memory")
#define PG8_WAIT_L(n) asm volatile("s_waitcnt lgkmcnt(" #n ")" ::: "memory")
#define PG8_BAR __builtin_amdgcn_s_barrier()
#define PG8_SCHED __builtin_amdgcn_sched_barrier(0)
    Unit cur, nxt; int ui = 0;
    if (!S.next(0, cur)) return;
    f32x4 acc[2][2][4][2];
#pragma unroll
    for (int a = 0; a < 2; ++a)
#pragma unroll
        for (int b = 0; b < 2; ++b)
#pragma unroll
            for (int m = 0; m < 4; ++m)
#pragma unroll
                for (int n = 0; n < 2; ++n) acc[a][b][m][n] = (f32x4){0.f, 0.f, 0.f, 0.f};
    bf16x8 At[4][2], B0[2][2], B1[2][2];
    const char* cA = (const char*)g.A + (size_t)cur.pm * tstep; const char* cB = (const char*)g.Bt + (size_t)cur.pn * tstep;
    S.a_ready(cur);
    if constexpr (SP2) {
        PG8_STAGE(PG8_SB(0, 0), cB, voffB); PG8_STAGE(PG8_SB(0, 1), cB + hstep, voffB); PG8_STAGE(PG8_SA(0, 0), cA, voffA); PG8_STAGE(PG8_SA(0, 1), cA + hstep, voffA);
        if (wr == 1) PG8_BAR;
        PG8_WAIT_V(2); PG8_BAR;
        PG8_STAGE(PG8_SB(1, 0), cB + kstep, voffB); PG8_STAGE(PG8_SA(1, 0), cA + kstep, voffA); PG8_STAGE(PG8_SB(1, 1), cB + hstep + kstep, voffB);
        PG8_WAIT_V(6); PG8_BAR;
    } else {
        PG8_STAGE(PG8_SB(0, 0), cB, voffB); PG8_STAGE(PG8_SA(0, 0), cA, voffA); PG8_STAGE(PG8_SB(0, 1), cB + hstep, voffB); PG8_STAGE(PG8_SA(0, 1), cA + hstep, voffA);
        if (wr == 1) PG8_BAR;
        PG8_WAIT_V(4); PG8_BAR;
        PG8_STAGE(PG8_SB(1, 0), cB + kstep, voffB); PG8_STAGE(PG8_SA(1, 0), cA + kstep, voffA); PG8_STAGE(PG8_SB(1, 1), cB + hstep + kstep, voffB);
        PG8_WAIT_V(6); PG8_BAR;
    }
    for (;;) {
        const bool has_next = S.next(ui + 1, nxt);
        const char* nA = has_next ? (const char*)g.A + (size_t)nxt.pm * tstep : cA; const char* nB = has_next ? (const char*)g.Bt + (size_t)nxt.pn * tstep : cB;
        for (int t = 0; t < nt; t += 2) {
            const bool last = (t == nt - 2);
            const char* a1 = cA + (size_t)(t + 1) * kstep;
            const char* a2 = last ? nA : cA + (size_t)(t + 2) * kstep; const char* b2 = last ? nB : cB + (size_t)(t + 2) * kstep;
            const char* a3 = a2 + kstep; const char* b3 = b2 + kstep;
            if (last && has_next) S.a_ready(nxt);
            if constexpr (SP2) {
            PG8_LDB(B0, 0, 0); PG8_LDB(B1, 0, 1); PG8_SCHED; PG8_LDA(At, 0, 0); PG8_STAGE(PG8_SA(1, 1), a1 + hstep, voffA);
            PG8_WAIT_V(8); PG8_WAIT_L(0); PG8_BAR; PG8_MMA(0, 0, At, B0); PG8_MMA(0, 1, At, B1); PG8_BAR; PG8_SCHED;
            PG8_LDA(At, 0, 1); PG8_STAGE(PG8_SB(0, 0), b2, voffB); PG8_STAGE(PG8_SB(0, 1), b2 + hstep, voffB); PG8_STAGE(PG8_SA(0, 0), a2, voffA);
            PG8_WAIT_V(8); PG8_WAIT_L(0); PG8_BAR; PG8_MMA(1, 0, At, B0); PG8_MMA(1, 1, At, B1); PG8_BAR; PG8_SCHED;
            PG8_LDB(B0, 1, 0); PG8_LDB(B1, 1, 1); PG8_SCHED; PG8_LDA(At, 1, 0); PG8_STAGE(PG8_SA(0, 1), a2 + hstep, voffA);
            PG8_WAIT_V(8); PG8_WAIT_L(0); PG8_BAR; PG8_MMA(0, 0, At, B0); PG8_MMA(0, 1, At, B1); PG8_BAR; PG8_SCHED;
            PG8_LDA(At, 1, 1); PG8_STAGE(PG8_SB(1, 0), b3, voffB); PG8_STAGE(PG8_SB(1, 1), b3 + hstep, voffB); PG8_STAGE(PG8_SA(1, 0), a3, voffA);
            PG8_WAIT_V(8); PG8_WAIT_L(0); PG8_BAR; PG8_MMA(1, 0, At, B0); PG8_MMA(1, 1, At, B1); PG8_BAR; PG8_SCHED;
            } else {
            PG8_LDB(B0, 0, 0); PG8_SCHED; PG8_LDA(At, 0, 0); PG8_STAGE(PG8_SA(1, 1), a1 + hstep, voffA);
            PG8_WAIT_L(8); PG8_BAR; PG8_WAIT_L(0); PG8_MMA(0, 0, At, B0); PG8_BAR; PG8_SCHED;
            PG8_LDB(B1, 0, 1); PG8_STAGE(PG8_SB(0, 0), b2, voffB);
            PG8_BAR; PG8_WAIT_L(0); PG8_MMA(0, 1, At, B1); PG8_BAR;
            PG8_LDA(At, 0, 1); PG8_STAGE(PG8_SA(0, 0), a2, voffA);
            PG8_BAR; PG8_WAIT_L(0); PG8_MMA(1, 0, At, B0); PG8_BAR; PG8_SCHED;
            PG8_STAGE(PG8_SB(0, 1), b2 + hstep, voffB);
            PG8_WAIT_V(6); PG8_BAR; PG8_MMA(1, 1, At, B1); PG8_BAR;
            PG8_LDB(B0, 1, 0); PG8_SCHED; PG8_LDA(At, 1, 0); PG8_STAGE(PG8_SA(0, 1), a2 + hstep, voffA);
            PG8_WAIT_L(8); PG8_BAR; PG8_WAIT_L(0); PG8_MMA(0, 0, At, B0); PG8_BAR; PG8_SCHED;
            PG8_LDB(B1, 1, 1); PG8_STAGE(PG8_SB(1, 0), b3, voffB);
            PG8_BAR; PG8_WAIT_L(0); PG8_MMA(0, 1, At, B1); PG8_BAR;
            PG8_LDA(At, 1, 1); PG8_STAGE(PG8_SA(1, 0), a3, voffA);
            PG8_BAR; PG8_WAIT_L(0); PG8_MMA(1, 0, At, B0); PG8_BAR; PG8_SCHED;
            PG8_STAGE(PG8_SB(1, 1), b3 + hstep, voffB);
            PG8_WAIT_V(6); PG8_BAR; PG8_MMA(1, 1, At, B1); PG8_BAR;
            }
        }
        if constexpr (ALIGN_EPI) { if (wr == 0) PG8_BAR; }
        if constexpr (!Epi::AFTER_DRAIN) { E(acc, cur, wr, wc, fr, fq); S.done(cur); }
        if (!has_next) break;
#pragma unroll
        for (int a = 0; a < 2; ++a)
#pragma unroll
            for (int b = 0; b < 2; ++b)
#pragma unroll
                for (int m = 0; m < 4; ++m)
#pragma unroll
                    for (int n = 0; n < 2; ++n) acc[a][b][m][n] = (f32x4){0.f, 0.f, 0.f, 0.f};
        cur = nxt; cA = nA; cB = nB; ++ui;
        if constexpr (ALIGN_EPI) { if (wr == 1) PG8_BAR; }
    }
    PG8_WAIT_V(0);
    if constexpr (!ALIGN_EPI) { if (wr == 0) PG8_BAR; }
    PG8_BAR;
    if constexpr (Epi::AFTER_DRAIN) { E.fused(acc, cur, wr, wc, fr, fq, lds, wid, lane); S.done(cur); }
#undef PG8_SA
#undef PG8_SB
#undef PG8_STAGE
#undef PG8_LDA
#undef PG8_LDB
#undef PG8_MMA
#undef PG8_WAIT_V
#undef PG8_WAIT_L
#undef PG8_BAR
#undef PG8_SCHED
}
}
#define LAS __attribute__((address_space(3)))
typedef unsigned short bf16;
typedef unsigned v4u __attribute__((ext_vector_type(4)));
typedef unsigned v2u __attribute__((ext_vector_type(2)));
typedef float v2f __attribute__((ext_vector_type(2)));
typedef float f32x4 __attribute__((ext_vector_type(4)));
typedef float f32x16 __attribute__((ext_vector_type(16)));
typedef short bf16x8 __attribute__((ext_vector_type(8)));
typedef short s16x4 __attribute__((ext_vector_type(4)));
constexpr int MTOK = 32768, DMOD = 2048, NZ = 5632, PLE = 256, NCHUNK = MTOK / 128;
constexpr int ZQ = 0, ZK = 1024, ZV = 1280, ZGA = 1536, ZCB = 2560, ZCC = 3072, ZCX = 3584, ZGC = 4096, ZXL = 4608, ZGL = 5120;
constexpr float LOG2E = 1.4426950408889634f;
constexpr int NWAVES = 8, NTHR = 512;
constexpr int LDS_BYTES = 147456;
constexpr size_t MiB = 1u << 20;
constexpr size_t WS_SSQ = 0;
constexpr size_t WS_AGG = 1 * MiB;
constexpr size_t WS_WL = 3 * MiB;
constexpr size_t WS_WPROJ = 4 * MiB;
constexpr size_t WS_CTL = 6 * MiB, CTL_BYTES = 16384;
constexpr size_t WS_WIN = 8 * MiB;
constexpr size_t WS_WOUT = 52 * MiB;
constexpr size_t WS_WGATE = 68 * MiB;
constexpr size_t WS_PB = 84 * MiB;
constexpr size_t WS_HBA = 116 * MiB;
constexpr size_t WS_HBB = 244 * MiB;
constexpr size_t WS_MIX = 372 * MiB;
constexpr size_t WS_PP = 500 * MiB;
constexpr size_t WS_Z = 628 * MiB;
constexpr size_t WS_END = 980 * MiB;

struct Params {
    const float *x_prompt, *x_sample, *p_prompt, *p_sample, *norm_mix, *w_in, *w_out, *rel_bias, *attn_sink, *conv_w, *lru_conv_w, *lru_conv_b,
                *lru_w_a, *lru_b_a, *lru_w_i, *lru_b_i, *lru_L, *ple_norm, *ple_w_gate, *ple_w_proj, *final_norm;
    float* out; unsigned char* ws;
};

__device__ __forceinline__ unsigned f2bf(float f) { unsigned u = __builtin_bit_cast(unsigned, f); return (u + 0x7fffu + ((u >> 16) & 1u)) >> 16; }
__device__ __forceinline__ unsigned pk2(float lo, float hi) { unsigned r; asm("v_cvt_pk_bf16_f32 %0, %1, %2" : "=v"(r) : "v"(lo), "v"(hi)); return r; }
__device__ __forceinline__ float bflo(unsigned w) { return __builtin_bit_cast(float, w << 16); }
__device__ __forceinline__ float bfhi(unsigned w) { return __builtin_bit_cast(float, w & 0xffff0000u); }
__device__ __forceinline__ float bf1(bf16 v) { return __builtin_bit_cast(float, (unsigned)v << 16); }
__device__ __forceinline__ float sigm(float x) { return __builtin_amdgcn_rcpf(1.f + __expf(-x)); }
__device__ __forceinline__ float silu(float x) { return x * sigm(x); }
__device__ __forceinline__ float wave_sum(float v) {
#pragma unroll
    for (int o = 1; o < 64; o <<= 1) v += __shfl_xor(v, o);
    return v;
}
__device__ __forceinline__ void seq_of_chunk(int c, int& s0, int& ns) { if (c < 128) { s0 = c & ~63; ns = 64; } else { s0 = c & ~15; ns = 16; } }

__device__ __forceinline__ void transpose_item(const float* W, int K, int N, bf16* WT, const float* kscale, LAS float* scr, int item, int lane) {
    const int nblk = N / 32, kb = item / nblk, nb = item % nblk, k0 = 64 * kb, n0 = 32 * nb;
#pragma unroll 8
    for (int i = 0; i < 32; ++i) { const int kk = 2 * i + (lane >> 5); float v = W[(size_t)(k0 + kk) * N + n0 + (lane & 31)]; if (kscale) v *= kscale[k0 + kk]; scr[kk * 33 + (lane & 31)] = v; }
    asm volatile("s_waitcnt lgkmcnt(0)" ::: "memory");
    const int c = lane & 7;
#pragma unroll
    for (int j = 0; j < 4; ++j) { const int n = (lane >> 3) + 8 * j; const LAS float* s = scr + (8 * c) * 33 + n;
        v4u o; o.x = pk2(s[0 * 33], s[1 * 33]); o.y = pk2(s[2 * 33], s[3 * 33]); o.z = pk2(s[4 * 33], s[5 * 33]); o.w = pk2(s[6 * 33], s[7 * 33]);
        *(v4u*)(WT + (size_t)(n0 + n) * K + k0 + 8 * c) = o; }
    asm volatile("s_waitcnt lgkmcnt(0)" ::: "memory");
}

__device__ __forceinline__ void p0_prologue(const Params& P, LAS unsigned char* lds, int tid, int G) {
    asm volatile("" : "+v"(tid));
    const int lane = tid & 63, wave = tid >> 6;
    const int gw = blockIdx.x * NWAVES + wave, NGW = G * NWAVES;
    const long gt = (long)blockIdx.x * NTHR + tid, NGT = (long)G * NTHR;
    unsigned char* ws = P.ws;
    { float* ssq = (float*)(ws + WS_SSQ); for (long i = gt; i < 4L * MTOK; i += NGT) ssq[MTOK + i] = 0.f; }
    LAS float* scr = (LAS float*)(lds + wave * 16384);
    constexpr int I_IN = (DMOD / 64) * (NZ / 32), I_SQ = (DMOD / 64) * (DMOD / 32), I_PR = (PLE / 64) * (DMOD / 32), I_L1 = (128 / 64) * (128 / 32), I_L = 16 * I_L1;
    constexpr int I_LAYER = I_IN + 2 * I_SQ + I_PR + I_L;
    for (int it = gw; it < 2 * I_LAYER; it += NGW) {
        const int l = it / I_LAYER; int r = it % I_LAYER;
        if (r < I_IN) { transpose_item(P.w_in + (size_t)l * DMOD * NZ, DMOD, NZ, (bf16*)(ws + WS_WIN) + (size_t)l * NZ * DMOD, P.norm_mix + l * DMOD, scr, r, lane); continue; } r -= I_IN;
        if (r < I_SQ) { transpose_item(P.w_out + (size_t)l * DMOD * DMOD, DMOD, DMOD, (bf16*)(ws + WS_WOUT) + (size_t)l * DMOD * DMOD, nullptr, scr, r, lane); continue; } r -= I_SQ;
        if (r < I_SQ) { transpose_item(P.ple_w_gate + (size_t)l * DMOD * DMOD, DMOD, DMOD, (bf16*)(ws + WS_WGATE) + (size_t)l * DMOD * DMOD, P.ple_norm + l * DMOD, scr, r, lane); continue; } r -= I_SQ;
        if (r < I_PR) { transpose_item(P.ple_w_proj + (size_t)l * PLE * DMOD, PLE, DMOD, (bf16*)(ws + WS_WPROJ) + (size_t)l * DMOD * PLE, nullptr, scr, r, lane); continue; } r -= I_PR;
        { const int mat = r / I_L1, sub = r % I_L1;
          const int dir = mat >> 3, which = (mat >> 2) & 1, h = mat & 3;
          const float* src = (which ? P.lru_w_i : P.lru_w_a) + ((size_t)((l * 2 + dir) * 4 + h)) * 128 * 128;
          bf16* dst = (bf16*)(ws + WS_WL) + ((size_t)(((l * 2 + dir) * 2 + which) * 4 + h)) * 128 * 128;
          transpose_item(src, 128, 128, dst, nullptr, scr, sub, lane); }
    }
    { bf16* hbA = (bf16*)(ws + WS_HBA); float* ssq = (float*)(ws + WS_SSQ);
      for (int row = gw; row < MTOK; row += NGW) {
          const float* xr = (row < 16384 ? P.x_prompt + (size_t)row * DMOD : P.x_sample + (size_t)(row - 16384) * DMOD);
          float s = 0.f;
#pragma unroll
          for (int j = 0; j < 8; ++j) { const f32x4 v = *(const f32x4*)(xr + 4 * lane + 256 * j); s += v[0] * v[0] + v[1] * v[1] + v[2] * v[2] + v[3] * v[3];
              v2u o; o.x = pk2(v[0], v[1]); o.y = pk2(v[2], v[3]); *(v2u*)(hbA + (size_t)row * DMOD + 4 * lane + 256 * j) = o; }
          s = wave_sum(s); if (lane == 0) ssq[row] = s; } }
    { bf16* pb = (bf16*)(ws + WS_PB);
      for (long i = gt; i < 2L * MTOK * PLE / 4; i += NGT) { const long e = i * 4; const int l = (int)(e / ((long)MTOK * PLE)); const long r = e % ((long)MTOK * PLE);
          const float* src = (r < 16384L * PLE) ? P.p_prompt + (size_t)l * 16384 * PLE + r : P.p_sample + (size_t)l * 16384 * PLE + (r - 16384L * PLE);
          const f32x4 v = *(const f32x4*)src; v2u o; o.x = pk2(v[0], v[1]); o.y = pk2(v[2], v[3]); *(v2u*)(pb + e) = o; } }
}

__device__ __forceinline__ int t5_bucket(int rel) {
    const int n = rel < 0 ? -rel : rel;
    int b = n < 8 ? n : 8 + (n >= 12) + (n >= 16) + (n >= 23) + (n >= 32) + (n >= 46) + (n >= 64) + (n >= 91);
    return b + (rel > 0 ? 16 : 0);
}
constexpr int AT_KP = 272, AT_VP = 320, AT_KB = 64 * AT_KP, AT_VB = 64 * AT_VP, AT_V0 = 2 * AT_KB, AT_TAB = AT_V0 + 2 * AT_VB, AT_TW = 384;

__device__ __forceinline__ void attn_build_tab(LAS unsigned char* lds, const float* rel_bias, int tid) {
    asm volatile("" : "+v"(tid));
    LAS float* tab = (LAS float*)(lds + AT_TAB);
    for (int i = tid; i < 8 * AT_TW; i += NTHR) { const int hd = i / AT_TW, rel = i % AT_TW - 192;
        tab[i] = (rel >= -128 && rel <= 128) ? rel_bias[t5_bucket(rel) * 8 + hd] * LOG2E : -1.0e30f; }
}

__device__ __forceinline__ void attn_item(LAS unsigned char* lds, int item, const bf16* z, bf16* mix, const float* sink, int tid) {
    asm volatile("" : "+v"(tid));
    const int c = item >> 2, kvh = (item >> 1) & 1, qhalf = item & 1;
    int s0, ns; seq_of_chunk(c, s0, ns);
    const int w = tid >> 6, lane = tid & 63, ql = lane & 31, h = lane >> 5;
    const int head = kvh * 4 + (w >> 1);
    const int tb = c * 128, tq = tb + qhalf * 64 + (w & 1) * 32 + ql;
    const int seq_lo = s0 * 128, seq_hi = (s0 + ns) * 128, kwin0 = tb - 128 + qhalf * 64;
    int j_lo = 0, j_hi = 4;
    while (kwin0 + 64 * j_lo < seq_lo) ++j_lo;
    while (kwin0 + 64 * j_hi + 64 > seq_hi) --j_hi;
    bf16x8 qf[8];
    { const bf16* qp = z + (size_t)tq * NZ + ZQ + head * 128 + 8 * h;
#pragma unroll
      for (int ks = 0; ks < 8; ++ks) qf[ks] = *(const bf16x8*)(qp + 16 * ks); }
    float m = sink[head] * LOG2E, lsum = (h == 0) ? 1.f : 0.f;
    f32x16 O[4];
#pragma unroll
    for (int dt = 0; dt < 4; ++dt)
#pragma unroll
        for (int i = 0; i < 16; ++i) O[dt][i] = 0.f;
    const LAS float* tabh = (const LAS float*)(lds + AT_TAB) + head * AT_TW;
    const float c1 = 0.08838834764831845f * LOG2E;
    v4u stg[4];
    const int pkey = tid >> 4, pc = tid & 15;
    auto prefetch = [&](int j) {
        const bf16* base = z + (size_t)(kwin0 + 64 * j + pkey) * NZ + kvh * 128 + pc * 8;
        stg[0] = *(const v4u*)(base + ZK); stg[1] = *(const v4u*)(base + ZK + (size_t)32 * NZ);
        stg[2] = *(const v4u*)(base + ZV); stg[3] = *(const v4u*)(base + ZV + (size_t)32 * NZ);
    };
    prefetch(j_lo);
    const int g4 = lane >> 4, q4 = (lane & 15) >> 2, p4 = lane & 3;
    for (int j = j_lo; j <= j_hi; ++j) {
        LAS unsigned char* Kb = lds + (j & 1) * AT_KB; LAS unsigned char* Vb = lds + AT_V0 + (j & 1) * AT_VB;
        *(LAS v4u*)(Kb + pkey * AT_KP + pc * 16) = stg[0]; *(LAS v4u*)(Kb + (pkey + 32) * AT_KP + pc * 16) = stg[1];
        *(LAS v4u*)(Vb + pkey * AT_VP + pc * 16) = stg[2]; *(LAS v4u*)(Vb + (pkey + 32) * AT_VP + pc * 16) = stg[3];
        if (j < j_hi) prefetch(j + 1);
        __syncthreads();
        f32x16 s[2];
#pragma unroll
        for (int kt = 0; kt < 2; ++kt) {
#pragma unroll
            for (int i = 0; i < 16; ++i) s[kt][i] = 0.f;
#pragma unroll
            for (int ks = 0; ks < 8; ++ks) { const bf16x8 kf = *(const LAS bf16x8*)(Kb + (kt * 32 + ql) * AT_KP + (16 * ks + 8 * h) * 2);
                s[kt] = __builtin_amdgcn_mfma_f32_32x32x16_bf16(kf, qf[ks], s[kt], 0, 0, 0); }
        }
        float mx = -3.0e38f;
#pragma unroll
        for (int kt = 0; kt < 2; ++kt) { const LAS float* tp = tabh + ((kwin0 + 64 * j + 32 * kt + 4 * h) - tq + 192);
#pragma unroll
            for (int i = 0; i < 16; ++i) { const float t = s[kt][i] * c1 + tp[(i & 3) + 8 * (i >> 2)]; s[kt][i] = t; mx = fmaxf(mx, t); } }
        mx = fmaxf(mx, __shfl_xor(mx, 32));
        const float mn = fmaxf(m, mx), alpha = __builtin_amdgcn_exp2f(m - mn); m = mn;
        float ps = 0.f;
#pragma unroll
        for (int kt = 0; kt < 2; ++kt)
#pragma unroll
            for (int i = 0; i < 16; ++i) { const float p = __builtin_amdgcn_exp2f(s[kt][i] - mn); s[kt][i] = p; ps += p; }
        lsum = lsum * alpha + ps;
        if (__any(alpha != 1.f)) {
#pragma unroll
            for (int dt = 0; dt < 4; ++dt)
#pragma unroll
                for (int i = 0; i < 16; ++i) O[dt][i] *= alpha;
        }
#pragma unroll
        for (int kt = 0; kt < 2; ++kt)
#pragma unroll
            for (int s2 = 0; s2 < 2; ++s2) {
                v4u pw; pw.x = pk2(s[kt][8 * s2 + 0], s[kt][8 * s2 + 1]); pw.y = pk2(s[kt][8 * s2 + 2], s[kt][8 * s2 + 3]);
                pw.z = pk2(s[kt][8 * s2 + 4], s[kt][8 * s2 + 5]); pw.w = pk2(s[kt][8 * s2 + 6], s[kt][8 * s2 + 7]);
                const bf16x8 pf = __builtin_bit_cast(bf16x8, pw);
                const LAS unsigned char* vrow = Vb + (32 * kt + 16 * s2 + 4 * h + q4) * AT_VP + (16 * (g4 & 1) + 4 * p4) * 2;
#pragma unroll
                for (int dt = 0; dt < 4; ++dt) {
                    const s16x4 lo = __builtin_amdgcn_ds_read_tr16_b64_v4i16((LAS s16x4*)(vrow + dt * 64));
                    const s16x4 hi = __builtin_amdgcn_ds_read_tr16_b64_v4i16((LAS s16x4*)(vrow + dt * 64 + 8 * AT_VP));
                    const bf16x8 vf = __builtin_shufflevector(lo, hi, 0, 1, 2, 3, 4, 5, 6, 7);
                    O[dt] = __builtin_amdgcn_mfma_f32_32x32x16_bf16(vf, pf, O[dt], 0, 0, 0);
                }
            }
    }
    const float ltot = lsum + __shfl_xor(lsum, 32), inv = 1.f / ltot;
    const bf16* gp = z + (size_t)tq * NZ + ZGA + head * 128 + 4 * h; bf16* op = mix + (size_t)tq * DMOD + head * 128 + 4 * h;
#pragma unroll
    for (int dt = 0; dt < 4; ++dt)
#pragma unroll
        for (int rg = 0; rg < 4; ++rg) { const v2u gw = *(const v2u*)(gp + 32 * dt + 8 * rg);
            const float o0 = O[dt][4 * rg + 0] * inv * silu(bflo(gw.x)), o1 = O[dt][4 * rg + 1] * inv * silu(bfhi(gw.x));
            const float o2 = O[dt][4 * rg + 2] * inv * silu(bflo(gw.y)), o3 = O[dt][4 * rg + 3] * inv * silu(bfhi(gw.y));
            v2u ow; ow.x = pk2(o0, o1); ow.y = pk2(o2, o3); *(v2u*)(op + 32 * dt + 8 * rg) = ow; }
    __syncthreads();
}

__device__ __forceinline__ void conv_phase(const bf16* z, bf16* mix, const float* cw  , int G, int tid) {
    asm volatile("" : "+v"(tid));
    const long NW = (long)MTOK * 64;
    for (long i = (long)blockIdx.x * NTHR + tid; i < NW; i += (long)G * NTHR) {
        const int t = (int)(i >> 6), cg8 = (int)(i & 63) * 8;
        int s0, ns; seq_of_chunk(t >> 7, s0, ns);
        const bool hasp = t > s0 * 128, hasn = t + 1 < (s0 + ns) * 128;
        const bf16* zr = z + (size_t)t * NZ;
        const v4u cb = *(const v4u*)(zr + ZCB + cg8), gc = *(const v4u*)(zr + ZGC + cg8);
        const v4u c1 = *(const v4u*)(zr + ZCC + cg8), x1 = *(const v4u*)(zr + ZCX + cg8);
        v4u c0 = {0, 0, 0, 0}, x0 = {0, 0, 0, 0}, c2 = {0, 0, 0, 0}, x2 = {0, 0, 0, 0};
        if (hasp) { c0 = *(const v4u*)(zr - NZ + ZCC + cg8); x0 = *(const v4u*)(zr - NZ + ZCX + cg8); }
        if (hasn) { c2 = *(const v4u*)(zr + NZ + ZCC + cg8); x2 = *(const v4u*)(zr + NZ + ZCX + cg8); }
        float o[8];
#pragma unroll
        for (int e = 0; e < 4; ++e) {
#pragma unroll
            for (int hh = 0; hh < 2; ++hh) { const int ch = cg8 + 2 * e + hh;
                const float a0 = hh ? bfhi(c0[e]) * bfhi(x0[e]) : bflo(c0[e]) * bflo(x0[e]);
                const float a1 = hh ? bfhi(c1[e]) * bfhi(x1[e]) : bflo(c1[e]) * bflo(x1[e]);
                const float a2 = hh ? bfhi(c2[e]) * bfhi(x2[e]) : bflo(c2[e]) * bflo(x2[e]);
                const float cv = cw[ch] * a0 + cw[512 + ch] * a1 + cw[1024 + ch] * a2;
                const float b = hh ? bfhi(cb[e]) : bflo(cb[e]), g = hh ? bfhi(gc[e]) : bflo(gc[e]);
                o[2 * e + hh] = b * cv * silu(g); } }
        v4u ow; ow.x = pk2(o[0], o[1]); ow.y = pk2(o[2], o[3]); ow.z = pk2(o[4], o[5]); ow.w = pk2(o[6], o[7]);
        *(v4u*)(mix + (size_t)t * DMOD + 1024 + cg8) = ow;
    }
}

constexpr int LR_XC = 0, LR_XCP = 272, LR_PB = 128 * LR_XCP, LR_Y = 2 * 128 * LR_XCP, LR_YP = 132;
struct LruLayer { const float *cw, *cb, *ba, *bi, *L; const bf16* WL; };
__device__ __forceinline__ void lru_heavy(LAS unsigned char* lds, int item, const bf16* z, const LruLayer& LP, float* agg, bf16* LL, bf16* PFB  , int tid) {
    asm volatile("" : "+v"(tid));
    const int c = item >> 2, hh = item & 3;
    int s0, ns; seq_of_chunk(c, s0, ns);
    const int w = tid >> 6, lane = tid & 63, tb = c * 128, seq_lo = s0 * 128, seq_hi = (s0 + ns) * 128;
    const int chl = 16 * w + (lane & 15), chg = hh * 128 + chl, q = lane >> 4;
    LAS float* Y = (LAS float*)(lds + LR_Y);
#pragma unroll 1
    for (int dir = 0; dir < 2; ++dir) {
        for (int p = tid; p < 128 * 16; p += NTHR) { const int t = p >> 4, pc = p & 15; const int tok0 = tb + t + (dir ? 0 : -3);
            const float* cb = LP.cb + dir * 512 + hh * 128 + pc * 8;
            f32x4 a0 = *(const f32x4*)cb, a1 = *(const f32x4*)(cb + 4);
#pragma unroll
            for (int k = 0; k < 4; ++k) { const int tok = tok0 + k; v4u xv = {0, 0, 0, 0};
                if (tok >= seq_lo && tok < seq_hi) xv = *(const v4u*)(z + (size_t)tok * NZ + ZXL + hh * 128 + pc * 8);
                const float* wk = LP.cw + (dir * 4 + k) * 512 + hh * 128 + pc * 8; const f32x4 w0 = *(const f32x4*)wk, w1 = *(const f32x4*)(wk + 4);
                a0[0] += w0[0] * bflo(xv[0]); a0[1] += w0[1] * bfhi(xv[0]); a0[2] += w0[2] * bflo(xv[1]); a0[3] += w0[3] * bfhi(xv[1]);
                a1[0] += w1[0] * bflo(xv[2]); a1[1] += w1[1] * bfhi(xv[2]); a1[2] += w1[2] * bflo(xv[3]); a1[3] += w1[3] * bfhi(xv[3]); }
            v4u o; o.x = pk2(a0[0], a0[1]); o.y = pk2(a0[2], a0[3]); o.z = pk2(a1[0], a1[1]); o.w = pk2(a1[2], a1[3]);
            const int s = dir ? 127 - t : t;
            *(LAS v4u*)(lds + LR_XC + s * LR_XCP + pc * 16) = o; }
        __syncthreads();
        f32x4 ar[8], ai[8];
#pragma unroll
        for (int mt = 0; mt < 8; ++mt) { ar[mt] = (f32x4){0.f, 0.f, 0.f, 0.f}; ai[mt] = (f32x4){0.f, 0.f, 0.f, 0.f}; }
        { const bf16* wa = LP.WL + ((size_t)((dir * 2 + 0) * 4 + hh)) * 16384 + (size_t)chl * 128 + 8 * q;
          const bf16* wi = LP.WL + ((size_t)((dir * 2 + 1) * 4 + hh)) * 16384 + (size_t)chl * 128 + 8 * q;
#pragma unroll
          for (int ks = 0; ks < 4; ++ks) { const bf16x8 bA = *(const bf16x8*)(wa + 32 * ks), bI = *(const bf16x8*)(wi + 32 * ks);
#pragma unroll
              for (int mt = 0; mt < 8; ++mt) { const bf16x8 af = *(const LAS bf16x8*)(lds + LR_XC + (16 * mt + (lane & 15)) * LR_XCP + (32 * ks + 8 * q) * 2);
                  ar[mt] = __builtin_amdgcn_mfma_f32_16x16x32_bf16(af, bA, ar[mt], 0, 0, 0);
                  ai[mt] = __builtin_amdgcn_mfma_f32_16x16x32_bf16(af, bI, ai[mt], 0, 0, 0); } } }
        const float b_a = LP.ba[dir * 512 + chg], b_i = LP.bi[dir * 512 + chg];
        const float c8 = 8.f * LOG2E * log1pf(__expf(-LP.L[dir * 512 + chg]));
        float Hrun = 0.f, Arun = 1.f;
#pragma unroll
        for (int mt = 0; mt < 8; ++mt) {
            float a[4], u[4];
#pragma unroll
            for (int r = 0; r < 4; ++r) { const int s = 16 * mt + 4 * q + r;
                const float er = __builtin_amdgcn_exp2f(-LOG2E * (ar[mt][r] + b_a)), ei = __builtin_amdgcn_exp2f(-LOG2E * (ai[mt][r] + b_i));
                const float dr = 1.f + er, di = 1.f + ei, R = __builtin_amdgcn_rcpf(dr * di);
                const float rr = R * di, ii = R * dr;
                const float av = __builtin_amdgcn_exp2f(-c8 * rr);
                const float xcv = bf1(*(const LAS bf16*)(lds + LR_XC + s * LR_XCP + chl * 2));
                a[r] = av; u[r] = __builtin_amdgcn_sqrtf(fmaxf(1.f - av * av, 0.f)) * ii * xcv; }
            float A4 = a[0] * a[1] * a[2] * a[3];
            float B4 = ((u[0] * a[1] + u[1]) * a[2] + u[2]) * a[3] + u[3];
            { const float Ap = __shfl_up(A4, 16), Bp = __shfl_up(B4, 16); if (q >= 1) { B4 = A4 * Bp + B4; A4 = A4 * Ap; } }
            { const float Ap = __shfl_up(A4, 32), Bp = __shfl_up(B4, 32); if (q >= 2) { B4 = A4 * Bp + B4; A4 = A4 * Ap; } }
            float Ae = __shfl_up(A4, 16), Be = __shfl_up(B4, 16); if (q == 0) { Ae = 1.f; Be = 0.f; }
            const float At = __shfl(A4, 48 + (lane & 15)), Bt = __shfl(B4, 48 + (lane & 15));
            float hcur = Ae * Hrun + Be, pcur = Arun * Ae;
#pragma unroll
            for (int r = 0; r < 4; ++r) { hcur = a[r] * hcur + u[r]; pcur *= a[r]; const int s = 16 * mt + 4 * q + r; const int t = dir ? 127 - s : s;
                if (dir == 0) Y[t * LR_YP + chl] = hcur; else Y[t * LR_YP + chl] += hcur;
                *(LAS bf16*)(lds + LR_PB + t * LR_XCP + chl * 2) = (bf16)(pk2(pcur, 0.f) & 0xffffu); }
            Hrun = At * Hrun + Bt; Arun *= At;
        }
        if (q == 0) { float* ag = agg + (size_t)c * 2048 + (size_t)dir * 1024 + 2 * chg; ag[0] = Arun; ag[1] = Hrun; }
        __syncthreads();
        { bf16* dst = PFB + (size_t)dir * MTOK * 512;
          for (int p = tid; p < 128 * 16; p += NTHR) { const int t = p >> 4, pc = p & 15;
              *(v4u*)(dst + (size_t)(tb + t) * 512 + hh * 128 + pc * 8) = *(const LAS v4u*)(lds + LR_PB + t * LR_XCP + pc * 16); } }
    }
    for (int p = tid; p < 128 * 16; p += NTHR) { const int t = p >> 4, pc = p & 15; const LAS float* yr = Y + t * LR_YP + pc * 8;
        v4u ow; ow.x = pk2(yr[0], yr[1]); ow.y = pk2(yr[2], yr[3]); ow.z = pk2(yr[4], yr[5]); ow.w = pk2(yr[6], yr[7]);
        *(v4u*)(LL + (size_t)(tb + t) * 512 + hh * 128 + pc * 8) = ow; }
    __syncthreads();
}

__device__ __forceinline__ void lru_light(LAS unsigned char* lds, int c, const bf16* z, bf16* mix, const float* agg, const bf16* LL, const bf16* PFB, int tid) {
    asm volatile("" : "+v"(tid));
    int s0, ns; seq_of_chunk(c, s0, ns);
    LAS float* car = (LAS float*)lds;
    {
      const float* ag0 = agg + 2 * tid; const float* ag1 = agg + 1024 + 2 * tid;
      float H0 = 0.f, H1 = 0.f; int cc = s0, cd = s0 + ns - 1;
      for (; cc + 8 <= c; cc += 8) { v2f v[8];
#pragma unroll
          for (int k = 0; k < 8; ++k) v[k] = *(const v2f*)(ag0 + (size_t)(cc + k) * 2048);
#pragma unroll
          for (int k = 0; k < 8; ++k) H0 = v[k][0] * H0 + v[k][1]; }
      for (; cc < c; ++cc) { const v2f v = *(const v2f*)(ag0 + (size_t)cc * 2048); H0 = v[0] * H0 + v[1]; }
      for (; cd - 8 >= c; cd -= 8) { v2f v[8];
#pragma unroll
          for (int k = 0; k < 8; ++k) v[k] = *(const v2f*)(ag1 + (size_t)(cd - k) * 2048);
#pragma unroll
          for (int k = 0; k < 8; ++k) H1 = v[k][0] * H1 + v[k][1]; }
      for (; cd > c; --cd) { const v2f v = *(const v2f*)(ag1 + (size_t)cd * 2048); H1 = v[0] * H1 + v[1]; }
      car[tid] = H0; car[512 + tid] = H1; }
    __syncthreads();
    const int tb = c * 128;
    for (int p = tid; p < 128 * 64; p += NTHR) { const int t = p >> 6, c8 = (p & 63) * 8; const size_t ro = (size_t)(tb + t) * 512 + c8;
        const v4u lv = *(const v4u*)(LL + ro), fv = *(const v4u*)(PFB + ro), bv = *(const v4u*)(PFB + (size_t)MTOK * 512 + ro);
        const v4u gv = *(const v4u*)(z + (size_t)(tb + t) * NZ + ZGL + c8);
        float o[8];
#pragma unroll
        for (int e = 0; e < 4; ++e) {
            o[2 * e] = (bflo(lv[e]) + bflo(fv[e]) * car[c8 + 2 * e] + bflo(bv[e]) * car[512 + c8 + 2 * e]) * silu(bflo(gv[e]));
            o[2 * e + 1] = (bfhi(lv[e]) + bfhi(fv[e]) * car[c8 + 2 * e + 1] + bfhi(bv[e]) * car[512 + c8 + 2 * e + 1]) * silu(bfhi(gv[e])); }
        v4u ow; ow.x = pk2(o[0], o[1]); ow.y = pk2(o[2], o[3]); ow.z = pk2(o[4], o[5]); ow.w = pk2(o[6], o[7]);
        *(v4u*)(mix + (size_t)(tb + t) * DMOD + 1536 + c8) = ow; }
    __syncthreads();
}

#define XB_TMO      128
#define XB_XCNT(j)  (256  + 64 * (j))
#define XB_XSUB(j)  (1280 + 64 * (j))
#define XB_XGEN(j)  (2304 + 64 * (j))
#define XB_TOP      3328
#define XB_TOPGEN   3392
#define XCD_BAR_WORDS 3456
#define XB_SPIN_CAP (1u << 18)

__device__ __forceinline__ unsigned xb_ld(unsigned* p)              { return __hip_atomic_load(p, __ATOMIC_RELAXED, __HIP_MEMORY_SCOPE_AGENT); }
__device__ __forceinline__ unsigned xb_add(unsigned* p, unsigned v) { return __hip_atomic_fetch_add(p, v, __ATOMIC_RELAXED, __HIP_MEMORY_SCOPE_AGENT); }
__device__ __forceinline__ unsigned xb_xcc_id() { return (unsigned)__builtin_amdgcn_s_getreg((3 << 11) | 20) & 0xFu; }
#define XB_SPIN(cond, bar) do { unsigned _sp = 0; while (cond) { __builtin_amdgcn_s_sleep(1); \
    if ((++_sp & 255u) == 0u) { if (xb_ld(&(bar)[XB_TMO])) break; if (_sp > XB_SPIN_CAP) { atomicAdd(&(bar)[XB_TMO], 1u); break; } } } } while (0)

struct XcdBarrier {
    unsigned* bar; unsigned x;
    volatile LAS unsigned* st;
};

__device__ __forceinline__ XcdBarrier xcd_barrier_post(unsigned* bar, volatile LAS unsigned* st) {
    XcdBarrier b; b.bar = bar; b.x = xb_xcc_id(); b.st = st;
    if (threadIdx.x == 0) (void)xb_add(&bar[XB_XCNT(b.x)], 1u);
    return b;
}
__device__ __forceinline__ void xcd_barrier_complete(unsigned* bar, unsigned x, unsigned& nloc, unsigned& nx) {
    const unsigned G = gridDim.x * gridDim.y * gridDim.z;
    unsigned sum, cnt, mine, sp = 0u;
    for (;;) {
        sum = 0u; cnt = 0u; mine = 0u;
#pragma unroll
        for (unsigned j = 0; j < 16; ++j) { const unsigned c = xb_ld(&bar[XB_XCNT(j)]); sum += c; cnt += (c > 0u) ? 1u : 0u; mine = (j == x) ? c : mine; }
        if (sum == G) break;
        __builtin_amdgcn_s_sleep(1);
        if ((++sp & 255u) == 0u) { if (xb_ld(&bar[XB_TMO])) break; if (sp > XB_SPIN_CAP) { atomicAdd(&bar[XB_TMO], 1u); break; } }
    }
    nloc = mine > 0u ? mine : 1u; nx = cnt > 0u ? cnt : 1u;
}

__device__ __forceinline__ void xcd_barrier(const XcdBarrier& b) {
    asm volatile("s_waitcnt vmcnt(0)" ::: "memory");
    __syncthreads();
    if (threadIdx.x == 0) {
        unsigned* bar = b.bar;
        __builtin_amdgcn_s_waitcnt(0);
        unsigned nloc = b.st[0], nx = b.st[1];
        if (nloc == 0u) { xcd_barrier_complete(bar, b.x, nloc, nx); b.st[0] = nloc; b.st[1] = nx; }
        const unsigned old = xb_add(&bar[XB_XSUB(b.x)], 1u);
        const unsigned gen = old / nloc;
        if (old + 1u == (gen + 1u) * nloc) {
            __builtin_amdgcn_fence(__ATOMIC_RELEASE, "agent");
            asm volatile("s_waitcnt vmcnt(0)" ::: "memory");
            const unsigned og = xb_add(&bar[XB_TOP], 1u);
            const unsigned tg = og / nx;
            if (og + 1u == (tg + 1u) * nx) xb_add(&bar[XB_TOPGEN], 1u);
            else XB_SPIN(xb_ld(&bar[XB_TOPGEN]) == tg, bar);
            __builtin_amdgcn_fence(__ATOMIC_ACQUIRE, "agent");
            xb_add(&bar[XB_XGEN(b.x)], 1u);
            asm volatile("s_waitcnt vmcnt(0)" ::: "memory");
        } else {
            XB_SPIN(xb_ld(&bar[XB_XGEN(b.x)]) == gen, bar);
            __builtin_amdgcn_fence(__ATOMIC_ACQUIRE, "agent");
            asm volatile("s_waitcnt vmcnt(0)" ::: "memory");
        }
    }
    __syncthreads();
}

#ifndef PH_LO
#define PH_LO 0
#endif
__global__ void __launch_bounds__(NTHR, 2) fwd_megakernel(Params P) {
    extern __shared__ __attribute__((aligned(16))) unsigned char lds_raw[];
    LAS unsigned char* lds = (LAS unsigned char*)lds_raw;
    cg::grid_group grid = cg::this_grid();
    const int tid = threadIdx.x, G = gridDim.x;
    unsigned char* ws = P.ws;
    volatile LAS unsigned* MISC = (volatile LAS unsigned*)(lds + LDS_BYTES - 64);
    if (tid < 16) MISC[tid] = 0u;
    __syncthreads();
    XcdBarrier xbar = xcd_barrier_post((unsigned*)(ws + WS_CTL), MISC);
    float* ssq = (float*)(ws + WS_SSQ); float* agg = (float*)(ws + WS_AGG);
    bf16* hbA = (bf16*)(ws + WS_HBA); bf16* hbB = (bf16*)(ws + WS_HBB); bf16* mix = (bf16*)(ws + WS_MIX); bf16* pp = (bf16*)(ws + WS_PP); bf16* z = (bf16*)(ws + WS_Z);

#ifndef NO_P0
    p0_prologue(P, lds, tid, G);
#ifdef DUP_P0
    __syncthreads(); p0_prologue(P, lds, tid, G);
#endif
#endif
    if (P.ws == nullptr) grid.sync();
    xcd_barrier(xbar);
#ifdef DUP_SYNC
#pragma unroll 1
    for (int r = 0; r < 10; ++r) xcd_barrier(xbar);
#endif
#pragma unroll 1
    for (int l = 0; l < 2; ++l) {
        { pg8::Gemm g{hbA, (const bf16*)(ws + WS_WIN) + (size_t)l * NZ * DMOD, MTOK, NZ, DMOD}; pg8::StaticOrder S; S.init(MTOK, NZ, G, (int)blockIdx.x);
          pg8::EpiZ E{z, NZ, ssq + (size_t)(2 * l) * MTOK};
          pg8::gemm_phase<pg8::EpiZ, pg8::StaticOrder, true, true>(lds, g, S, E);
#ifdef DUP_A
          pg8::gemm_phase<pg8::EpiZ, pg8::StaticOrder, true, true>(lds, g, S, E);
#endif
 }
        { pg8::Gemm g{(const bf16*)(ws + WS_PB) + (size_t)l * MTOK * PLE, (const bf16*)(ws + WS_WPROJ) + (size_t)l * DMOD * PLE, MTOK, DMOD, PLE}; pg8::StaticOrder S; S.init(MTOK, DMOD, G, (int)blockIdx.x);
          pg8::EpiZ E{pp, DMOD, nullptr};
#ifndef NO_GP
          pg8::gemm_phase<pg8::EpiZ, pg8::StaticOrder, true, true>(lds, g, S, E);
#endif
 }
        xcd_barrier(xbar);
#ifdef DUP_MIX
        for (int rep = 0; rep < 2; ++rep) {
#endif
        LruLayer LP{P.lru_conv_w + (size_t)l * 2 * 4 * 512, P.lru_conv_b + l * 1024, P.lru_b_a + l * 1024, P.lru_b_i + l * 1024, P.lru_L + l * 1024, (const bf16*)(ws + WS_WL) + (size_t)l * 16 * 16384};
        bf16* LL = hbB; bf16* PFB = hbB + (size_t)MTOK * 512;
        for (int it = blockIdx.x; it < NCHUNK * 4; it += G) lru_heavy(lds, it, z, LP, agg, LL, PFB, tid);
#ifdef DUP_HEAVY
        for (int it = blockIdx.x; it < NCHUNK * 4; it += G) lru_heavy(lds, it, z, LP, agg, LL, PFB, tid);
#endif
        xcd_barrier(xbar);
        attn_build_tab(lds, P.rel_bias, tid);
        __syncthreads();
#ifndef NO_ATTN
        for (int it = blockIdx.x; it < NCHUNK * 4; it += G) attn_item(lds, it, z, mix, P.attn_sink + l * 8, tid);
#ifdef DUP_ATTN
        for (int it = blockIdx.x; it < NCHUNK * 4; it += G) attn_item(lds, it, z, mix, P.attn_sink + l * 8, tid);
#endif
#endif
        for (int it = blockIdx.x; it < NCHUNK; it += G) lru_light(lds, it, z, mix, agg, LL, PFB, tid);
#ifdef DUP_LIGHT
        for (int it = blockIdx.x; it < NCHUNK; it += G) lru_light(lds, it, z, mix, agg, LL, PFB, tid);
#endif
#ifndef NO_CONV
        conv_phase(z, mix, P.conv_w + (size_t)l * 3 * 512, G, tid);
#ifdef DUP_CONV
        conv_phase(z, mix, P.conv_w + (size_t)l * 3 * 512, G, tid);
#endif
#endif
        xcd_barrier(xbar);
#ifdef DUP_MIX
        }
#endif
        { pg8::Gemm g{mix, (const bf16*)(ws + WS_WOUT) + (size_t)l * DMOD * DMOD, MTOK, DMOD, DMOD}; pg8::StaticOrder S; S.init(MTOK, DMOD, G, (int)blockIdx.x);
          pg8::EpiRes E{hbA, hbB, ssq + (size_t)(2 * l + 1) * MTOK};
#ifndef NO_GC
          pg8::gemm_phase<pg8::EpiRes, pg8::StaticOrder, true, true>(lds, g, S, E);
#endif
 }
        xcd_barrier(xbar);
        { pg8::Gemm g{hbB, (const bf16*)(ws + WS_WGATE) + (size_t)l * DMOD * DMOD, MTOK, DMOD, DMOD}; pg8::StaticOrder S; S.init(MTOK, DMOD, G, (int)blockIdx.x);
          pg8::EpiGate E{ssq + (size_t)(2 * l + 1) * MTOK, hbB, pp, hbA, ssq + (size_t)(2 * l + 2) * MTOK};
#ifndef NO_GD
          pg8::gemm_phase<pg8::EpiGate, pg8::StaticOrder, true, true>(lds, g, S, E);
#endif
 }
        xcd_barrier(xbar);
    }
    { const int lane = tid & 63, gw = blockIdx.x * NWAVES + (tid >> 6), NGW = G * NWAVES; const float* sf = ssq + (size_t)4 * MTOK;
      for (int row = gw; row < MTOK; row += NGW) { const float rs = rsqrtf(sf[row] * (1.f / DMOD) + 1e-6f); float* orow = P.out + (size_t)row * DMOD; const bf16* hrow = hbA + (size_t)row * DMOD;
#pragma unroll
          for (int j = 0; j < 4; ++j) { const int cidx = 8 * lane + 512 * j; const v4u hv = *(const v4u*)(hrow + cidx); const f32x4 g0 = *(const f32x4*)(P.final_norm + cidx), g1 = *(const f32x4*)(P.final_norm + cidx + 4);
              f32x4 v0, v1; v0[0] = bflo(hv.x) * rs * g0[0]; v0[1] = bfhi(hv.x) * rs * g0[1]; v0[2] = bflo(hv.y) * rs * g0[2]; v0[3] = bfhi(hv.y) * rs * g0[3];
              v1[0] = bflo(hv.z) * rs * g1[0]; v1[1] = bfhi(hv.z) * rs * g1[1]; v1[2] = bflo(hv.w) * rs * g1[2]; v1[3] = bfhi(hv.w) * rs * g1[3];
              *(f32x4*)(orow + cidx) = v0; *(f32x4*)(orow + cidx + 4) = v1; } } }
}

extern "C" void kernel_launch(void* const* d_in, const int* in_sizes, int n_in, void* d_out, int out_size, void* d_ws, size_t ws_size, hipStream_t stream) {
    static int grid_blocks = 0;
    if (!grid_blocks) {
        if (n_in != 21 || ws_size < WS_END) { fprintf(stderr, "kernel_launch: unexpected n_in %d / ws_size %zu\n", n_in, ws_size); grid_blocks = -1; return; }
        int dev = 0, cus = 0, per_cu = 0;
        (void)hipGetDevice(&dev);
        (void)hipDeviceGetAttribute(&cus, hipDeviceAttributeMultiprocessorCount, dev);
        (void)hipFuncSetAttribute((const void*)fwd_megakernel, hipFuncAttributeMaxDynamicSharedMemorySize, LDS_BYTES);
        (void)hipOccupancyMaxActiveBlocksPerMultiprocessor(&per_cu, (const void*)fwd_megakernel, NTHR, LDS_BYTES);
        if (per_cu < 1) { fprintf(stderr, "kernel_launch: occupancy query says %d blocks/CU\n", per_cu); per_cu = 1; }
        grid_blocks = cus;
    }
    if (grid_blocks < 0) return;
    (void)hipMemsetAsync((unsigned char*)d_ws + WS_CTL, 0, CTL_BYTES, stream);
    Params p{};
    const float** pf = (const float**)&p;
    for (int i = 0; i < 21; ++i) pf[i] = (const float*)d_in[i];
    p.out = (float*)d_out; p.ws = (unsigned char*)d_ws;
    void* args[] = {&p};
    hipError_t e = hipLaunchCooperativeKernel((void*)fwd_megakernel, dim3(grid_blocks), dim3(NTHR), args, LDS_BYTES, stream);
    if (e != hipSuccess) fprintf(stderr, "cooperative launch failed: %s (grid %d)\n", hipGetErrorString(e), grid_blocks);
}
```

```cpp
#include <hip/hip_runtime.h>
#include <hip/hip_cooperative_groups.h>
#include <cstdio>
#include <cstdint>
namespace cg = cooperative_groups;
namespace pg8 {
#define PG8_LAS __attribute__((address_space(3)))
typedef unsigned short bf16_t;
typedef short bf16x8 __attribute__((ext_vector_type(8)));
typedef float f32x4 __attribute__((ext_vector_type(4)));
typedef unsigned u32x4 __attribute__((ext_vector_type(4)));
constexpr int BM = 256, BK = 64, HALF = 128, HTB = HALF * BK * 2  , STAGE_BYTES = 8 * HTB, NXCD = 8, WGM = 8;

__host__ __device__ __forceinline__ int lds_byte(int r, int c) { const int st = (r >> 4) * 2 + (c >> 5), rr = r & 15, cc = c & 31, ob = rr * 64 + cc * 2; return st * 1024 + (ob ^ (((ob >> 9) & 1) << 5)); }
__host__ __device__ __forceinline__ void stage_rc(int b, int& R, int& C) { const int st = b / 1024, sb = b % 1024, swz = sb ^ (((sb >> 9) & 1) << 5); R = (st >> 1) * 16 + swz / 64; C = (st & 1) * 32 + (swz % 64) / 2; }
__host__ __device__ __forceinline__ int perm32(int rho) { const int n = rho >> 4, i = rho & 15; return 8 * (i >> 2) + 4 * n + (i & 3); }

struct Unit { int pm, pn; };
struct Gemm { const bf16_t* A; const bf16_t* Bt; int M, N, K; };

struct StaticOrder {
    int nM, nN, nwg, G, c;
    __host__ __device__ void init(int M, int N, int G_, int c_) { nM = M / BM; nN = N / BM; nwg = nM * nN; G = G_; c = c_; }
    __host__ __device__ bool next(int i, Unit& u) const {
        const long L = (long)i * G + c; if (L >= nwg) return false;
        int wgid = (int)L; { const int q = nwg / NXCD, r = nwg % NXCD, xcd = wgid % NXCD, off = wgid / NXCD; wgid = (xcd < r ? xcd * (q + 1) : r * (q + 1) + (xcd - r) * q) + off; }
        const int nig = WGM * nN, gid = wgid / nig, fm = gid * WGM, gsz = (nM - fm) < WGM ? (nM - fm) : WGM;
        u.pm = fm + ((wgid % nig) % gsz); u.pn = (wgid % nig) / gsz; return true;
    }
    __device__ __forceinline__ void a_ready(const Unit&) const {}
    __device__ __forceinline__ void done(const Unit&) const {}
};

__device__ __forceinline__ unsigned cvt_pk_bf16(float lo, float hi) { unsigned r; asm volatile("v_cvt_pk_bf16_f32 %0, %1, %2" : "=v"(r) : "v"(lo), "v"(hi)); return r; }
__device__ __forceinline__ float fast_sigmoid(float x) { return __builtin_amdgcn_rcpf(1.f + __expf(-x)); }
__device__ __forceinline__ float bf_lo(unsigned w) { return __builtin_bit_cast(float, w << 16); }
__device__ __forceinline__ float bf_hi(unsigned w) { return __builtin_bit_cast(float, w & 0xffff0000u); }
constexpr int DM = 2048;
constexpr float NEPS = 1e-6f;

struct EpiZ {
    static constexpr bool PERM = true, AFTER_DRAIN = false;
    bf16_t* O; int ldc; const float* ssq;
    __device__ __forceinline__ void operator()(const f32x4 (&acc)[2][2][4][2], const Unit& u, int wr, int wc, int fr, int fq) const {
        const int row0 = u.pm * BM + wr * 64 + fr, col0 = u.pn * BM + wc * 32 + 8 * fq;
#pragma unroll
        for (int ai = 0; ai < 2; ++ai)
#pragma unroll
            for (int m = 0; m < 4; ++m) { const int row = row0 + ai * HALF + m * 16;
                const float sc = ssq ? rsqrtf(ssq[row] * (1.f / DM) + NEPS) : 1.f;
                bf16_t* rowp = O + (size_t)row * ldc + col0;
#pragma unroll
                for (int bj = 0; bj < 2; ++bj) { const f32x4 v0 = acc[ai][bj][m][0] * sc, v1 = acc[ai][bj][m][1] * sc;
                    u32x4 w; w.x = cvt_pk_bf16(v0[0], v0[1]); w.y = cvt_pk_bf16(v0[2], v0[3]); w.z = cvt_pk_bf16(v1[0], v1[1]); w.w = cvt_pk_bf16(v1[2], v1[3]);
                    *(u32x4*)(rowp + bj * HALF) = w; } }
    }
};

struct EpiRes {
    static constexpr bool PERM = true, AFTER_DRAIN = false;
    const bf16_t* res; bf16_t* hb; float* ssq;
    __device__ __forceinline__ void operator()(const f32x4 (&acc)[2][2][4][2], const Unit& u, int wr, int wc, int fr, int fq) const {
        const int row0 = u.pm * BM + wr * 64 + fr, col0 = u.pn * BM + wc * 32 + 8 * fq;
#pragma unroll
        for (int ai = 0; ai < 2; ++ai)
#pragma unroll
            for (int m = 0; m < 4; ++m) { const int row = row0 + ai * HALF + m * 16;
                const bf16_t* sp = res + (size_t)row * DM + col0; bf16_t* hp = hb + (size_t)row * DM + col0; float s = 0.f;
#pragma unroll
                for (int bj = 0; bj < 2; ++bj) { const u32x4 rw = *(const u32x4*)(sp + bj * HALF);
                    f32x4 v0 = acc[ai][bj][m][0], v1 = acc[ai][bj][m][1];
                    v0[0] += bf_lo(rw.x); v0[1] += bf_hi(rw.x); v0[2] += bf_lo(rw.y); v0[3] += bf_hi(rw.y);
                    v1[0] += bf_lo(rw.z); v1[1] += bf_hi(rw.z); v1[2] += bf_lo(rw.w); v1[3] += bf_hi(rw.w);
                    u32x4 w; w.x = cvt_pk_bf16(v0[0], v0[1]); w.y = cvt_pk_bf16(v0[2], v0[3]); w.z = cvt_pk_bf16(v1[0], v1[1]); w.w = cvt_pk_bf16(v1[2], v1[3]);
                    *(u32x4*)(hp + bj * HALF) = w;
                    s += v0[0] * v0[0] + v0[1] * v0[1] + v0[2] * v0[2] + v0[3] * v0[3] + v1[0] * v1[0] + v1[1] * v1[1] + v1[2] * v1[2] + v1[3] * v1[3]; }
                s += __shfl_xor(s, 16); s += __shfl_xor(s, 32);
                if (fq == 0) atomicAdd(ssq + row, s); }
    }
};

struct EpiGate {
    static constexpr bool PERM = true, AFTER_DRAIN = false;
    const float* ssq_in; const bf16_t* res; const bf16_t* pp; bf16_t* hb; float* ssq_out;
    __device__ __forceinline__ void operator()(const f32x4 (&acc)[2][2][4][2], const Unit& u, int wr, int wc, int fr, int fq) const {
        const int row0 = u.pm * BM + wr * 64 + fr, col0 = u.pn * BM + wc * 32 + 8 * fq;
#pragma unroll
        for (int ai = 0; ai < 2; ++ai)
#pragma unroll
            for (int m = 0; m < 4; ++m) { const int row = row0 + ai * HALF + m * 16;
                const float sc = rsqrtf(ssq_in[row] * (1.f / DM) + NEPS);
                const bf16_t* sp = res + (size_t)row * DM + col0; bf16_t* hp = hb + (size_t)row * DM + col0; const bf16_t* ppp = pp + (size_t)row * DM + col0; float s = 0.f;
#pragma unroll
                for (int bj = 0; bj < 2; ++bj) { const u32x4 rw = *(const u32x4*)(sp + bj * HALF); const u32x4 pw = *(const u32x4*)(ppp + bj * HALF);
                    const f32x4 a0 = acc[ai][bj][m][0] * sc, a1 = acc[ai][bj][m][1] * sc;
                    f32x4 v0, v1;
                    v0[0] = bf_lo(rw.x) + fast_sigmoid(a0[0]) * bf_lo(pw.x); v0[1] = bf_hi(rw.x) + fast_sigmoid(a0[1]) * bf_hi(pw.x);
                    v0[2] = bf_lo(rw.y) + fast_sigmoid(a0[2]) * bf_lo(pw.y); v0[3] = bf_hi(rw.y) + fast_sigmoid(a0[3]) * bf_hi(pw.y);
                    v1[0] = bf_lo(rw.z) + fast_sigmoid(a1[0]) * bf_lo(pw.z); v1[1] = bf_hi(rw.z) + fast_sigmoid(a1[1]) * bf_hi(pw.z);
                    v1[2] = bf_lo(rw.w) + fast_sigmoid(a1[2]) * bf_lo(pw.w); v1[3] = bf_hi(rw.w) + fast_sigmoid(a1[3]) * bf_hi(pw.w);
                    u32x4 w; w.x = cvt_pk_bf16(v0[0], v0[1]); w.y = cvt_pk_bf16(v0[2], v0[3]); w.z = cvt_pk_bf16(v1[0], v1[1]); w.w = cvt_pk_bf16(v1[2], v1[3]);
                    *(u32x4*)(hp + bj * HALF) = w;
                    s += v0[0] * v0[0] + v0[1] * v0[1] + v0[2] * v0[2] + v0[3] * v0[3] + v1[0] * v1[0] + v1[1] * v1[1] + v1[2] * v1[2] + v1[3] * v1[3]; }
                s += __shfl_xor(s, 16); s += __shfl_xor(s, 32);
                if (fq == 0) atomicAdd(ssq_out + row, s); }
    }
};
template <class Epi, class Sched, bool ALIGN_EPI = false, bool SP2 = false>
__device__ __forceinline__ void gemm_phase(PG8_LAS unsigned char* lds, const Gemm g, const Sched& S, const Epi& E) {
    int tid_ = threadIdx.x; asm volatile("" : "+v"(tid_));
    const int tid = tid_, wid = __builtin_amdgcn_readfirstlane(tid >> 6), lane = tid & 63, wr = wid >> 2, wc = wid & 3, fr = lane & 15, fq = lane >> 4;
    int K_ = g.K; asm volatile("" : "+s"(K_));
    const int K = K_, nt = K / BK;
    unsigned voffA[2], voffB[2];
#pragma unroll
    for (int i = 0; i < 2; ++i) { int R, C; stage_rc(tid * 16 + i * 8192, R, C); const int Rb = Epi::PERM ? ((R & ~31) + perm32(R & 31)) : R;
        voffA[i] = (unsigned)(R * K + C) * 2u; voffB[i] = (unsigned)(Rb * K + C) * 2u; }
    const size_t kstep = (size_t)(BK * 2);
    const size_t hstep = (size_t)HALF * K * 2;
    const size_t tstep = 2 * hstep;
    const unsigned ldsw = (unsigned)wid * 1024u;
    const int aoff = lds_byte(wr * 64 + fr, fq * 8), boff = lds_byte(wc * 32 + fr, fq * 8);
#define PG8_SA(b, h) (((b) * 2 + (h)) * HTB)
#define PG8_SB(b, h) ((4 + (b) * 2 + (h)) * HTB)
#define PG8_STAGE(bufoff, gbase, voff) do { _Pragma("unroll") for (int _i = 0; _i < 2; ++_i) \
        __builtin_amdgcn_global_load_lds((const unsigned*)((const char*)(gbase) + (voff)[_i]), (PG8_LAS unsigned*)(lds + (bufoff) + ldsw + _i * 8192), 16, 0, 0); } while (0)
#define PG8_LDA(dst, b, h) do { _Pragma("unroll") for (int m = 0; m < 4; ++m) _Pragma("unroll") for (int k = 0; k < 2; ++k) dst[m][k] = *(const PG8_LAS bf16x8*)(lds + PG8_SA(b, h) + aoff + m * 2048 + k * 1024); } while (0)
#define PG8_LDB(dst, b, h) do { _Pragma("unroll") for (int n = 0; n < 2; ++n) _Pragma("unroll") for (int k = 0; k < 2; ++k) dst[n][k] = *(const PG8_LAS bf16x8*)(lds + PG8_SB(b, h) + boff + n * 2048 + k * 1024); } while (0)
#define PG8_MMA(ai, bj, At, Bt) do { __builtin_amdgcn_s_setprio(1); _Pragma("unroll") for (int m = 0; m < 4; ++m) _Pragma("unroll") for (int n = 0; n < 2; ++n) _Pragma("unroll") for (int k = 0; k < 2; ++k) \
        acc[ai][bj][m][n] = __builtin_amdgcn_mfma_f32_16x16x32_bf16(Bt[n][k], At[m][k], acc[ai][bj][m][n], 0, 0, 0); __builtin_amdgcn_s_setprio(0); } while (0)
#define PG8_WAIT_V(n) asm volatile("s_waitcnt vmcnt(" #n ")" ::: "memory")
#define PG8_WAIT_L(n) asm volatile("s_waitcnt lgkmcnt(" #n ")" ::: "memory")
#define PG8_BAR __builtin_amdgcn_s_barrier()
#define PG8_SCHED __builtin_amdgcn_sched_barrier(0)
    Unit cur, nxt; int ui = 0;
    if (!S.next(0, cur)) return;
    f32x4 acc[2][2][4][2];
#pragma unroll
    for (int a = 0; a < 2; ++a)
#pragma unroll
        for (int b = 0; b < 2; ++b)
#pragma unroll
            for (int m = 0; m < 4; ++m)
#pragma unroll
                for (int n = 0; n < 2; ++n) acc[a][b][m][n] = (f32x4){0.f, 0.f, 0.f, 0.f};
    bf16x8 At[4][2], B0[2][2], B1[2][2];
    const char* cA = (const char*)g.A + (size_t)cur.pm * tstep; const char* cB = (const char*)g.Bt + (size_t)cur.pn * tstep;
    S.a_ready(cur);
    if constexpr (SP2) {
        PG8_STAGE(PG8_SB(0, 0), cB, voffB); PG8_STAGE(PG8_SB(0, 1), cB + hstep, voffB); PG8_STAGE(PG8_SA(0, 0), cA, voffA); PG8_STAGE(PG8_SA(0, 1), cA + hstep, voffA);
        if (wr == 1) PG8_BAR;
        PG8_WAIT_V(2); PG8_BAR;
        PG8_STAGE(PG8_SB(1, 0), cB + kstep, voffB); PG8_STAGE(PG8_SA(1, 0), cA + kstep, voffA); PG8_STAGE(PG8_SB(1, 1), cB + hstep + kstep, voffB);
        PG8_WAIT_V(6); PG8_BAR;
    } else {
        PG8_STAGE(PG8_SB(0, 0), cB, voffB); PG8_STAGE(PG8_SA(0, 0), cA, voffA); PG8_STAGE(PG8_SB(0, 1), cB + hstep, voffB); PG8_STAGE(PG8_SA(0, 1), cA + hstep, voffA);
        if (wr == 1) PG8_BAR;
        PG8_WAIT_V(4); PG8_BAR;
        PG8_STAGE(PG8_SB(1, 0), cB + kstep, voffB); PG8_STAGE(PG8_SA(1, 0), cA + kstep, voffA); PG8_STAGE(PG8_SB(1, 1), cB + hstep + kstep, voffB);
        PG8_WAIT_V(6); PG8_BAR;
    }
    for (;;) {
        const bool has_next = S.next(ui + 1, nxt);
        const char* nA = has_next ? (const char*)g.A + (size_t)nxt.pm * tstep : cA; const char* nB = has_next ? (const char*)g.Bt + (size_t)nxt.pn * tstep : cB;
        for (int t = 0; t < nt; t += 2) {
            const bool last = (t == nt - 2);
            const char* a1 = cA + (size_t)(t + 1) * kstep;
            const char* a2 = last ? nA : cA + (size_t)(t + 2) * kstep; const char* b2 = last ? nB : cB + (size_t)(t + 2) * kstep;
            const char* a3 = a2 + kstep; const char* b3 = b2 + kstep;
            if (last && has_next) S.a_ready(nxt);
            if constexpr (SP2) {
            PG8_LDB(B0, 0, 0); PG8_LDB(B1, 0, 1); PG8_SCHED; PG8_LDA(At, 0, 0); PG8_STAGE(PG8_SA(1, 1), a1 + hstep, voffA);
            PG8_WAIT_V(8); PG8_WAIT_L(0); PG8_BAR; PG8_MMA(0, 0, At, B0); PG8_MMA(0, 1, At, B1); PG8_BAR; PG8_SCHED;
            PG8_LDA(At, 0, 1); PG8_STAGE(PG8_SB(0, 0), b2, voffB); PG8_STAGE(PG8_SB(0, 1), b2 + hstep, voffB); PG8_STAGE(PG8_SA(0, 0), a2, voffA);
            PG8_WAIT_V(8); PG8_WAIT_L(0); PG8_BAR; PG8_MMA(1, 0, At, B0); PG8_MMA(1, 1, At, B1); PG8_BAR; PG8_SCHED;
            PG8_LDB(B0, 1, 0); PG8_LDB(B1, 1, 1); PG8_SCHED; PG8_LDA(At, 1, 0); PG8_STAGE(PG8_SA(0, 1), a2 + hstep, voffA);
            PG8_WAIT_V(8); PG8_WAIT_L(0); PG8_BAR; PG8_MMA(0, 0, At, B0); PG8_MMA(0, 1, At, B1); PG8_BAR; PG8_SCHED;
            PG8_LDA(At, 1, 1); PG8_STAGE(PG8_SB(1, 0), b3, voffB); PG8_STAGE(PG8_SB(1, 1), b3 + hstep, voffB); PG8_STAGE(PG8_SA(1, 0), a3, voffA);
            PG8_WAIT_V(8); PG8_WAIT_L(0); PG8_BAR; PG8_MMA(1, 0, At, B0); PG8_MMA(1, 1, At, B1); PG8_BAR; PG8_SCHED;
            } else {
            PG8_LDB(B0, 0, 0); PG8_SCHED; PG8_LDA(At, 0, 0); PG8_STAGE(PG8_SA(1, 1), a1 + hstep, voffA);
            PG8_WAIT_L(8); PG8_BAR; PG8_WAIT_L(0); PG8_MMA(0, 0, At, B0); PG8_BAR; PG8_SCHED;
            PG8_LDB(B1, 0, 1); PG8_STAGE(PG8_SB(0, 0), b2, voffB);
            PG8_BAR; PG8_WAIT_L(0); PG8_MMA(0, 1, At, B1); PG8_BAR;
            PG8_LDA(At, 0, 1); PG8_STAGE(PG8_SA(0, 0), a2, voffA);
            PG8_BAR; PG8_WAIT_L(0); PG8_MMA(1, 0, At, B0); PG8_BAR; PG8_SCHED;
            PG8_STAGE(PG8_SB(0, 1), b2 + hstep, voffB);
            PG8_WAIT_V(6); PG8_BAR; PG8_MMA(1, 1, At, B1); PG8_BAR;
            PG8_LDB(B0, 1, 0); PG8_SCHED; PG8_LDA(At, 1, 0); PG8_STAGE(PG8_SA(0, 1), a2 + hstep, voffA);
            PG8_WAIT_L(8); PG8_BAR; PG8_WAIT_L(0); PG8_MMA(0, 0, At, B0); PG8_BAR; PG8_SCHED;
            PG8_LDB(B1, 1, 1); PG8_STAGE(PG8_SB(1, 0), b3, voffB);
            PG8_BAR; PG8_WAIT_L(0); PG8_MMA(0, 1, At, B1); PG8_BAR;
            PG8_LDA(At, 1, 1); PG8_STAGE(PG8_SA(1, 0), a3, voffA);
            PG8_BAR; PG8_WAIT_L(0); PG8_MMA(1, 0, At, B0); PG8_BAR; PG8_SCHED;
            PG8_STAGE(PG8_SB(1, 1), b3 + hstep, voffB);
            PG8_WAIT_V(6); PG8_BAR; PG8_MMA(1, 1, At, B1); PG8_BAR;
            }
        }
        if constexpr (ALIGN_EPI) { if (wr == 0) PG8_BAR; }
        if constexpr (!Epi::AFTER_DRAIN) { E(acc, cur, wr, wc, fr, fq); S.done(cur); }
        if (!has_next) break;
#pragma unroll
        for (int a = 0; a < 2; ++a)
#pragma unroll
            for (int b = 0; b < 2; ++b)
#pragma unroll
                for (int m = 0; m < 4; ++m)
#pragma unroll
                    for (int n = 0; n < 2; ++n) acc[a][b][m][n] = (f32x4){0.f, 0.f, 0.f, 0.f};
        cur = nxt; cA = nA; cB = nB; ++ui;
        if constexpr (ALIGN_EPI) { if (wr == 1) PG8_BAR; }
    }
    PG8_WAIT_V(0);
    if constexpr (!ALIGN_EPI) { if (wr == 0) PG8_BAR; }
    PG8_BAR;
    if constexpr (Epi::AFTER_DRAIN) { E.fused(acc, cur, wr, wc, fr, fq, lds, wid, lane); S.done(cur); }
#undef PG8_SA
#undef PG8_SB
#undef PG8_STAGE
#undef PG8_LDA
#undef PG8_LDB
#undef PG8_MMA
#undef PG8_WAIT_V
#undef PG8_WAIT_L
#undef PG8_BAR
#undef PG8_SCHED
}
}
#define LAS __attribute__((address_space(3)))
typedef unsigned short bf16;
typedef unsigned v4u __attribute__((ext_vector_type(4)));
typedef unsigned v2u __attribute__((ext_vector_type(2)));
typedef float v2f __attribute__((ext_vector_type(2)));
typedef float f32x4 __attribute__((ext_vector_type(4)));
typedef float f32x16 __attribute__((ext_vector_type(16)));
typedef short bf16x8 __attribute__((ext_vector_type(8)));
typedef short s16x4 __attribute__((ext_vector_type(4)));
constexpr int MTOK = 32768, DMOD = 2048, NZ = 5632, PLE = 256, NCHUNK = MTOK / 128;
constexpr int ZQ = 0, ZK = 1024, ZV = 1280, ZGA = 1536, ZCB = 2560, ZCC = 3072, ZCX = 3584, ZGC = 4096, ZXL = 4608, ZGL = 5120;
constexpr float LOG2E = 1.4426950408889634f;
constexpr int NWAVES = 8, NTHR = 512;
constexpr int LDS_BYTES = 147456;
constexpr size_t MiB = 1u << 20;
constexpr size_t WS_SSQ = 0;
constexpr size_t WS_AGG = 1 * MiB;
constexpr size_t WS_WL = 3 * MiB;
constexpr size_t WS_WPROJ = 4 * MiB;
constexpr size_t WS_CTL = 6 * MiB, CTL_BYTES = 16384;
constexpr size_t WS_WIN = 8 * MiB;
constexpr size_t WS_WOUT = 52 * MiB;
constexpr size_t WS_WGATE = 68 * MiB;
constexpr size_t WS_PB = 84 * MiB;
constexpr size_t WS_HBA = 116 * MiB;
constexpr size_t WS_HBB = 244 * MiB;
constexpr size_t WS_MIX = 372 * MiB;
constexpr size_t WS_PP = 500 * MiB;
constexpr size_t WS_Z = 628 * MiB;
constexpr size_t WS_END = 980 * MiB;

struct Params {
    const float *x_prompt, *x_sample, *p_prompt, *p_sample, *norm_mix, *w_in, *w_out, *rel_bias, *attn_sink, *conv_w, *lru_conv_w, *lru_conv_b,
                *lru_w_a, *lru_b_a, *lru_w_i, *lru_b_i, *lru_L, *ple_norm, *ple_w_gate, *ple_w_proj, *final_norm;
    float* out; unsigned char* ws;
};

__device__ __forceinline__ unsigned f2bf(float f) { unsigned u = __builtin_bit_cast(unsigned, f); return (u + 0x7fffu + ((u >> 16) & 1u)) >> 16; }
__device__ __forceinline__ unsigned pk2(float lo, float hi) { unsigned r; asm("v_cvt_pk_bf16_f32 %0, %1, %2" : "=v"(r) : "v"(lo), "v"(hi)); return r; }
__device__ __forceinline__ float bflo(unsigned w) { return __builtin_bit_cast(float, w << 16); }
__device__ __forceinline__ float bfhi(unsigned w) { return __builtin_bit_cast(float, w & 0xffff0000u); }
__device__ __forceinline__ float bf1(bf16 v) { return __builtin_bit_cast(float, (unsigned)v << 16); }
__device__ __forceinline__ float sigm(float x) { return __builtin_amdgcn_rcpf(1.f + __expf(-x)); }
__device__ __forceinline__ float silu(float x) { return x * sigm(x); }
__device__ __forceinline__ float wave_sum(float v) {
#pragma unroll
    for (int o = 1; o < 64; o <<= 1) v += __shfl_xor(v, o);
    return v;
}
__device__ __forceinline__ void seq_of_chunk(int c, int& s0, int& ns) { if (c < 128) { s0 = c & ~63; ns = 64; } else { s0 = c & ~15; ns = 16; } }

struct TrDesc { const float* W; bf16* WT; const float* ks; int K, N, k0, n0; };
__device__ __forceinline__ void tr_load(const TrDesc& d, int lane, f32x4 (&v)[16]) {
    const float* p = d.W + (size_t)(d.k0 + (lane >> 4)) * d.N + d.n0 + 4 * (lane & 15);
#pragma unroll
    for (int i = 0; i < 16; ++i) v[i] = *(const f32x4*)(p + (size_t)(4 * i) * d.N);
}
__device__ __forceinline__ void tr_store(const TrDesc& d, int lane, const f32x4 (&v)[16], LAS float* scr) {
#pragma unroll
    for (int i = 0; i < 16; ++i) { const int kk = 4 * i + (lane >> 4); const float sc = d.ks ? d.ks[d.k0 + kk] : 1.f; LAS float* q = scr + kk * 65 + 4 * (lane & 15);
        q[0] = v[i][0] * sc; q[1] = v[i][1] * sc; q[2] = v[i][2] * sc; q[3] = v[i][3] * sc; }
    asm volatile("s_waitcnt lgkmcnt(0)" ::: "memory");
    const int c = lane & 7;
#pragma unroll
    for (int j = 0; j < 8; ++j) { const int n = (lane >> 3) + 8 * j; const LAS float* s = scr + (8 * c) * 65 + n;
        v4u o; o.x = pk2(s[0 * 65], s[1 * 65]); o.y = pk2(s[2 * 65], s[3 * 65]); o.z = pk2(s[4 * 65], s[5 * 65]); o.w = pk2(s[6 * 65], s[7 * 65]);
        *(v4u*)(d.WT + (size_t)(d.n0 + n) * d.K + d.k0 + 8 * c) = o; }
    asm volatile("s_waitcnt lgkmcnt(0)" ::: "memory");
}
constexpr int TI_IN = (DMOD / 64) * (NZ / 64), TI_SQ = (DMOD / 64) * (DMOD / 64), TI_PR = (PLE / 64) * (DMOD / 64), TI_L1 = 4, TI_L = 16 * TI_L1;
constexpr int TI_LAYER = TI_IN + 2 * TI_SQ + TI_PR + TI_L;
__device__ __forceinline__ TrDesc tr_decode(const Params& P, int it) {
    unsigned char* ws = P.ws; TrDesc d; const int l = it / TI_LAYER; int r = it % TI_LAYER;
    if (r < TI_IN) { d.W = P.w_in + (size_t)l * DMOD * NZ; d.K = DMOD; d.N = NZ; d.WT = (bf16*)(ws + WS_WIN) + (size_t)l * NZ * DMOD; d.ks = P.norm_mix + l * DMOD; }
    else if ((r -= TI_IN) < TI_SQ) { d.W = P.w_out + (size_t)l * DMOD * DMOD; d.K = DMOD; d.N = DMOD; d.WT = (bf16*)(ws + WS_WOUT) + (size_t)l * DMOD * DMOD; d.ks = nullptr; }
    else if ((r -= TI_SQ) < TI_SQ) { d.W = P.ple_w_gate + (size_t)l * DMOD * DMOD; d.K = DMOD; d.N = DMOD; d.WT = (bf16*)(ws + WS_WGATE) + (size_t)l * DMOD * DMOD; d.ks = P.ple_norm + l * DMOD; }
    else if ((r -= TI_SQ) < TI_PR) { d.W = P.ple_w_proj + (size_t)l * PLE * DMOD; d.K = PLE; d.N = DMOD; d.WT = (bf16*)(ws + WS_WPROJ) + (size_t)l * DMOD * PLE; d.ks = nullptr; }
    else { r -= TI_PR; const int mat = r / TI_L1; r = r % TI_L1;
        const int dir = mat >> 3, which = (mat >> 2) & 1, h = mat & 3;
        d.W = (which ? P.lru_w_i : P.lru_w_a) + ((size_t)((l * 2 + dir) * 4 + h)) * 128 * 128; d.K = 128; d.N = 128;
        d.WT = (bf16*)(ws + WS_WL) + ((size_t)(((l * 2 + dir) * 2 + which) * 4 + h)) * 128 * 128; d.ks = nullptr; }
    const int nblk = d.N / 64; d.k0 = 64 * (r / nblk); d.n0 = 64 * (r % nblk);
    return d;
}

__device__ __forceinline__ void p0_prologue(const Params& P, LAS unsigned char* lds, int tid, int G) {
    asm volatile("" : "+v"(tid));
    const int lane = tid & 63, wave = tid >> 6;
    const int gw = blockIdx.x * NWAVES + wave, NGW = G * NWAVES;
    const long gt = (long)blockIdx.x * NTHR + tid, NGT = (long)G * NTHR;
    unsigned char* ws = P.ws;
    { float* ssq = (float*)(ws + WS_SSQ); for (long i = gt; i < 4L * MTOK; i += NGT) ssq[MTOK + i] = 0.f; }
    { LAS float* scr = (LAS float*)(lds + wave * 16640);
      int it = gw; TrDesc d; f32x4 va[16];
      if (it < 2 * TI_LAYER) { d = tr_decode(P, it); tr_load(d, lane, va); }
      while (it < 2 * TI_LAYER) {
          const int nx = it + NGW; TrDesc dn = d; f32x4 vb[16];
          if (nx < 2 * TI_LAYER) { dn = tr_decode(P, nx); tr_load(dn, lane, vb); }
          tr_store(d, lane, va, scr);
          it = nx; d = dn;
#pragma unroll
          for (int i = 0; i < 16; ++i) va[i] = vb[i];
      } }
    { bf16* hbA = (bf16*)(ws + WS_HBA); float* ssq = (float*)(ws + WS_SSQ);
      for (int row = gw; row < MTOK; row += NGW) {
          const float* xr = (row < 16384 ? P.x_prompt + (size_t)row * DMOD : P.x_sample + (size_t)(row - 16384) * DMOD);
          float s = 0.f;
#pragma unroll
          for (int j = 0; j < 8; ++j) { const f32x4 v = *(const f32x4*)(xr + 4 * lane + 256 * j); s += v[0] * v[0] + v[1] * v[1] + v[2] * v[2] + v[3] * v[3];
              v2u o; o.x = pk2(v[0], v[1]); o.y = pk2(v[2], v[3]); *(v2u*)(hbA + (size_t)row * DMOD + 4 * lane + 256 * j) = o; }
          s = wave_sum(s); if (lane == 0) ssq[row] = s; } }
    { bf16* pb = (bf16*)(ws + WS_PB);
      for (long i = gt; i < 2L * MTOK * PLE / 4; i += NGT) { const long e = i * 4; const int l = (int)(e / ((long)MTOK * PLE)); const long r = e % ((long)MTOK * PLE);
          const float* src = (r < 16384L * PLE) ? P.p_prompt + (size_t)l * 16384 * PLE + r : P.p_sample + (size_t)l * 16384 * PLE + (r - 16384L * PLE);
          const f32x4 v = *(const f32x4*)src; v2u o; o.x = pk2(v[0], v[1]); o.y = pk2(v[2], v[3]); *(v2u*)(pb + e) = o; } }
}

__device__ __forceinline__ int t5_bucket(int rel) {
    const int n = rel < 0 ? -rel : rel;
    int b = n < 8 ? n : 8 + (n >= 12) + (n >= 16) + (n >= 23) + (n >= 32) + (n >= 46) + (n >= 64) + (n >= 91);
    return b + (rel > 0 ? 16 : 0);
}
constexpr int AT_KP = 272, AT_VP = 320, AT_KB = 64 * AT_KP, AT_VB = 64 * AT_VP, AT_V0 = 2 * AT_KB, AT_TAB = AT_V0 + 2 * AT_VB, AT_TW = 384;

__device__ __forceinline__ void attn_build_tab(LAS unsigned char* lds, const float* rel_bias, int tid) {
    asm volatile("" : "+v"(tid));
    LAS float* tab = (LAS float*)(lds + AT_TAB);
    for (int i = tid; i < 8 * AT_TW; i += NTHR) { const int hd = i / AT_TW, rel = i % AT_TW - 192;
        tab[i] = (rel >= -128 && rel <= 128) ? rel_bias[t5_bucket(rel) * 8 + hd] * LOG2E : -1.0e30f; }
}

__device__ __forceinline__ void attn_item(LAS unsigned char* lds, int item, const bf16* z, bf16* mix, const float* sink, int tid) {
    asm volatile("" : "+v"(tid));
    const int c = item >> 2, kvh = (item >> 1) & 1, qhalf = item & 1;
    int s0, ns; seq_of_chunk(c, s0, ns);
    const int w = tid >> 6, lane = tid & 63, ql = lane & 31, h = lane >> 5;
    const int head = kvh * 4 + (w >> 1);
    const int tb = c * 128, tq = tb + qhalf * 64 + (w & 1) * 32 + ql;
    const int seq_lo = s0 * 128, seq_hi = (s0 + ns) * 128, kwin0 = tb - 128 + qhalf * 64;
    int j_lo = 0, j_hi = 4;
    while (kwin0 + 64 * j_lo < seq_lo) ++j_lo;
    while (kwin0 + 64 * j_hi + 64 > seq_hi) --j_hi;
    bf16x8 qf[8];
    { const bf16* qp = z + (size_t)tq * NZ + ZQ + head * 128 + 8 * h;
#pragma unroll
      for (int ks = 0; ks < 8; ++ks) qf[ks] = *(const bf16x8*)(qp + 16 * ks); }
    float m = sink[head] * LOG2E, lsum = (h == 0) ? 1.f : 0.f;
    f32x16 O[4];
#pragma unroll
    for (int dt = 0; dt < 4; ++dt)
#pragma unroll
        for (int i = 0; i < 16; ++i) O[dt][i] = 0.f;
    const LAS float* tabh = (const LAS float*)(lds + AT_TAB) + head * AT_TW;
    const float c1 = 0.08838834764831845f * LOG2E;
    v4u stg[4];
    const int pkey = tid >> 4, pc = tid & 15;
    auto prefetch = [&](int j) {
        const bf16* base = z + (size_t)(kwin0 + 64 * j + pkey) * NZ + kvh * 128 + pc * 8;
        stg[0] = *(const v4u*)(base + ZK); stg[1] = *(const v4u*)(base + ZK + (size_t)32 * NZ);
        stg[2] = *(const v4u*)(base + ZV); stg[3] = *(const v4u*)(base + ZV + (size_t)32 * NZ);
    };
    prefetch(j_lo);
    const int g4 = lane >> 4, q4 = (lane & 15) >> 2, p4 = lane & 3;
    for (int j = j_lo; j <= j_hi; ++j) {
        LAS unsigned char* Kb = lds + (j & 1) * AT_KB; LAS unsigned char* Vb = lds + AT_V0 + (j & 1) * AT_VB;
        *(LAS v4u*)(Kb + pkey * AT_KP + pc * 16) = stg[0]; *(LAS v4u*)(Kb + (pkey + 32) * AT_KP + pc * 16) = stg[1];
        *(LAS v4u*)(Vb + pkey * AT_VP + pc * 16) = stg[2]; *(LAS v4u*)(Vb + (pkey + 32) * AT_VP + pc * 16) = stg[3];
        if (j < j_hi) prefetch(j + 1);
        __syncthreads();
        f32x16 s[2];
#pragma unroll
        for (int kt = 0; kt < 2; ++kt) {
#pragma unroll
            for (int i = 0; i < 16; ++i) s[kt][i] = 0.f;
#pragma unroll
            for (int ks = 0; ks < 8; ++ks) { const bf16x8 kf = *(const LAS bf16x8*)(Kb + (kt * 32 + ql) * AT_KP + (16 * ks + 8 * h) * 2);
                s[kt] = __builtin_amdgcn_mfma_f32_32x32x16_bf16(kf, qf[ks], s[kt], 0, 0, 0); }
        }
        float mx = -3.0e38f;
#pragma unroll
        for (int kt = 0; kt < 2; ++kt) { const LAS float* tp = tabh + ((kwin0 + 64 * j + 32 * kt + 4 * h) - tq + 192);
#pragma unroll
            for (int i = 0; i < 16; ++i) { const float t = s[kt][i] * c1 + tp[(i & 3) + 8 * (i >> 2)]; s[kt][i] = t; mx = fmaxf(mx, t); } }
        mx = fmaxf(mx, __shfl_xor(mx, 32));
        const float mn = fmaxf(m, mx), alpha = __builtin_amdgcn_exp2f(m - mn); m = mn;
        float ps = 0.f;
#pragma unroll
        for (int kt = 0; kt < 2; ++kt)
#pragma unroll
            for (int i = 0; i < 16; ++i) { const float p = __builtin_amdgcn_exp2f(s[kt][i] - mn); s[kt][i] = p; ps += p; }
        lsum = lsum * alpha + ps;
        if (__any(alpha != 1.f)) {
#pragma unroll
            for (int dt = 0; dt < 4; ++dt)
#pragma unroll
                for (int i = 0; i < 16; ++i) O[dt][i] *= alpha;
        }
#pragma unroll
        for (int kt = 0; kt < 2; ++kt)
#pragma unroll
            for (int s2 = 0; s2 < 2; ++s2) {
                v4u pw; pw.x = pk2(s[kt][8 * s2 + 0], s[kt][8 * s2 + 1]); pw.y = pk2(s[kt][8 * s2 + 2], s[kt][8 * s2 + 3]);
                pw.z = pk2(s[kt][8 * s2 + 4], s[kt][8 * s2 + 5]); pw.w = pk2(s[kt][8 * s2 + 6], s[kt][8 * s2 + 7]);
                const bf16x8 pf = __builtin_bit_cast(bf16x8, pw);
                const LAS unsigned char* vrow = Vb + (32 * kt + 16 * s2 + 4 * h + q4) * AT_VP + (16 * (g4 & 1) + 4 * p4) * 2;
#pragma unroll
                for (int dt = 0; dt < 4; ++dt) {
                    const s16x4 lo = __builtin_amdgcn_ds_read_tr16_b64_v4i16((LAS s16x4*)(vrow + dt * 64));
                    const s16x4 hi = __builtin_amdgcn_ds_read_tr16_b64_v4i16((LAS s16x4*)(vrow + dt * 64 + 8 * AT_VP));
                    const bf16x8 vf = __builtin_shufflevector(lo, hi, 0, 1, 2, 3, 4, 5, 6, 7);
                    O[dt] = __builtin_amdgcn_mfma_f32_32x32x16_bf16(vf, pf, O[dt], 0, 0, 0);
                }
            }
    }
    const float ltot = lsum + __shfl_xor(lsum, 32), inv = 1.f / ltot;
    const bf16* gp = z + (size_t)tq * NZ + ZGA + head * 128 + 4 * h; bf16* op = mix + (size_t)tq * DMOD + head * 128 + 4 * h;
#pragma unroll
    for (int dt = 0; dt < 4; ++dt)
#pragma unroll
        for (int rg = 0; rg < 4; ++rg) { const v2u gw = *(const v2u*)(gp + 32 * dt + 8 * rg);
            const float o0 = O[dt][4 * rg + 0] * inv * silu(bflo(gw.x)), o1 = O[dt][4 * rg + 1] * inv * silu(bfhi(gw.x));
            const float o2 = O[dt][4 * rg + 2] * inv * silu(bflo(gw.y)), o3 = O[dt][4 * rg + 3] * inv * silu(bfhi(gw.y));
            v2u ow; ow.x = pk2(o0, o1); ow.y = pk2(o2, o3); *(v2u*)(op + 32 * dt + 8 * rg) = ow; }
    __syncthreads();
}

__device__ __forceinline__ void conv_phase(const bf16* z, bf16* mix, const float* cw  , int G, int tid) {
    asm volatile("" : "+v"(tid));
    const long NW = (long)MTOK * 64;
    for (long i = (long)blockIdx.x * NTHR + tid; i < NW; i += (long)G * NTHR) {
        const int t = (int)(i >> 6), cg8 = (int)(i & 63) * 8;
        int s0, ns; seq_of_chunk(t >> 7, s0, ns);
        const bool hasp = t > s0 * 128, hasn = t + 1 < (s0 + ns) * 128;
        const bf16* zr = z + (size_t)t * NZ;
        const v4u cb = *(const v4u*)(zr + ZCB + cg8), gc = *(const v4u*)(zr + ZGC + cg8);
        const v4u c1 = *(const v4u*)(zr + ZCC + cg8), x1 = *(const v4u*)(zr + ZCX + cg8);
        v4u c0 = {0, 0, 0, 0}, x0 = {0, 0, 0, 0}, c2 = {0, 0, 0, 0}, x2 = {0, 0, 0, 0};
        if (hasp) { c0 = *(const v4u*)(zr - NZ + ZCC + cg8); x0 = *(const v4u*)(zr - NZ + ZCX + cg8); }
        if (hasn) { c2 = *(const v4u*)(zr + NZ + ZCC + cg8); x2 = *(const v4u*)(zr + NZ + ZCX + cg8); }
        float o[8];
#pragma unroll
        for (int e = 0; e < 4; ++e) {
#pragma unroll
            for (int hh = 0; hh < 2; ++hh) { const int ch = cg8 + 2 * e + hh;
                const float a0 = hh ? bfhi(c0[e]) * bfhi(x0[e]) : bflo(c0[e]) * bflo(x0[e]);
                const float a1 = hh ? bfhi(c1[e]) * bfhi(x1[e]) : bflo(c1[e]) * bflo(x1[e]);
                const float a2 = hh ? bfhi(c2[e]) * bfhi(x2[e]) : bflo(c2[e]) * bflo(x2[e]);
                const float cv = cw[ch] * a0 + cw[512 + ch] * a1 + cw[1024 + ch] * a2;
                const float b = hh ? bfhi(cb[e]) : bflo(cb[e]), g = hh ? bfhi(gc[e]) : bflo(gc[e]);
                o[2 * e + hh] = b * cv * silu(g); } }
        v4u ow; ow.x = pk2(o[0], o[1]); ow.y = pk2(o[2], o[3]); ow.z = pk2(o[4], o[5]); ow.w = pk2(o[6], o[7]);
        *(v4u*)(mix + (size_t)t * DMOD + 1024 + cg8) = ow;
    }
}

constexpr int LR_XC = 0, LR_XCP = 272, LR_PB = 128 * LR_XCP, LR_Y = 2 * 128 * LR_XCP, LR_YP = 132;
struct LruLayer { const float *cw, *cb, *ba, *bi, *L; const bf16* WL; };
__device__ __forceinline__ void lru_heavy(LAS unsigned char* lds, int item, const bf16* z, const LruLayer& LP, float* agg, bf16* LL, bf16* PFB  , int tid) {
    asm volatile("" : "+v"(tid));
    const int c = item >> 2, hh = item & 3;
    int s0, ns; seq_of_chunk(c, s0, ns);
    const int w = tid >> 6, lane = tid & 63, tb = c * 128, seq_lo = s0 * 128, seq_hi = (s0 + ns) * 128;
    const int chl = 16 * w + (lane & 15), chg = hh * 128 + chl, q = lane >> 4;
    LAS float* Y = (LAS float*)(lds + LR_Y);
#pragma unroll 1
    for (int dir = 0; dir < 2; ++dir) {
        for (int p = tid; p < 128 * 16; p += NTHR) { const int t = p >> 4, pc = p & 15; const int tok0 = tb + t + (dir ? 0 : -3);
            const float* cb = LP.cb + dir * 512 + hh * 128 + pc * 8;
            f32x4 a0 = *(const f32x4*)cb, a1 = *(const f32x4*)(cb + 4);
#pragma unroll
            for (int k = 0; k < 4; ++k) { const int tok = tok0 + k; v4u xv = {0, 0, 0, 0};
                if (tok >= seq_lo && tok < seq_hi) xv = *(const v4u*)(z + (size_t)tok * NZ + ZXL + hh * 128 + pc * 8);
                const float* wk = LP.cw + (dir * 4 + k) * 512 + hh * 128 + pc * 8; const f32x4 w0 = *(const f32x4*)wk, w1 = *(const f32x4*)(wk + 4);
                a0[0] += w0[0] * bflo(xv[0]); a0[1] += w0[1] * bfhi(xv[0]); a0[2] += w0[2] * bflo(xv[1]); a0[3] += w0[3] * bfhi(xv[1]);
                a1[0] += w1[0] * bflo(xv[2]); a1[1] += w1[1] * bfhi(xv[2]); a1[2] += w1[2] * bflo(xv[3]); a1[3] += w1[3] * bfhi(xv[3]); }
            v4u o; o.x = pk2(a0[0], a0[1]); o.y = pk2(a0[2], a0[3]); o.z = pk2(a1[0], a1[1]); o.w = pk2(a1[2], a1[3]);
            const int s = dir ? 127 - t : t;
            *(LAS v4u*)(lds + LR_XC + s * LR_XCP + pc * 16) = o; }
        __syncthreads();
        f32x4 ar[8], ai[8];
#pragma unroll
        for (int mt = 0; mt < 8; ++mt) { ar[mt] = (f32x4){0.f, 0.f, 0.f, 0.f}; ai[mt] = (f32x4){0.f, 0.f, 0.f, 0.f}; }
        { const bf16* wa = LP.WL + ((size_t)((dir * 2 + 0) * 4 + hh)) * 16384 + (size_t)chl * 128 + 8 * q;
          const bf16* wi = LP.WL + ((size_t)((dir * 2 + 1) * 4 + hh)) * 16384 + (size_t)chl * 128 + 8 * q;
#pragma unroll
          for (int ks = 0; ks < 4; ++ks) { const bf16x8 bA = *(const bf16x8*)(wa + 32 * ks), bI = *(const bf16x8*)(wi + 32 * ks);
#pragma unroll
              for (int mt = 0; mt < 8; ++mt) { const bf16x8 af = *(const LAS bf16x8*)(lds + LR_XC + (16 * mt + (lane & 15)) * LR_XCP + (32 * ks + 8 * q) * 2);
                  ar[mt] = __builtin_amdgcn_mfma_f32_16x16x32_bf16(af, bA, ar[mt], 0, 0, 0);
                  ai[mt] = __builtin_amdgcn_mfma_f32_16x16x32_bf16(af, bI, ai[mt], 0, 0, 0); } } }
        const float b_a = LP.ba[dir * 512 + chg], b_i = LP.bi[dir * 512 + chg];
        const float c8 = 8.f * LOG2E * log1pf(__expf(-LP.L[dir * 512 + chg]));
        float Hrun = 0.f, Arun = 1.f;
#pragma unroll
        for (int mt = 0; mt < 8; ++mt) {
            float a[4], u[4];
#pragma unroll
            for (int r = 0; r < 4; ++r) { const int s = 16 * mt + 4 * q + r;
                const float er = __builtin_amdgcn_exp2f(-LOG2E * (ar[mt][r] + b_a)), ei = __builtin_amdgcn_exp2f(-LOG2E * (ai[mt][r] + b_i));
                const float dr = 1.f + er, di = 1.f + ei, R = __builtin_amdgcn_rcpf(dr * di);
                const float rr = R * di, ii = R * dr;
                const float av = __builtin_amdgcn_exp2f(-c8 * rr);
                const float xcv = bf1(*(const LAS bf16*)(lds + LR_XC + s * LR_XCP + chl * 2));
                a[r] = av; u[r] = __builtin_amdgcn_sqrtf(fmaxf(1.f - av * av, 0.f)) * ii * xcv; }
            float A4 = a[0] * a[1] * a[2] * a[3];
            float B4 = ((u[0] * a[1] + u[1]) * a[2] + u[2]) * a[3] + u[3];
            { const float Ap = __shfl_up(A4, 16), Bp = __shfl_up(B4, 16); if (q >= 1) { B4 = A4 * Bp + B4; A4 = A4 * Ap; } }
            { const float Ap = __shfl_up(A4, 32), Bp = __shfl_up(B4, 32); if (q >= 2) { B4 = A4 * Bp + B4; A4 = A4 * Ap; } }
            float Ae = __shfl_up(A4, 16), Be = __shfl_up(B4, 16); if (q == 0) { Ae = 1.f; Be = 0.f; }
            const float At = __shfl(A4, 48 + (lane & 15)), Bt = __shfl(B4, 48 + (lane & 15));
            float hcur = Ae * Hrun + Be, pcur = Arun * Ae;
#pragma unroll
            for (int r = 0; r < 4; ++r) { hcur = a[r] * hcur + u[r]; pcur *= a[r]; const int s = 16 * mt + 4 * q + r; const int t = dir ? 127 - s : s;
                if (dir == 0) Y[t * LR_YP + chl] = hcur; else Y[t * LR_YP + chl] += hcur;
                *(LAS bf16*)(lds + LR_PB + t * LR_XCP + chl * 2) = (bf16)(pk2(pcur, 0.f) & 0xffffu); }
            Hrun = At * Hrun + Bt; Arun *= At;
        }
        if (q == 0) { float* ag = agg + (size_t)c * 2048 + (size_t)dir * 1024 + 2 * chg; ag[0] = Arun; ag[1] = Hrun; }
        __syncthreads();
        { bf16* dst = PFB + (size_t)dir * MTOK * 512;
          for (int p = tid; p < 128 * 16; p += NTHR) { const int t = p >> 4, pc = p & 15;
              *(v4u*)(dst + (size_t)(tb + t) * 512 + hh * 128 + pc * 8) = *(const LAS v4u*)(lds + LR_PB + t * LR_XCP + pc * 16); } }
    }
    for (int p = tid; p < 128 * 16; p += NTHR) { const int t = p >> 4, pc = p & 15; const LAS float* yr = Y + t * LR_YP + pc * 8;
        v4u ow; ow.x = pk2(yr[0], yr[1]); ow.y = pk2(yr[2], yr[3]); ow.z = pk2(yr[4], yr[5]); ow.w = pk2(yr[6], yr[7]);
        *(v4u*)(LL + (size_t)(tb + t) * 512 + hh * 128 + pc * 8) = ow; }
    __syncthreads();
}

__device__ __forceinline__ void lru_light(LAS unsigned char* lds, int c, const bf16* z, bf16* mix, const float* agg, const bf16* LL, const bf16* PFB, int tid) {
    asm volatile("" : "+v"(tid));
    int s0, ns; seq_of_chunk(c, s0, ns);
    LAS float* car = (LAS float*)lds;
    {
      const float* ag0 = agg + 2 * tid; const float* ag1 = agg + 1024 + 2 * tid;
      float H0 = 0.f, H1 = 0.f; int cc = s0, cd = s0 + ns - 1;
      for (; cc + 8 <= c; cc += 8) { v2f v[8];
#pragma unroll
          for (int k = 0; k < 8; ++k) v[k] = *(const v2f*)(ag0 + (size_t)(cc + k) * 2048);
#pragma unroll
          for (int k = 0; k < 8; ++k) H0 = v[k][0] * H0 + v[k][1]; }
      for (; cc < c; ++cc) { const v2f v = *(const v2f*)(ag0 + (size_t)cc * 2048); H0 = v[0] * H0 + v[1]; }
      for (; cd - 8 >= c; cd -= 8) { v2f v[8];
#pragma unroll
          for (int k = 0; k < 8; ++k) v[k] = *(const v2f*)(ag1 + (size_t)(cd - k) * 2048);
#pragma unroll
          for (int k = 0; k < 8; ++k) H1 = v[k][0] * H1 + v[k][1]; }
      for (; cd > c; --cd) { const v2f v = *(const v2f*)(ag1 + (size_t)cd * 2048); H1 = v[0] * H1 + v[1]; }
      car[tid] = H0; car[512 + tid] = H1; }
    __syncthreads();
    const int tb = c * 128;
    for (int p = tid; p < 128 * 64; p += NTHR) { const int t = p >> 6, c8 = (p & 63) * 8; const size_t ro = (size_t)(tb + t) * 512 + c8;
        const v4u lv = *(const v4u*)(LL + ro), fv = *(const v4u*)(PFB + ro), bv = *(const v4u*)(PFB + (size_t)MTOK * 512 + ro);
        const v4u gv = *(const v4u*)(z + (size_t)(tb + t) * NZ + ZGL + c8);
        float o[8];
#pragma unroll
        for (int e = 0; e < 4; ++e) {
            o[2 * e] = (bflo(lv[e]) + bflo(fv[e]) * car[c8 + 2 * e] + bflo(bv[e]) * car[512 + c8 + 2 * e]) * silu(bflo(gv[e]));
            o[2 * e + 1] = (bfhi(lv[e]) + bfhi(fv[e]) * car[c8 + 2 * e + 1] + bfhi(bv[e]) * car[512 + c8 + 2 * e + 1]) * silu(bfhi(gv[e])); }
        v4u ow; ow.x = pk2(o[0], o[1]); ow.y = pk2(o[2], o[3]); ow.z = pk2(o[4], o[5]); ow.w = pk2(o[6], o[7]);
        *(v4u*)(mix + (size_t)(tb + t) * DMOD + 1536 + c8) = ow; }
    __syncthreads();
}

#define XB_TMO      128
#define XB_XCNT(j)  (256  + 64 * (j))
#define XB_XSUB(j)  (1280 + 64 * (j))
#define XB_XGEN(j)  (2304 + 64 * (j))
#define XB_TOP      3328
#define XB_TOPGEN   3392
#define XCD_BAR_WORDS 3456
#define XB_SPIN_CAP (1u << 18)

__device__ __forceinline__ unsigned xb_ld(unsigned* p)              { return __hip_atomic_load(p, __ATOMIC_RELAXED, __HIP_MEMORY_SCOPE_AGENT); }
__device__ __forceinline__ unsigned xb_add(unsigned* p, unsigned v) { return __hip_atomic_fetch_add(p, v, __ATOMIC_RELAXED, __HIP_MEMORY_SCOPE_AGENT); }
__device__ __forceinline__ unsigned xb_xcc_id() { return (unsigned)__builtin_amdgcn_s_getreg((3 << 11) | 20) & 0xFu; }
#define XB_SPIN(cond, bar) do { unsigned _sp = 0; while (cond) { __builtin_amdgcn_s_sleep(1); \
    if ((++_sp & 255u) == 0u) { if (xb_ld(&(bar)[XB_TMO])) break; if (_sp > XB_SPIN_CAP) { atomicAdd(&(bar)[XB_TMO], 1u); break; } } } } while (0)

struct XcdBarrier {
    unsigned* bar; unsigned x;
    volatile LAS unsigned* st;
};

__device__ __forceinline__ XcdBarrier xcd_barrier_post(unsigned* bar, volatile LAS unsigned* st) {
    XcdBarrier b; b.bar = bar; b.x = xb_xcc_id(); b.st = st;
    if (threadIdx.x == 0) (void)xb_add(&bar[XB_XCNT(b.x)], 1u);
    return b;
}
__device__ __forceinline__ void xcd_barrier_complete(unsigned* bar, unsigned x, unsigned& nloc, unsigned& nx) {
    const unsigned G = gridDim.x * gridDim.y * gridDim.z;
    unsigned sum, cnt, mine, sp = 0u;
    for (;;) {
        sum = 0u; cnt = 0u; mine = 0u;
#pragma unroll
        for (unsigned j = 0; j < 16; ++j) { const unsigned c = xb_ld(&bar[XB_XCNT(j)]); sum += c; cnt += (c > 0u) ? 1u : 0u; mine = (j == x) ? c : mine; }
        if (sum == G) break;
        __builtin_amdgcn_s_sleep(1);
        if ((++sp & 255u) == 0u) { if (xb_ld(&bar[XB_TMO])) break; if (sp > XB_SPIN_CAP) { atomicAdd(&bar[XB_TMO], 1u); break; } }
    }
    nloc = mine > 0u ? mine : 1u; nx = cnt > 0u ? cnt : 1u;
}

__device__ __forceinline__ void xcd_barrier(const XcdBarrier& b) {
    asm volatile("s_waitcnt vmcnt(0)" ::: "memory");
    __syncthreads();
    if (threadIdx.x == 0) {
        unsigned* bar = b.bar;
        __builtin_amdgcn_s_waitcnt(0);
        unsigned nloc = b.st[0], nx = b.st[1];
        if (nloc == 0u) { xcd_barrier_complete(bar, b.x, nloc, nx); b.st[0] = nloc; b.st[1] = nx; }
        const unsigned old = xb_add(&bar[XB_XSUB(b.x)], 1u);
        const unsigned gen = old / nloc;
        if (old + 1u == (gen + 1u) * nloc) {
            __builtin_amdgcn_fence(__ATOMIC_RELEASE, "agent");
            asm volatile("s_waitcnt vmcnt(0)" ::: "memory");
            const unsigned og = xb_add(&bar[XB_TOP], 1u);
            const unsigned tg = og / nx;
            if (og + 1u == (tg + 1u) * nx) xb_add(&bar[XB_TOPGEN], 1u);
            else XB_SPIN(xb_ld(&bar[XB_TOPGEN]) == tg, bar);
            __builtin_amdgcn_fence(__ATOMIC_ACQUIRE, "agent");
            xb_add(&bar[XB_XGEN(b.x)], 1u);
            asm volatile("s_waitcnt vmcnt(0)" ::: "memory");
        } else {
            XB_SPIN(xb_ld(&bar[XB_XGEN(b.x)]) == gen, bar);
            __builtin_amdgcn_fence(__ATOMIC_ACQUIRE, "agent");
            asm volatile("s_waitcnt vmcnt(0)" ::: "memory");
        }
    }
    __syncthreads();
}

#ifndef PH_LO
#define PH_LO 0
#endif
__global__ void __launch_bounds__(NTHR, 2) fwd_megakernel(Params P) {
    extern __shared__ __attribute__((aligned(16))) unsigned char lds_raw[];
    LAS unsigned char* lds = (LAS unsigned char*)lds_raw;
    cg::grid_group grid = cg::this_grid();
    const int tid = threadIdx.x, G = gridDim.x;
    unsigned char* ws = P.ws;
    volatile LAS unsigned* MISC = (volatile LAS unsigned*)(lds + LDS_BYTES - 64);
    if (tid < 16) MISC[tid] = 0u;
    __syncthreads();
    (void)xcd_barrier_post((unsigned*)(ws + WS_CTL), MISC);
#define GRID_BAR() do { unsigned char* w_ = P.ws; asm volatile("" : "+s"(w_)); XcdBarrier b_; b_.bar = (unsigned*)(w_ + WS_CTL); b_.x = xb_xcc_id(); \
        b_.st = (volatile LAS unsigned*)(lds + LDS_BYTES - 64); xcd_barrier(b_); } while (0)
    float* ssq = (float*)(ws + WS_SSQ); float* agg = (float*)(ws + WS_AGG);
    bf16* hbA = (bf16*)(ws + WS_HBA); bf16* hbB = (bf16*)(ws + WS_HBB); bf16* mix = (bf16*)(ws + WS_MIX); bf16* pp = (bf16*)(ws + WS_PP); bf16* z = (bf16*)(ws + WS_Z);

#ifndef NO_P0
    p0_prologue(P, lds, tid, G);
#ifdef DUP_P0
    __syncthreads(); p0_prologue(P, lds, tid, G);
#endif
#endif
    if (P.ws == nullptr) grid.sync();
    GRID_BAR();
#ifdef DUP_SYNC
#pragma unroll 1
    for (int r = 0; r < 10; ++r) GRID_BAR();
#endif
#pragma unroll 1
    for (int l = 0; l < 2; ++l) {
        { pg8::Gemm g{hbA, (const bf16*)(ws + WS_WIN) + (size_t)l * NZ * DMOD, MTOK, NZ, DMOD}; pg8::StaticOrder S; S.init(MTOK, NZ, G, (int)blockIdx.x);
          pg8::EpiZ E{z, NZ, ssq + (size_t)(2 * l) * MTOK};
          pg8::gemm_phase<pg8::EpiZ, pg8::StaticOrder, true, true>(lds, g, S, E);
#ifdef DUP_A
          pg8::gemm_phase<pg8::EpiZ, pg8::StaticOrder, true, true>(lds, g, S, E);
#endif
 }
        { pg8::Gemm g{(const bf16*)(ws + WS_PB) + (size_t)l * MTOK * PLE, (const bf16*)(ws + WS_WPROJ) + (size_t)l * DMOD * PLE, MTOK, DMOD, PLE}; pg8::StaticOrder S; S.init(MTOK, DMOD, G, (int)blockIdx.x);
          pg8::EpiZ E{pp, DMOD, nullptr};
#ifndef NO_GP
          pg8::gemm_phase<pg8::EpiZ, pg8::StaticOrder, true, true>(lds, g, S, E);
#endif
 }
        GRID_BAR();
#ifdef DUP_MIX
        for (int rep = 0; rep < 2; ++rep) {
#endif
        LruLayer LP{P.lru_conv_w + (size_t)l * 2 * 4 * 512, P.lru_conv_b + l * 1024, P.lru_b_a + l * 1024, P.lru_b_i + l * 1024, P.lru_L + l * 1024, (const bf16*)(ws + WS_WL) + (size_t)l * 16 * 16384};
        bf16* LL = hbB; bf16* PFB = hbB + (size_t)MTOK * 512;
        for (int it = blockIdx.x; it < NCHUNK * 4; it += G) lru_heavy(lds, it, z, LP, agg, LL, PFB, tid);
#ifdef DUP_HEAVY
        for (int it = blockIdx.x; it < NCHUNK * 4; it += G) lru_heavy(lds, it, z, LP, agg, LL, PFB, tid);
#endif
        GRID_BAR();
        attn_build_tab(lds, P.rel_bias, tid);
        __syncthreads();
#ifndef NO_ATTN
        if (G == 256) {
            const int xc = (blockIdx.x & 7) * 32 + (blockIdx.x >> 3);
#pragma unroll 1
            for (int r = 0; r < 4; ++r) attn_item(lds, xc * 4 + r, z, mix, P.attn_sink + l * 8, tid);
        } else
        for (int it = blockIdx.x; it < NCHUNK * 4; it += G) attn_item(lds, it, z, mix, P.attn_sink + l * 8, tid);
#ifdef DUP_ATTN
        for (int it = blockIdx.x; it < NCHUNK * 4; it += G) attn_item(lds, it, z, mix, P.attn_sink + l * 8, tid);
#endif
#endif
        for (int it = blockIdx.x; it < NCHUNK; it += G) lru_light(lds, it, z, mix, agg, LL, PFB, tid);
#ifdef DUP_LIGHT
        for (int it = blockIdx.x; it < NCHUNK; it += G) lru_light(lds, it, z, mix, agg, LL, PFB, tid);
#endif
#ifndef NO_CONV
        conv_phase(z, mix, P.conv_w + (size_t)l * 3 * 512, G, tid);
#ifdef DUP_CONV
        conv_phase(z, mix, P.conv_w + (size_t)l * 3 * 512, G, tid);
#endif
#endif
        GRID_BAR();
#ifdef DUP_MIX
        }
#endif
        { pg8::Gemm g{mix, (const bf16*)(ws + WS_WOUT) + (size_t)l * DMOD * DMOD, MTOK, DMOD, DMOD}; pg8::StaticOrder S; S.init(MTOK, DMOD, G, (int)blockIdx.x);
          pg8::EpiRes E{hbA, hbB, ssq + (size_t)(2 * l + 1) * MTOK};
#ifndef NO_GC
          pg8::gemm_phase<pg8::EpiRes, pg8::StaticOrder, true, true>(lds, g, S, E);
#endif
 }
        GRID_BAR();
        { pg8::Gemm g{hbB, (const bf16*)(ws + WS_WGATE) + (size_t)l * DMOD * DMOD, MTOK, DMOD, DMOD}; pg8::StaticOrder S; S.init(MTOK, DMOD, G, (int)blockIdx.x);
          pg8::EpiGate E{ssq + (size_t)(2 * l + 1) * MTOK, hbB, pp, hbA, ssq + (size_t)(2 * l + 2) * MTOK};
#ifndef NO_GD
          pg8::gemm_phase<pg8::EpiGate, pg8::StaticOrder, true, true>(lds, g, S, E);
#endif
 }
        GRID_BAR();
    }
    { const int lane = tid & 63, gw = blockIdx.x * NWAVES + (tid >> 6), NGW = G * NWAVES; const float* sf = ssq + (size_t)4 * MTOK;
      for (int row = gw; row < MTOK; row += NGW) { const float rs = rsqrtf(sf[row] * (1.f / DMOD) + 1e-6f); float* orow = P.out + (size_t)row * DMOD; const bf16* hrow = hbA + (size_t)row * DMOD;
#pragma unroll
          for (int j = 0; j < 4; ++j) { const int cidx = 8 * lane + 512 * j; const v4u hv = *(const v4u*)(hrow + cidx); const f32x4 g0 = *(const f32x4*)(P.final_norm + cidx), g1 = *(const f32x4*)(P.final_norm + cidx + 4);
              f32x4 v0, v1; v0[0] = bflo(hv.x) * rs * g0[0]; v0[1] = bfhi(hv.x) * rs * g0[1]; v0[2] = bflo(hv.y) * rs * g0[2]; v0[3] = bfhi(hv.y) * rs * g0[3];
              v1[0] = bflo(hv.z) * rs * g1[0]; v1[1] = bfhi(hv.z) * rs * g1[1]; v1[2] = bflo(hv.w) * rs * g1[2]; v1[3] = bfhi(hv.w) * rs * g1[3];
              *(f32x4*)(orow + cidx) = v0; *(f32x4*)(orow + cidx + 4) = v1; } } }
}

extern "C" void kernel_launch(void* const* d_in, const int* in_sizes, int n_in, void* d_out, int out_size, void* d_ws, size_t ws_size, hipStream_t stream) {
    static int grid_blocks = 0;
    if (!grid_blocks) {
        if (n_in != 21 || ws_size < WS_END) { fprintf(stderr, "kernel_launch: unexpected n_in %d / ws_size %zu\n", n_in, ws_size); grid_blocks = -1; return; }
        int dev = 0, cus = 0, per_cu = 0;
        (void)hipGetDevice(&dev);
        (void)hipDeviceGetAttribute(&cus, hipDeviceAttributeMultiprocessorCount, dev);
        (void)hipFuncSetAttribute((const void*)fwd_megakernel, hipFuncAttributeMaxDynamicSharedMemorySize, LDS_BYTES);
        (void)hipOccupancyMaxActiveBlocksPerMultiprocessor(&per_cu, (const void*)fwd_megakernel, NTHR, LDS_BYTES);
        if (per_cu < 1) { fprintf(stderr, "kernel_launch: occupancy query says %d blocks/CU\n", per_cu); per_cu = 1; }
        grid_blocks = cus;
    }
    if (grid_blocks < 0) return;
    (void)hipMemsetAsync((unsigned char*)d_ws + WS_CTL, 0, CTL_BYTES, stream);
    Params p{};
    const float** pf = (const float**)&p;
    for (int i = 0; i < 21; ++i) pf[i] = (const float*)d_in[i];
    p.out = (float*)d_out; p.ws = (unsigned char*)d_ws;
    void* args[] = {&p};
    hipError_t e = hipLaunchCooperativeKernel((void*)fwd_megakernel, dim3(grid_blocks), dim3(NTHR), args, LDS_BYTES, stream);
    if (e != hipSuccess) fprintf(stderr, "cooperative launch failed: %s (grid %d)\n", hipGetErrorString(e), grid_blocks);
}
```

```cpp
#include <hip/hip_runtime.h>
#include <hip/hip_cooperative_groups.h>
#include <cstdio>
#include <cstdint>
namespace cg = cooperative_groups;
namespace pg8 {
#define PG8_LAS __attribute__((address_space(3)))
typedef unsigned short bf16_t;
typedef short bf16x8 __attribute__((ext_vector_type(8)));
typedef float f32x4 __attribute__((ext_vector_type(4)));
typedef unsigned u32x4 __attribute__((ext_vector_type(4)));
constexpr int BM = 256, BK = 64, HALF = 128, HTB = HALF * BK * 2  , STAGE_BYTES = 8 * HTB, NXCD = 8, WGM = 8;

__host__ __device__ __forceinline__ int lds_byte(int r, int c) { const int st = (r >> 4) * 2 + (c >> 5), rr = r & 15, cc = c & 31, ob = rr * 64 + cc * 2; return st * 1024 + (ob ^ (((ob >> 9) & 1) << 5)); }
__host__ __device__ __forceinline__ void stage_rc(int b, int& R, int& C) { const int st = b / 1024, sb = b % 1024, swz = sb ^ (((sb >> 9) & 1) << 5); R = (st >> 1) * 16 + swz / 64; C = (st & 1) * 32 + (swz % 64) / 2; }
__host__ __device__ __forceinline__ int perm32(int rho) { const int n = rho >> 4, i = rho & 15; return 8 * (i >> 2) + 4 * n + (i & 3); }

struct Unit { int pm, pn; };
struct Gemm { const bf16_t* A; const bf16_t* Bt; int M, N, K; };

struct StaticOrder {
    int nM, nN, nwg, G, c;
    __host__ __device__ void init(int M, int N, int G_, int c_) { nM = M / BM; nN = N / BM; nwg = nM * nN; G = G_; c = c_; }
    __host__ __device__ bool next(int i, Unit& u) const {
        const long L = (long)i * G + c; if (L >= nwg) return false;
        int wgid = (int)L; { const int q = nwg / NXCD, r = nwg % NXCD, xcd = wgid % NXCD, off = wgid / NXCD; wgid = (xcd < r ? xcd * (q + 1) : r * (q + 1) + (xcd - r) * q) + off; }
        const int nig = WGM * nN, gid = wgid / nig, fm = gid * WGM, gsz = (nM - fm) < WGM ? (nM - fm) : WGM;
        u.pm = fm + ((wgid % nig) % gsz); u.pn = (wgid % nig) / gsz; return true;
    }
    __device__ __forceinline__ void a_ready(const Unit&) const {}
    __device__ __forceinline__ void done(const Unit&) const {}
};

__device__ __forceinline__ unsigned cvt_pk_bf16(float lo, float hi) { unsigned r; asm volatile("v_cvt_pk_bf16_f32 %0, %1, %2" : "=v"(r) : "v"(lo), "v"(hi)); return r; }
__device__ __forceinline__ float fast_sigmoid(float x) { return __builtin_amdgcn_rcpf(1.f + __expf(-x)); }
__device__ __forceinline__ float bf_lo(unsigned w) { return __builtin_bit_cast(float, w << 16); }
__device__ __forceinline__ float bf_hi(unsigned w) { return __builtin_bit_cast(float, w & 0xffff0000u); }
constexpr int DM = 2048;
constexpr float NEPS = 1e-6f;

struct EpiZ {
    static constexpr bool PERM = true, AFTER_DRAIN = false;
    bf16_t* O; int ldc; const PG8_LAS float* ssq;
    __device__ __forceinline__ void operator()(const f32x4 (&acc)[2][2][4][2], const Unit& u, int wr, int wc, int fr, int fq) const {
        const int row0 = u.pm * BM + wr * 64 + fr, col0 = u.pn * BM + wc * 32 + 8 * fq;
        float sq[2][4];
#pragma unroll
        for (int ai = 0; ai < 2; ++ai)
#pragma unroll
            for (int m = 0; m < 4; ++m) sq[ai][m] = ssq ? ssq[((u.pm >> 3) & 3) * 256 + wr * 64 + fr + ai * HALF + m * 16] : 1.f;
#pragma unroll
        for (int ai = 0; ai < 2; ++ai)
#pragma unroll
            for (int m = 0; m < 4; ++m) { const int row = row0 + ai * HALF + m * 16;
                const float sc = sq[ai][m];
                bf16_t* rowp = ldc ? O + (size_t)row * ldc + col0 : O + ((size_t)(u.pm * 8 + u.pn) * 256 + (row - u.pm * BM)) * 256 + (col0 - u.pn * BM);
#pragma unroll
                for (int bj = 0; bj < 2; ++bj) { const f32x4 v0 = acc[ai][bj][m][0] * sc, v1 = acc[ai][bj][m][1] * sc;
                    u32x4 w; w.x = cvt_pk_bf16(v0[0], v0[1]); w.y = cvt_pk_bf16(v0[2], v0[3]); w.z = cvt_pk_bf16(v1[0], v1[1]); w.w = cvt_pk_bf16(v1[2], v1[3]);
                    *(u32x4*)(rowp + bj * HALF) = w; } }
    }
};

struct EpiRes {
    static constexpr bool PERM = true, AFTER_DRAIN = false;
    const bf16_t* res; bf16_t* hb; float* ssq;
    __device__ __forceinline__ void operator()(const f32x4 (&acc)[2][2][4][2], const Unit& u, int wr, int wc, int fr, int fq) const {
#ifdef TIME_EPI
        const unsigned long long t0_ = __builtin_amdgcn_s_memrealtime();
#endif
        const int row0 = u.pm * BM + wr * 64 + fr, col0 = u.pn * BM + wc * 32 + 8 * fq;
#pragma unroll
        for (int ai = 0; ai < 2; ++ai)
#pragma unroll
            for (int m = 0; m < 4; ++m) { const int row = row0 + ai * HALF + m * 16;
                const bf16_t* sp = res + (size_t)row * DM + col0; bf16_t* hp = hb + (size_t)row * DM + col0; float s = 0.f;
#pragma unroll
                for (int bj = 0; bj < 2; ++bj) { const u32x4 rw = *(const u32x4*)(sp + bj * HALF);
                    f32x4 v0 = acc[ai][bj][m][0], v1 = acc[ai][bj][m][1];
                    v0[0] += bf_lo(rw.x); v0[1] += bf_hi(rw.x); v0[2] += bf_lo(rw.y); v0[3] += bf_hi(rw.y);
                    v1[0] += bf_lo(rw.z); v1[1] += bf_hi(rw.z); v1[2] += bf_lo(rw.w); v1[3] += bf_hi(rw.w);
                    u32x4 w; w.x = cvt_pk_bf16(v0[0], v0[1]); w.y = cvt_pk_bf16(v0[2], v0[3]); w.z = cvt_pk_bf16(v1[0], v1[1]); w.w = cvt_pk_bf16(v1[2], v1[3]);
                    *(u32x4*)(hp + bj * HALF) = w;
                    s += v0[0] * v0[0] + v0[1] * v0[1] + v0[2] * v0[2] + v0[3] * v0[3] + v1[0] * v1[0] + v1[1] * v1[1] + v1[2] * v1[2] + v1[3] * v1[3]; }
                s += __shfl_xor(s, 16); s += __shfl_xor(s, 32);
                if (fq == 0) atomicAdd(ssq + row, s); }
#ifdef TIME_EPI
#if TIME_EPI == 2
        asm volatile("s_waitcnt vmcnt(0)" ::: "memory");
#endif
        *tacc += (unsigned)(__builtin_amdgcn_s_memrealtime() - t0_);
#endif
    }
#ifdef TIME_EPI
    unsigned* tacc;
#endif
};

struct EpiResNoAtom {
    static constexpr bool PERM = true, AFTER_DRAIN = false;
    const bf16_t* res; bf16_t* hb; float* ssq;
    __device__ __forceinline__ void operator()(const f32x4 (&acc)[2][2][4][2], const Unit& u, int wr, int wc, int fr, int fq) const {
#ifdef TIME_EPI
        const unsigned long long t0_ = __builtin_amdgcn_s_memrealtime();
#endif
        const int row0 = u.pm * BM + wr * 64 + fr, col0 = u.pn * BM + wc * 32 + 8 * fq;
#pragma unroll
        for (int ai = 0; ai < 2; ++ai)
#pragma unroll
            for (int m = 0; m < 4; ++m) { const int row = row0 + ai * HALF + m * 16;
                const bf16_t* sp = res + (size_t)row * DM + col0; bf16_t* hp = hb + (size_t)row * DM + col0; float s = 0.f;
#pragma unroll
                for (int bj = 0; bj < 2; ++bj) { const u32x4 rw = *(const u32x4*)(sp + bj * HALF);
                    f32x4 v0 = acc[ai][bj][m][0], v1 = acc[ai][bj][m][1];
                    v0[0] += bf_lo(rw.x); v0[1] += bf_hi(rw.x); v0[2] += bf_lo(rw.y); v0[3] += bf_hi(rw.y);
                    v1[0] += bf_lo(rw.z); v1[1] += bf_hi(rw.z); v1[2] += bf_lo(rw.w); v1[3] += bf_hi(rw.w);
                    u32x4 w; w.x = cvt_pk_bf16(v0[0], v0[1]); w.y = cvt_pk_bf16(v0[2], v0[3]); w.z = cvt_pk_bf16(v1[0], v1[1]); w.w = cvt_pk_bf16(v1[2], v1[3]);
                    *(u32x4*)(hp + bj * HALF) = w;
                    s += v0[0] * v0[0] + v0[1] * v0[1] + v0[2] * v0[2] + v0[3] * v0[3] + v1[0] * v1[0] + v1[1] * v1[1] + v1[2] * v1[2] + v1[3] * v1[3]; }
                s += __shfl_xor(s, 16); s += __shfl_xor(s, 32);
                if (s == 12345.678f) ssq[row] = s; }
#ifdef TIME_EPI
#if TIME_EPI == 2
        asm volatile("s_waitcnt vmcnt(0)" ::: "memory");
#endif
        *tacc += (unsigned)(__builtin_amdgcn_s_memrealtime() - t0_);
#endif
    }
#ifdef TIME_EPI
    unsigned* tacc;
#endif
};

struct EpiGate {
    static constexpr bool PERM = true, AFTER_DRAIN = false;
    const PG8_LAS float* ssq_in; const bf16_t* res; const bf16_t* pp; bf16_t* hb; float* ssq_out;
    __device__ __forceinline__ void operator()(const f32x4 (&acc)[2][2][4][2], const Unit& u, int wr, int wc, int fr, int fq) const {
        const int row0 = u.pm * BM + wr * 64 + fr, col0 = u.pn * BM + wc * 32 + 8 * fq;
#pragma unroll
        for (int ai = 0; ai < 2; ++ai)
#pragma unroll
            for (int m = 0; m < 4; ++m) { const int row = row0 + ai * HALF + m * 16;
                const float sc = ssq_in[((u.pm >> 3) & 3) * 256 + (row - u.pm * BM)];
                const bf16_t* sp = res + (size_t)row * DM + col0; bf16_t* hp = hb + (size_t)row * DM + col0; const bf16_t* ppp = pp + ((size_t)(u.pm * 8 + u.pn) * 256 + (row - u.pm * BM)) * 256 + (col0 - u.pn * BM);   float s = 0.f;
#pragma unroll
                for (int bj = 0; bj < 2; ++bj) { const u32x4 rw = *(const u32x4*)(sp + bj * HALF); const u32x4 pw = *(const u32x4*)(ppp + bj * HALF);
                    const f32x4 a0 = acc[ai][bj][m][0] * sc, a1 = acc[ai][bj][m][1] * sc;
                    f32x4 v0, v1;
                    v0[0] = bf_lo(rw.x) + fast_sigmoid(a0[0]) * bf_lo(pw.x); v0[1] = bf_hi(rw.x) + fast_sigmoid(a0[1]) * bf_hi(pw.x);
                    v0[2] = bf_lo(rw.y) + fast_sigmoid(a0[2]) * bf_lo(pw.y); v0[3] = bf_hi(rw.y) + fast_sigmoid(a0[3]) * bf_hi(pw.y);
                    v1[0] = bf_lo(rw.z) + fast_sigmoid(a1[0]) * bf_lo(pw.z); v1[1] = bf_hi(rw.z) + fast_sigmoid(a1[1]) * bf_hi(pw.z);
                    v1[2] = bf_lo(rw.w) + fast_sigmoid(a1[2]) * bf_lo(pw.w); v1[3] = bf_hi(rw.w) + fast_sigmoid(a1[3]) * bf_hi(pw.w);
                    u32x4 w; w.x = cvt_pk_bf16(v0[0], v0[1]); w.y = cvt_pk_bf16(v0[2], v0[3]); w.z = cvt_pk_bf16(v1[0], v1[1]); w.w = cvt_pk_bf16(v1[2], v1[3]);
                    *(u32x4*)(hp + bj * HALF) = w;
                    s += v0[0] * v0[0] + v0[1] * v0[1] + v0[2] * v0[2] + v0[3] * v0[3] + v1[0] * v1[0] + v1[1] * v1[1] + v1[2] * v1[2] + v1[3] * v1[3]; }
                s += __shfl_xor(s, 16); s += __shfl_xor(s, 32);
                if (fq == 0) atomicAdd(ssq_out + row, s); }
    }
};

struct EpiNull {
    static constexpr bool PERM = true, AFTER_DRAIN = false;
    float* sink;
    __device__ __forceinline__ void operator()(const f32x4 (&acc)[2][2][4][2], const Unit& u, int wr, int wc, int fr, int fq) const {
        float s = 0.f;
#pragma unroll
        for (int ai = 0; ai < 2; ++ai)
#pragma unroll
            for (int bj = 0; bj < 2; ++bj)
#pragma unroll
                for (int m = 0; m < 4; ++m)
#pragma unroll
                    for (int n = 0; n < 2; ++n) s += acc[ai][bj][m][n][0] + acc[ai][bj][m][n][1] + acc[ai][bj][m][n][2] + acc[ai][bj][m][n][3];
        if (s == 12345.678f) sink[u.pm + wr + wc + fr + fq] = s;
    }
};
template <class Epi, class Sched, bool ALIGN_EPI = false, bool SP2 = false>
__device__ __forceinline__ void gemm_phase(PG8_LAS unsigned char* lds, const Gemm g, const Sched& S, const Epi& E) {
    int tid_ = threadIdx.x; asm volatile("" : "+v"(tid_));
    const int tid = tid_, wid = __builtin_amdgcn_readfirstlane(tid >> 6), lane = tid & 63, wr = wid >> 2, wc = wid & 3, fr = lane & 15, fq = lane >> 4;
    int K_ = g.K; asm volatile("" : "+s"(K_));
    const int K = K_, nt = K / BK;
    unsigned voffA[2], voffB[2];
#pragma unroll
    for (int i = 0; i < 2; ++i) { int R, C; stage_rc(tid * 16 + i * 8192, R, C); const int Rb = Epi::PERM ? ((R & ~31) + perm32(R & 31)) : R;
        voffA[i] = (unsigned)(R * K + C) * 2u; voffB[i] = (unsigned)(Rb * K + C) * 2u; }
    const size_t kstep = (size_t)(BK * 2);
    const size_t hstep = (size_t)HALF * K * 2;
    const size_t tstep = 2 * hstep;
    const unsigned ldsw = (unsigned)wid * 1024u;
    const int aoff = lds_byte(wr * 64 + fr, fq * 8), boff = lds_byte(wc * 32 + fr, fq * 8);
#define PG8_SA(b, h) (((b) * 2 + (h)) * HTB)
#define PG8_SB(b, h) ((4 + (b) * 2 + (h)) * HTB)
#define PG8_STAGE(bufoff, gbase, voff) do { _Pragma("unroll") for (int _i = 0; _i < 2; ++_i) \
        __builtin_amdgcn_global_load_lds((const unsigned*)((const char*)(gbase) + (voff)[_i]), (PG8_LAS unsigned*)(lds + (bufoff) + ldsw + _i * 8192), 16, 0, 0); } while (0)
#define PG8_LDA(dst, b, h) do { _Pragma("unroll") for (int m = 0; m < 4; ++m) _Pragma("unroll") for (int k = 0; k < 2; ++k) dst[m][k] = *(const PG8_LAS bf16x8*)(lds + PG8_SA(b, h) + aoff + m * 2048 + k * 1024); } while (0)
#define PG8_LDB(dst, b, h) do { _Pragma("unroll") for (int n = 0; n < 2; ++n) _Pragma("unroll") for (int k = 0; k < 2; ++k) dst[n][k] = *(const PG8_LAS bf16x8*)(lds + PG8_SB(b, h) + boff + n * 2048 + k * 1024); } while (0)
#define PG8_MMA(ai, bj, At, Bt) do { __builtin_amdgcn_s_setprio(1); _Pragma("unroll") for (int m = 0; m < 4; ++m) _Pragma("unroll") for (int n = 0; n < 2; ++n) _Pragma("unroll") for (int k = 0; k < 2; ++k) \
        acc[ai][bj][m][n] = __builtin_amdgcn_mfma_f32_16x16x32_bf16(Bt[n][k], At[m][k], acc[ai][bj][m][n], 0, 0, 0); __builtin_amdgcn_s_setprio(0); } while (0)
#define PG8_WAIT_V(n) asm volatile("s_waitcnt vmcnt(" #n ")" ::: "memory")
#define PG8_WAIT_L(n) asm volatile("s_waitcnt lgkmcnt(" #n ")" ::: "memory")
#define PG8_BAR __builtin_amdgcn_s_barrier()
#define PG8_SCHED __builtin_amdgcn_sched_barrier(0)
    Unit cur, nxt; int ui = 0;
    if (!S.next(0, cur)) return;
    f32x4 acc[2][2][4][2];
#pragma unroll
    for (int a = 0; a < 2; ++a)
#pragma unroll
        for (int b = 0; b < 2; ++b)
#pragma unroll
            for (int m = 0; m < 4; ++m)
#pragma unroll
                for (int n = 0; n < 2; ++n) acc[a][b][m][n] = (f32x4){0.f, 0.f, 0.f, 0.f};
    bf16x8 At[4][2], B0[2][2], B1[2][2];
    const char* cA = (const char*)g.A + (size_t)cur.pm * tstep; const char* cB = (const char*)g.Bt + (size_t)cur.pn * tstep;
    S.a_ready(cur);
    if constexpr (SP2) {
        PG8_STAGE(PG8_SB(0, 0), cB, voffB); PG8_STAGE(PG8_SB(0, 1), cB + hstep, voffB); PG8_STAGE(PG8_SA(0, 0), cA, voffA); PG8_STAGE(PG8_SA(0, 1), cA + hstep, voffA);
        if (wr == 1) PG8_BAR;
        PG8_WAIT_V(2); PG8_BAR;
        PG8_STAGE(PG8_SB(1, 0), cB + kstep, voffB); PG8_STAGE(PG8_SA(1, 0), cA + kstep, voffA); PG8_STAGE(PG8_SB(1, 1), cB + hstep + kstep, voffB);
        PG8_WAIT_V(6); PG8_BAR;
    } else {
        PG8_STAGE(PG8_SB(0, 0), cB, voffB); PG8_STAGE(PG8_SA(0, 0), cA, voffA); PG8_STAGE(PG8_SB(0, 1), cB + hstep, voffB); PG8_STAGE(PG8_SA(0, 1), cA + hstep, voffA);
        if (wr == 1) PG8_BAR;
        PG8_WAIT_V(4); PG8_BAR;
        PG8_STAGE(PG8_SB(1, 0), cB + kstep, voffB); PG8_STAGE(PG8_SA(1, 0), cA + kstep, voffA); PG8_STAGE(PG8_SB(1, 1), cB + hstep + kstep, voffB);
        PG8_WAIT_V(6); PG8_BAR;
    }
    for (;;) {
        const bool has_next = S.next(ui + 1, nxt);
        const char* nA = has_next ? (const char*)g.A + (size_t)nxt.pm * tstep : cA; const char* nB = has_next ? (const char*)g.Bt + (size_t)nxt.pn * tstep : cB;
        for (int t = 0; t < nt; t += 2) {
            const bool last = (t == nt - 2);
            const char* a1 = cA + (size_t)(t + 1) * kstep;
            const char* a2 = last ? nA : cA + (size_t)(t + 2) * kstep; const char* b2 = last ? nB : cB + (size_t)(t + 2) * kstep;
            const char* a3 = a2 + kstep; const char* b3 = b2 + kstep;
            if (last && has_next) S.a_ready(nxt);
            if constexpr (SP2) {
            PG8_LDB(B0, 0, 0); PG8_LDB(B1, 0, 1); PG8_SCHED; PG8_LDA(At, 0, 0); PG8_STAGE(PG8_SA(1, 1), a1 + hstep, voffA);
            PG8_WAIT_V(8); PG8_WAIT_L(0); PG8_BAR; PG8_MMA(0, 0, At, B0); PG8_MMA(0, 1, At, B1); PG8_BAR; PG8_SCHED;
            PG8_LDA(At, 0, 1); PG8_STAGE(PG8_SB(0, 0), b2, voffB); PG8_STAGE(PG8_SB(0, 1), b2 + hstep, voffB); PG8_STAGE(PG8_SA(0, 0), a2, voffA);
            PG8_WAIT_V(8); PG8_WAIT_L(0); PG8_BAR; PG8_MMA(1, 0, At, B0); PG8_MMA(1, 1, At, B1); PG8_BAR; PG8_SCHED;
            PG8_LDB(B0, 1, 0); PG8_LDB(B1, 1, 1); PG8_SCHED; PG8_LDA(At, 1, 0); PG8_STAGE(PG8_SA(0, 1), a2 + hstep, voffA);
            PG8_WAIT_V(8); PG8_WAIT_L(0); PG8_BAR; PG8_MMA(0, 0, At, B0); PG8_MMA(0, 1, At, B1); PG8_BAR; PG8_SCHED;
            PG8_LDA(At, 1, 1); PG8_STAGE(PG8_SB(1, 0), b3, voffB); PG8_STAGE(PG8_SB(1, 1), b3 + hstep, voffB); PG8_STAGE(PG8_SA(1, 0), a3, voffA);
            PG8_WAIT_V(8); PG8_WAIT_L(0); PG8_BAR; PG8_MMA(1, 0, At, B0); PG8_MMA(1, 1, At, B1); PG8_BAR; PG8_SCHED;
            } else {
            PG8_LDB(B0, 0, 0); PG8_SCHED; PG8_LDA(At, 0, 0); PG8_STAGE(PG8_SA(1, 1), a1 + hstep, voffA);
            PG8_WAIT_L(8); PG8_BAR; PG8_WAIT_L(0); PG8_MMA(0, 0, At, B0); PG8_BAR; PG8_SCHED;
            PG8_LDB(B1, 0, 1); PG8_STAGE(PG8_SB(0, 0), b2, voffB);
            PG8_BAR; PG8_WAIT_L(0); PG8_MMA(0, 1, At, B1); PG8_BAR;
            PG8_LDA(At, 0, 1); PG8_STAGE(PG8_SA(0, 0), a2, voffA);
            PG8_BAR; PG8_WAIT_L(0); PG8_MMA(1, 0, At, B0); PG8_BAR; PG8_SCHED;
            PG8_STAGE(PG8_SB(0, 1), b2 + hstep, voffB);
            PG8_WAIT_V(6); PG8_BAR; PG8_MMA(1, 1, At, B1); PG8_BAR;
            PG8_LDB(B0, 1, 0); PG8_SCHED; PG8_LDA(At, 1, 0); PG8_STAGE(PG8_SA(0, 1), a2 + hstep, voffA);
            PG8_WAIT_L(8); PG8_BAR; PG8_WAIT_L(0); PG8_MMA(0, 0, At, B0); PG8_BAR; PG8_SCHED;
            PG8_LDB(B1, 1, 1); PG8_STAGE(PG8_SB(1, 0), b3, voffB);
            PG8_BAR; PG8_WAIT_L(0); PG8_MMA(0, 1, At, B1); PG8_BAR;
            PG8_LDA(At, 1, 1); PG8_STAGE(PG8_SA(1, 0), a3, voffA);
            PG8_BAR; PG8_WAIT_L(0); PG8_MMA(1, 0, At, B0); PG8_BAR; PG8_SCHED;
            PG8_STAGE(PG8_SB(1, 1), b3 + hstep, voffB);
            PG8_WAIT_V(6); PG8_BAR; PG8_MMA(1, 1, At, B1); PG8_BAR;
            }
        }
        if constexpr (ALIGN_EPI) { if (wr == 0) PG8_BAR; }
        if constexpr (!Epi::AFTER_DRAIN) { E(acc, cur, wr, wc, fr, fq); S.done(cur); }
        if (!has_next) break;
#pragma unroll
        for (int a = 0; a < 2; ++a)
#pragma unroll
            for (int b = 0; b < 2; ++b)
#pragma unroll
                for (int m = 0; m < 4; ++m)
#pragma unroll
                    for (int n = 0; n < 2; ++n) acc[a][b][m][n] = (f32x4){0.f, 0.f, 0.f, 0.f};
        cur = nxt; cA = nA; cB = nB; ++ui;
        if constexpr (ALIGN_EPI) { if (wr == 1) PG8_BAR; }
    }
    PG8_WAIT_V(0);
    if constexpr (!ALIGN_EPI) { if (wr == 0) PG8_BAR; }
    PG8_BAR;
    if constexpr (Epi::AFTER_DRAIN) { E.fused(acc, cur, wr, wc, fr, fq, lds, wid, lane); S.done(cur); }
#undef PG8_SA
#undef PG8_SB
#undef PG8_STAGE
#undef PG8_LDA
#undef PG8_LDB
#undef PG8_MMA
#undef PG8_WAIT_V
#undef PG8_WAIT_L
#undef PG8_BAR
#undef PG8_SCHED
}
}
#define LAS __attribute__((address_space(3)))
typedef unsigned short bf16;
typedef unsigned v4u __attribute__((ext_vector_type(4)));
typedef unsigned v2u __attribute__((ext_vector_type(2)));
typedef float v2f __attribute__((ext_vector_type(2)));
typedef float f32x4 __attribute__((ext_vector_type(4)));
typedef float f32x16 __attribute__((ext_vector_type(16)));
typedef short bf16x8 __attribute__((ext_vector_type(8)));
typedef short s16x4 __attribute__((ext_vector_type(4)));
constexpr int MTOK = 32768, DMOD = 2048, NZ = 5632, PLE = 256, NCHUNK = MTOK / 128;
constexpr int ZQ = 0, ZK = 1024, ZV = 1280, ZGA = 1536, ZCB = 2560, ZCC = 3072, ZCX = 3584, ZGC = 4096, ZXL = 4608, ZGL = 5120;
constexpr float LOG2E = 1.4426950408889634f;
constexpr int NWAVES = 8, NTHR = 512;
constexpr int LDS_BYTES = 147456;
constexpr size_t MiB = 1u << 20;
constexpr size_t WS_SSQ = 0;
constexpr size_t WS_AGG = 1 * MiB;
constexpr size_t WS_WL = 3 * MiB;
constexpr size_t WS_WPROJ = 4 * MiB;
constexpr size_t WS_CTL = 6 * MiB, CTL_BYTES = 16384;
constexpr size_t WS_WIN = 8 * MiB;
constexpr size_t WS_WOUT = 52 * MiB;
constexpr size_t WS_WGATE = 68 * MiB;
constexpr size_t WS_PB = 84 * MiB;
constexpr size_t WS_HBA = 116 * MiB;
constexpr size_t WS_HBB = 244 * MiB;
constexpr size_t WS_MIX = 372 * MiB;
constexpr size_t WS_PP = 500 * MiB;
constexpr size_t WS_Z = 628 * MiB;
constexpr size_t WS_END = 980 * MiB;

struct Params {
    const float *x_prompt, *x_sample, *p_prompt, *p_sample, *norm_mix, *w_in, *w_out, *rel_bias, *attn_sink, *conv_w, *lru_conv_w, *lru_conv_b,
                *lru_w_a, *lru_b_a, *lru_w_i, *lru_b_i, *lru_L, *ple_norm, *ple_w_gate, *ple_w_proj, *final_norm;
    float* out; unsigned char* ws;
};

__device__ __forceinline__ unsigned f2bf(float f) { unsigned u = __builtin_bit_cast(unsigned, f); return (u + 0x7fffu + ((u >> 16) & 1u)) >> 16; }
__device__ __forceinline__ unsigned pk2(float lo, float hi) { unsigned r; asm("v_cvt_pk_bf16_f32 %0, %1, %2" : "=v"(r) : "v"(lo), "v"(hi)); return r; }
__device__ __forceinline__ float bflo(unsigned w) { return __builtin_bit_cast(float, w << 16); }
__device__ __forceinline__ float bfhi(unsigned w) { return __builtin_bit_cast(float, w & 0xffff0000u); }
__device__ __forceinline__ float bf1(bf16 v) { return __builtin_bit_cast(float, (unsigned)v << 16); }
__device__ __forceinline__ float sigm(float x) { return __builtin_amdgcn_rcpf(1.f + __expf(-x)); }
__device__ __forceinline__ float silu(float x) { return x * sigm(x); }
__device__ __forceinline__ float wave_sum(float v) {
#pragma unroll
    for (int o = 1; o < 64; o <<= 1) v += __shfl_xor(v, o);
    return v;
}
__device__ __forceinline__ void seq_of_chunk(int c, int& s0, int& ns) { if (c < 128) { s0 = c & ~63; ns = 64; } else { s0 = c & ~15; ns = 16; } }

struct TrDesc { const float* W; bf16* WT; const float* ks; int K, N, k0, n0; };
__device__ __forceinline__ void tr_load(const TrDesc& d, int lane, f32x4 (&v)[16]) {
    const float* p = d.W + (size_t)(d.k0 + (lane >> 4)) * d.N + d.n0 + 4 * (lane & 15);
#pragma unroll
    for (int i = 0; i < 16; ++i) v[i] = *(const f32x4*)(p + (size_t)(4 * i) * d.N);
}
__device__ __forceinline__ void tr_store(const TrDesc& d, int lane, const f32x4 (&v)[16], LAS float* scr) {
#pragma unroll
    for (int i = 0; i < 16; ++i) { const int kk = 4 * i + (lane >> 4); const float sc = d.ks ? d.ks[d.k0 + kk] : 1.f; LAS float* q = scr + kk * 65 + 4 * (lane & 15);
        q[0] = v[i][0] * sc; q[1] = v[i][1] * sc; q[2] = v[i][2] * sc; q[3] = v[i][3] * sc; }
    asm volatile("s_waitcnt lgkmcnt(0)" ::: "memory");
    const int c = lane & 7;
#pragma unroll
    for (int j = 0; j < 8; ++j) { const int n = (lane >> 3) + 8 * j; const LAS float* s = scr + (8 * c) * 65 + n;
        v4u o; o.x = pk2(s[0 * 65], s[1 * 65]); o.y = pk2(s[2 * 65], s[3 * 65]); o.z = pk2(s[4 * 65], s[5 * 65]); o.w = pk2(s[6 * 65], s[7 * 65]);
        *(v4u*)(d.WT + (size_t)(d.n0 + n) * d.K + d.k0 + 8 * c) = o; }
    asm volatile("s_waitcnt lgkmcnt(0)" ::: "memory");
}
constexpr int TI_IN = (DMOD / 64) * (NZ / 64), TI_SQ = (DMOD / 64) * (DMOD / 64), TI_PR = (PLE / 64) * (DMOD / 64), TI_L1 = 4, TI_L = 16 * TI_L1;
constexpr int TI_LAYER = TI_IN + 2 * TI_SQ + TI_PR + TI_L;
constexpr int TI_EARLY = TI_IN + TI_L, TI_LATE0 = 2 * TI_SQ + TI_PR, TI_LATE = TI_LATE0 + TI_LAYER;
__device__ __forceinline__ TrDesc tr_decode(const Params& P, int late, int it) {
    unsigned char* ws = P.ws; TrDesc d; int l, r;
    if (!late) { l = 0; r = it < TI_IN ? it : it + 2 * TI_SQ + TI_PR; }
    else if (it < TI_LATE0) { l = 0; r = TI_IN + it; }
    else { l = 1; r = it - TI_LATE0; }
    if (r < TI_IN) { d.W = P.w_in + (size_t)l * DMOD * NZ; d.K = DMOD; d.N = NZ; d.WT = (bf16*)(ws + WS_WIN) + (size_t)l * NZ * DMOD; d.ks = P.norm_mix + l * DMOD; }
    else if ((r -= TI_IN) < TI_SQ) { d.W = P.w_out + (size_t)l * DMOD * DMOD; d.K = DMOD; d.N = DMOD; d.WT = (bf16*)(ws + WS_WOUT) + (size_t)l * DMOD * DMOD; d.ks = nullptr; }
    else if ((r -= TI_SQ) < TI_SQ) { d.W = P.ple_w_gate + (size_t)l * DMOD * DMOD; d.K = DMOD; d.N = DMOD; d.WT = (bf16*)(ws + WS_WGATE) + (size_t)l * DMOD * DMOD; d.ks = P.ple_norm + l * DMOD; }
    else if ((r -= TI_SQ) < TI_PR) { d.W = P.ple_w_proj + (size_t)l * PLE * DMOD; d.K = PLE; d.N = DMOD; d.WT = (bf16*)(ws + WS_WPROJ) + (size_t)l * DMOD * PLE; d.ks = nullptr; }
    else { r -= TI_PR; const int mat = r / TI_L1; r = r % TI_L1;
        const int dir = mat >> 3, which = (mat >> 2) & 1, h = mat & 3;
        d.W = (which ? P.lru_w_i : P.lru_w_a) + ((size_t)((l * 2 + dir) * 4 + h)) * 128 * 128; d.K = 128; d.N = 128;
        d.WT = (bf16*)(ws + WS_WL) + ((size_t)(((l * 2 + dir) * 2 + which) * 4 + h)) * 128 * 128; d.ks = nullptr; }
    const int nblk = d.N / 64; d.k0 = 64 * (r / nblk); d.n0 = 64 * (r % nblk);
    return d;
}

__device__ __forceinline__ void tr_run(const Params& P, LAS unsigned char* lds, int tid, int G, int late, int nitems) {
    asm volatile("" : "+v"(tid));
    const int lane = tid & 63, wave = tid >> 6, gw = blockIdx.x * NWAVES + wave, NGW = G * NWAVES;
    LAS float* scr = (LAS float*)(lds + wave * 16640);
    int it = gw; TrDesc d; f32x4 va[16];
    if (it < nitems) { d = tr_decode(P, late, it); tr_load(d, lane, va); }
    while (it < nitems) {
        const int nx = it + NGW; TrDesc dn = d; f32x4 vb[16];
        if (nx < nitems) { dn = tr_decode(P, late, nx); tr_load(dn, lane, vb); }
        tr_store(d, lane, va, scr);
        it = nx; d = dn;
#pragma unroll
        for (int i = 0; i < 16; ++i) va[i] = vb[i];
    }
}

__device__ __forceinline__ void p0_prologue(const Params& P, LAS unsigned char* lds, int tid, int G) {
    asm volatile("" : "+v"(tid));
    const int lane = tid & 63, wave = tid >> 6;
    const int gw = blockIdx.x * NWAVES + wave, NGW = G * NWAVES;
    const long gt = (long)blockIdx.x * NTHR + tid, NGT = (long)G * NTHR;
    unsigned char* ws = P.ws;
    { float* ssq = (float*)(ws + WS_SSQ); for (long i = gt; i < 4L * MTOK; i += NGT) ssq[MTOK + i] = 0.f; }
    tr_run(P, lds, tid, G, 0, TI_EARLY);
    { bf16* hbA = (bf16*)(ws + WS_HBA); float* ssq = (float*)(ws + WS_SSQ);
      for (int row = gw; row < MTOK; row += NGW) {
          const float* xr = (row < 16384 ? P.x_prompt + (size_t)row * DMOD : P.x_sample + (size_t)(row - 16384) * DMOD);
          float s = 0.f;
#pragma unroll
          for (int j = 0; j < 8; ++j) { const f32x4 v = *(const f32x4*)(xr + 4 * lane + 256 * j); s += v[0] * v[0] + v[1] * v[1] + v[2] * v[2] + v[3] * v[3];
              v2u o; o.x = pk2(v[0], v[1]); o.y = pk2(v[2], v[3]); *(v2u*)(hbA + (size_t)row * DMOD + 4 * lane + 256 * j) = o; }
          s = wave_sum(s); if (lane == 0) ssq[row] = s; } }
}

__device__ __forceinline__ void pb_convert(const Params& P, int tid, int G) {
    asm volatile("" : "+v"(tid));
    const long gt = (long)blockIdx.x * NTHR + tid, NGT = (long)G * NTHR;
    unsigned char* ws = P.ws;
    { bf16* pb = (bf16*)(ws + WS_PB);
      for (long i = gt; i < 2L * MTOK * PLE / 4; i += NGT) { const long e = i * 4; const int l = (int)(e / ((long)MTOK * PLE)); const long r = e % ((long)MTOK * PLE);
          const float* src = (r < 16384L * PLE) ? P.p_prompt + (size_t)l * 16384 * PLE + r : P.p_sample + (size_t)l * 16384 * PLE + (r - 16384L * PLE);
          const f32x4 v = *(const f32x4*)src; v2u o; o.x = pk2(v[0], v[1]); o.y = pk2(v[2], v[3]); *(v2u*)(pb + e) = o; } }
}

__device__ __forceinline__ int t5_bucket(int rel) {
    const int n = rel < 0 ? -rel : rel;
    int b = n < 8 ? n : 8 + (n >= 12) + (n >= 16) + (n >= 23) + (n >= 32) + (n >= 46) + (n >= 64) + (n >= 91);
    return b + (rel > 0 ? 16 : 0);
}
constexpr float AT_SHIFT = 40.f;
constexpr int AT_KP = 272, AT_VP = 320, AT_KB = 64 * AT_KP, AT_VB = 64 * AT_VP, AT_V0 = 2 * AT_KB, AT_TAB = AT_V0 + 2 * AT_VB, AT_TW = 384;

__device__ __forceinline__ void attn_build_tab(LAS unsigned char* lds, const float* rel_bias, int tid) {
    asm volatile("" : "+v"(tid));
    LAS float* tab = (LAS float*)(lds + AT_TAB);
    for (int i = tid; i < 8 * AT_TW; i += NTHR) { const int hd = i / AT_TW, rel = i % AT_TW - 192;
        tab[i] = (rel >= -128 && rel <= 128) ? rel_bias[t5_bucket(rel) * 8 + hd] * LOG2E - AT_SHIFT : -1.0e30f; }
}

template <int VAR>
__device__ __forceinline__ void attn_item(LAS unsigned char* lds, int item, const bf16* z, bf16* mix, const float* sink, int tid) {
    asm volatile("" : "+v"(tid));
    const int c = item >> 2, kvh = (item >> 1) & 1, qhalf = item & 1;
    int s0, ns; seq_of_chunk(c, s0, ns);
    const int w = tid >> 6, lane = tid & 63, ql = lane & 31, h = lane >> 5;
    const int head = kvh * 4 + (w >> 1);
    const int tb = c * 128, tq = tb + qhalf * 64 + (w & 1) * 32 + ql;
    const int seq_lo = s0 * 128, seq_hi = (s0 + ns) * 128, kwin0 = tb - 128 + qhalf * 64;
    int j_lo = 0, j_hi = 4;
    while (kwin0 + 64 * j_lo < seq_lo) ++j_lo;
    while (kwin0 + 64 * j_hi + 64 > seq_hi) --j_hi;
    v4u stg[4];
    const int pkey = tid >> 4, pc = tid & 15;
    auto prefetch = [&](int j) {
        const bf16* base = z + (size_t)(kwin0 + 64 * j + pkey) * NZ + kvh * 128 + pc * 8;
        stg[0] = *(const v4u*)(base + ZK); stg[1] = *(const v4u*)(base + ZK + (size_t)32 * NZ);
        stg[2] = *(const v4u*)(base + ZV); stg[3] = *(const v4u*)(base + ZV + (size_t)32 * NZ);
    };
    if (VAR != 1) prefetch(j_lo);
    bf16x8 qf[8];
    {
      const int erow_ = lane >> 4, ech_ = lane & 15, tq0_ = tb + qhalf * 64 + (w & 1) * 32; LAS unsigned char* qst = lds + w * (32 * 272);
      v4u qv[8];
#pragma unroll
      for (int i = 0; i < 8; ++i) qv[i] = *(const v4u*)(z + (size_t)(tq0_ + 4 * i + erow_) * NZ + ZQ + head * 128 + ech_ * 8);
#pragma unroll
      for (int i = 0; i < 8; ++i) *(LAS v4u*)(qst + (4 * i + erow_) * 272 + ech_ * 16) = qv[i];
#pragma unroll
      for (int ks = 0; ks < 8; ++ks) qf[ks] = *(const LAS bf16x8*)(qst + ql * 272 + (16 * ks + 8 * h) * 2);
      __syncthreads(); }
    float lsum = (h == 0) ? __builtin_amdgcn_exp2f(sink[head] * LOG2E - AT_SHIFT) : 0.f;
    f32x16 O[4];
#pragma unroll
    for (int dt = 0; dt < 4; ++dt)
#pragma unroll
        for (int i = 0; i < 16; ++i) O[dt][i] = 0.f;
    const LAS float* tabh = (const LAS float*)(lds + AT_TAB) + head * AT_TW;
    const float c1 = 0.08838834764831845f * LOG2E;
    const int g4 = lane >> 4, q4 = (lane & 15) >> 2, p4 = lane & 3;
    const int tq0g = tb + qhalf * 64 + (w & 1) * 32;
    v4u gv[8];
    for (int j = j_lo; j <= j_hi; ++j) {
        LAS unsigned char* Kb = lds + (j & 1) * AT_KB; LAS unsigned char* Vb = lds + AT_V0 + (j & 1) * AT_VB;
        if (VAR != 1) {
        *(LAS v4u*)(Kb + pkey * AT_KP + pc * 16) = stg[0]; *(LAS v4u*)(Kb + (pkey + 32) * AT_KP + pc * 16) = stg[1];
        *(LAS v4u*)(Vb + pkey * AT_VP + pc * 16) = stg[2]; *(LAS v4u*)(Vb + (pkey + 32) * AT_VP + pc * 16) = stg[3];
        if (j < j_hi) prefetch(j + 1);
        }
        __syncthreads();
        if (j == j_hi) {
#pragma unroll
            for (int i = 0; i < 8; ++i) gv[i] = *(const v4u*)(z + (size_t)(tq0g + 4 * i + (lane >> 4)) * NZ + ZGA + head * 128 + (lane & 15) * 8);
        }
        f32x16 s[2];
#pragma unroll
        for (int kt = 0; kt < 2; ++kt) {
#pragma unroll
            for (int i = 0; i < 16; ++i) s[kt][i] = 0.f;
#pragma unroll
            for (int ks = 0; ks < 8; ++ks) { const bf16x8 kf = *(const LAS bf16x8*)(Kb + (kt * 32 + ql) * AT_KP + (16 * ks + 8 * h) * 2);
                s[kt] = __builtin_amdgcn_mfma_f32_32x32x16_bf16(kf, qf[ks], s[kt], 0, 0, 0); }
        }
        float ps = 0.f;
#pragma unroll
        for (int kt = 0; kt < 2; ++kt) { const LAS float* tp = tabh + ((kwin0 + 64 * j + 32 * kt + 4 * h) - tq + 192);
#pragma unroll
            for (int i = 0; i < 16; ++i) { float p; asm("v_exp_f32_e64 %0, %1 clamp" : "=v"(p) : "v"(s[kt][i] * c1 + tp[(i & 3) + 8 * (i >> 2)])); s[kt][i] = p; ps += p; } }
        lsum += ps;
#pragma unroll
        for (int kt = 0; kt < 2; ++kt)
#pragma unroll
            for (int s2 = 0; s2 < 2; ++s2) {
                v4u pw; pw.x = pk2(s[kt][8 * s2 + 0], s[kt][8 * s2 + 1]); pw.y = pk2(s[kt][8 * s2 + 2], s[kt][8 * s2 + 3]);
                pw.z = pk2(s[kt][8 * s2 + 4], s[kt][8 * s2 + 5]); pw.w = pk2(s[kt][8 * s2 + 6], s[kt][8 * s2 + 7]);
                const bf16x8 pf = __builtin_bit_cast(bf16x8, pw);
                const LAS unsigned char* vrow = Vb + (32 * kt + 16 * s2 + 4 * h + q4) * AT_VP + (16 * (g4 & 1) + 4 * p4) * 2;
#pragma unroll
                for (int dt = 0; dt < 4; ++dt) {
                    const s16x4 lo = __builtin_amdgcn_ds_read_tr16_b64_v4i16((LAS s16x4*)(vrow + dt * 64));
                    const s16x4 hi = __builtin_amdgcn_ds_read_tr16_b64_v4i16((LAS s16x4*)(vrow + dt * 64 + 8 * AT_VP));
                    const bf16x8 vf = __builtin_shufflevector(lo, hi, 0, 1, 2, 3, 4, 5, 6, 7);
                    O[dt] = __builtin_amdgcn_mfma_f32_32x32x16_bf16(vf, pf, O[dt], 0, 0, 0);
                }
            }
    }
    const float ltot = lsum + __shfl_xor(lsum, 32), inv = 1.f / ltot;
    const int erow = lane >> 4, ech = lane & 15, tq0 = tb + qhalf * 64 + (w & 1) * 32;
    __syncthreads();
    LAS unsigned char* ost = lds + w * (32 * 272);
#pragma unroll
    for (int dt = 0; dt < 4; ++dt)
#pragma unroll
        for (int rg = 0; rg < 4; ++rg) { v2u ow; ow.x = pk2(O[dt][4 * rg + 0] * inv, O[dt][4 * rg + 1] * inv); ow.y = pk2(O[dt][4 * rg + 2] * inv, O[dt][4 * rg + 3] * inv);
            *(LAS v2u*)(ost + ql * 272 + (32 * dt + 8 * rg + 4 * h) * 2) = ow; }
    if (VAR != 3) {
#pragma unroll
        for (int i = 0; i < 8; ++i) { const v4u ov = *(const LAS v4u*)(ost + (4 * i + erow) * 272 + ech * 16); const v4u g = gv[i];
            v4u r; r.x = pk2(bflo(ov.x) * silu(bflo(g.x)), bfhi(ov.x) * silu(bfhi(g.x))); r.y = pk2(bflo(ov.y) * silu(bflo(g.y)), bfhi(ov.y) * silu(bfhi(g.y)));
            r.z = pk2(bflo(ov.z) * silu(bflo(g.z)), bfhi(ov.z) * silu(bfhi(g.z))); r.w = pk2(bflo(ov.w) * silu(bflo(g.w)), bfhi(ov.w) * silu(bfhi(g.w)));
            *(v4u*)(mix + (size_t)(tq0 + 4 * i + erow) * DMOD + head * 128 + ech * 8) = r; }
    }
    __syncthreads();
}

__device__ __forceinline__ void conv_phase(const bf16* z, bf16* mix, const float* cw  , int G, int tid) {
    asm volatile("" : "+v"(tid));
    const long NW = (long)MTOK * 64;
#pragma unroll 2
    for (long i = (long)blockIdx.x * NTHR + tid; i < NW; i += (long)G * NTHR) {
        const int t = (int)(i >> 6), cg8 = (int)(i & 63) * 8;
        int s0, ns; seq_of_chunk(t >> 7, s0, ns);
        const bool hasp = t > s0 * 128, hasn = t + 1 < (s0 + ns) * 128;
        const bf16* zr = z + (size_t)t * NZ;
        const v4u cb = *(const v4u*)(zr + ZCB + cg8), gc = *(const v4u*)(zr + ZGC + cg8);
        const v4u c1 = *(const v4u*)(zr + ZCC + cg8), x1 = *(const v4u*)(zr + ZCX + cg8);
        v4u c0 = {0, 0, 0, 0}, x0 = {0, 0, 0, 0}, c2 = {0, 0, 0, 0}, x2 = {0, 0, 0, 0};
        if (hasp) { c0 = *(const v4u*)(zr - NZ + ZCC + cg8); x0 = *(const v4u*)(zr - NZ + ZCX + cg8); }
        if (hasn) { c2 = *(const v4u*)(zr + NZ + ZCC + cg8); x2 = *(const v4u*)(zr + NZ + ZCX + cg8); }
        float o[8];
#pragma unroll
        for (int e = 0; e < 4; ++e) {
#pragma unroll
            for (int hh = 0; hh < 2; ++hh) { const int ch = cg8 + 2 * e + hh;
                const float a0 = hh ? bfhi(c0[e]) * bfhi(x0[e]) : bflo(c0[e]) * bflo(x0[e]);
                const float a1 = hh ? bfhi(c1[e]) * bfhi(x1[e]) : bflo(c1[e]) * bflo(x1[e]);
                const float a2 = hh ? bfhi(c2[e]) * bfhi(x2[e]) : bflo(c2[e]) * bflo(x2[e]);
                const float cv = cw[ch] * a0 + cw[512 + ch] * a1 + cw[1024 + ch] * a2;
                const float b = hh ? bfhi(cb[e]) : bflo(cb[e]), g = hh ? bfhi(gc[e]) : bflo(gc[e]);
                o[2 * e + hh] = b * cv * silu(g); } }
        v4u ow; ow.x = pk2(o[0], o[1]); ow.y = pk2(o[2], o[3]); ow.z = pk2(o[4], o[5]); ow.w = pk2(o[6], o[7]);
        *(v4u*)(mix + (size_t)t * DMOD + 1024 + cg8) = ow;
    }
}

constexpr int LR_XC = 0, LR_XCP = 272, LR_PB = 128 * LR_XCP, LR_Y = 2 * 128 * LR_XCP, LR_YP = 132;
struct LruLayer { const float *cw, *cb, *ba, *bi, *L; const bf16* WL; };
template <int DIR>
__device__ __forceinline__ void lru_load(v4u (&xr)[7], const bf16* z, int tb, int hh, int seq_lo, int seq_hi, int tid) {
    const int pc = tid & 15, base = tb + 4 * (tid >> 4) + (DIR ? 0 : -3);
#pragma unroll
    for (int k = 0; k < 7; ++k) { const int tok = base + k; const int tc = tok < seq_lo ? seq_lo : (tok >= seq_hi ? seq_hi - 1 : tok);
        xr[k] = *(const v4u*)(z + (size_t)tc * NZ + ZXL + hh * 128 + pc * 8); }
}
template <int DIR>
__device__ __forceinline__ void lru_bload(bf16x8 (&b)[8], const LruLayer& LP, int hh, int tid) {
    const int lane = tid & 63, chl = 16 * (tid >> 6) + (lane & 15), q = lane >> 4;
    const bf16* wa = LP.WL + ((size_t)((DIR * 2 + 0) * 4 + hh)) * 16384 + (size_t)chl * 128 + 8 * q;
    const bf16* wi = LP.WL + ((size_t)((DIR * 2 + 1) * 4 + hh)) * 16384 + (size_t)chl * 128 + 8 * q;
#pragma unroll
    for (int ks = 0; ks < 4; ++ks) { b[ks] = *(const bf16x8*)(wa + 32 * ks); b[4 + ks] = *(const bf16x8*)(wi + 32 * ks); }
}
template <int DIR>
__device__ __forceinline__ void lru_dir(LAS unsigned char* lds, const bf16* z, const LruLayer& LP, float* agg, bf16* PFB, int c, int hh, int seq_lo, int seq_hi, int tid,
                                        v4u (&xr)[7], v4u (&xnx)[7], bf16x8 (&bcur)[8], bf16x8 (&bnx)[8], bool pf, int pf_tb, int pf_hh, int pf_lo, int pf_hi) {
    const int w = tid >> 6, lane = tid & 63, tb = c * 128;
    const int chl = 16 * w + (lane & 15), chg = hh * 128 + chl, q = lane >> 4;
    LAS float* Y = (LAS float*)(lds + LR_Y);
    const float nba = -LOG2E * LP.ba[DIR * 512 + chg], nbi = -LOG2E * LP.bi[DIR * 512 + chg];
    const float c8 = -8.f * LOG2E * log1pf(__expf(-LP.L[DIR * 512 + chg]));
    { const int pc = tid & 15, tg = tid >> 4;
      const float* cb = LP.cb + DIR * 512 + hh * 128 + pc * 8; const f32x4 c0 = *(const f32x4*)cb, c1 = *(const f32x4*)(cb + 4);
      f32x4 w0[4], w1[4];
#pragma unroll
      for (int k = 0; k < 4; ++k) { const float* wk = LP.cw + (DIR * 4 + k) * 512 + hh * 128 + pc * 8; w0[k] = *(const f32x4*)wk; w1[k] = *(const f32x4*)(wk + 4); }
      const int base = tb + 4 * tg + (DIR ? 0 : -3);
#pragma unroll
      for (int i = 0; i < 4; ++i) { f32x4 a0 = c0, a1 = c1; const int t = 4 * tg + i;
#pragma unroll
          for (int k = 0; k < 4; ++k) { const int tok = base + i + k; const bool ok = tok >= seq_lo && tok < seq_hi; v4u xv = xr[i + k];
              if (!ok) xv = (v4u){0u, 0u, 0u, 0u};
              a0[0] += w0[k][0] * bflo(xv[0]); a0[1] += w0[k][1] * bfhi(xv[0]); a0[2] += w0[k][2] * bflo(xv[1]); a0[3] += w0[k][3] * bfhi(xv[1]);
              a1[0] += w1[k][0] * bflo(xv[2]); a1[1] += w1[k][1] * bfhi(xv[2]); a1[2] += w1[k][2] * bflo(xv[3]); a1[3] += w1[k][3] * bfhi(xv[3]); }
          v4u o; o.x = pk2(a0[0], a0[1]); o.y = pk2(a0[2], a0[3]); o.z = pk2(a1[0], a1[1]); o.w = pk2(a1[2], a1[3]);
          const int s = DIR ? 127 - t : t, row = 16 * ((s & 31) >> 2) + 4 * (s >> 5) + (s & 3);
          *(LAS v4u*)(lds + LR_XC + row * LR_XCP + pc * 16) = o; } }
    __syncthreads();
    f32x4 ar[8], ai[8];
#pragma unroll
    for (int mt = 0; mt < 8; ++mt) { ar[mt] = (f32x4){0.f, 0.f, 0.f, 0.f}; ai[mt] = (f32x4){0.f, 0.f, 0.f, 0.f}; }
#pragma unroll
    for (int ks = 0; ks < 4; ++ks) {
#pragma unroll
        for (int mt = 0; mt < 8; ++mt) { const bf16x8 af = *(const LAS bf16x8*)(lds + LR_XC + (16 * mt + (lane & 15)) * LR_XCP + (32 * ks + 8 * q) * 2);
            ar[mt] = __builtin_amdgcn_mfma_f32_16x16x32_bf16(af, bcur[ks], ar[mt], 0, 0, 0);
            ai[mt] = __builtin_amdgcn_mfma_f32_16x16x32_bf16(af, bcur[4 + ks], ai[mt], 0, 0, 0); } }
    if (pf) { lru_load<1 - DIR>(xnx, z, pf_tb, pf_hh, pf_lo, pf_hi, tid); lru_bload<1 - DIR>(bnx, LP, pf_hh, tid); }
    float Al = 1.f, Bl = 0.f;
    const LAS unsigned char* xcp = lds + LR_XC + (4 * q) * LR_XCP + chl * 2;
#pragma unroll
    for (int mt = 0; mt < 8; ++mt)
#pragma unroll
        for (int r = 0; r < 4; ++r) {
            const float er = __builtin_amdgcn_exp2f(__builtin_fmaf(ar[mt][r], -LOG2E, nba)), ei = __builtin_amdgcn_exp2f(__builtin_fmaf(ai[mt][r], -LOG2E, nbi));
            const float dr = 1.f + er, di = 1.f + ei, R = __builtin_amdgcn_rcpf(dr * di);
            const float av = __builtin_amdgcn_exp2f(c8 * (R * di));
            const float xcv = bf1(*(const LAS bf16*)(xcp + (16 * mt + r) * LR_XCP));
            const float uv = __builtin_amdgcn_sqrtf(fmaxf(__builtin_fmaf(-av, av, 1.f), 0.f)) * (R * dr) * xcv;
            ar[mt][r] = av; ai[mt][r] = uv; Bl = __builtin_fmaf(av, Bl, uv); Al *= av; }
    float A4 = Al, B4 = Bl;
    { const float Ap = __shfl_up(A4, 16), Bp = __shfl_up(B4, 16); if (q >= 1) { B4 = A4 * Bp + B4; A4 = A4 * Ap; } }
    { const float Ap = __shfl_up(A4, 32), Bp = __shfl_up(B4, 32); if (q >= 2) { B4 = A4 * Bp + B4; A4 = A4 * Ap; } }
    float Ae = __shfl_up(A4, 16), Be = __shfl_up(B4, 16); if (q == 0) { Ae = 1.f; Be = 0.f; }
    const float At = __shfl(A4, 48 + (lane & 15)), Bt = __shfl(B4, 48 + (lane & 15));
    if (q == 0) { float* ag = agg + (size_t)c * 2048 + (size_t)DIR * 1024 + 2 * chg; ag[0] = At; ag[1] = Bt; }
    { float hcur = Be, pcur = Ae;
      const int tq0 = DIR ? 127 - 32 * q : 32 * q, rot = (chl + 16 * (DIR ? 3 - q : q)) & 127;
      LAS float* yp = Y + tq0 * LR_YP + rot; LAS unsigned char* pp_ = lds + LR_PB + tq0 * LR_XCP + rot * 2;
#pragma unroll
      for (int mt = 0; mt < 8; ++mt)
#pragma unroll
          for (int r = 0; r < 4; ++r) { hcur = __builtin_fmaf(ar[mt][r], hcur, ai[mt][r]); pcur *= ar[mt][r];
              const int dt_ = DIR ? -(4 * mt + r) : (4 * mt + r);
              if (DIR == 0) yp[dt_ * LR_YP] = hcur; else yp[dt_ * LR_YP] += hcur;
              *(LAS bf16*)(pp_ + dt_ * LR_XCP) = (bf16)(pk2(pcur, 0.f) & 0xffffu); } }
    __syncthreads();
    { bf16* dst = PFB + (size_t)DIR * MTOK * 512;
      for (int p = tid; p < 128 * 16; p += NTHR) { const int t = p >> 4, pc = p & 15, pcr = (pc + 2 * (t >> 5)) & 15;
          *(v4u*)(dst + (size_t)(tb + t) * 512 + hh * 128 + pc * 8) = *(const LAS v4u*)(lds + LR_PB + t * LR_XCP + pcr * 16); } }
}

__device__ __forceinline__ void lru_heavy(LAS unsigned char* lds, int item, int next_item, v4u (&xa)[7], v4u (&xb)[7], const bf16* z, const LruLayer& LP, float* agg, bf16* LL, bf16* PFB  , int tid) {
    asm volatile("" : "+v"(tid));
    const int c = item >> 2, hh = item & 3;
    int s0, ns; seq_of_chunk(c, s0, ns);
    const int tb = c * 128, seq_lo = s0 * 128, seq_hi = (s0 + ns) * 128;
    int n_tb = 0, n_hh = 0, n_lo = 0, n_hi = 1;
    if (next_item >= 0) { const int nc = next_item >> 2; int t0_, t1_; seq_of_chunk(nc, t0_, t1_); n_tb = nc * 128; n_hh = next_item & 3; n_lo = t0_ * 128; n_hi = (t0_ + t1_) * 128; }
    bf16x8 ba_[8], bb_[8];
    lru_bload<0>(ba_, LP, hh, tid);
    lru_load<0>(xa, z, tb, hh, seq_lo, seq_hi, tid);
    lru_dir<0>(lds, z, LP, agg, PFB, c, hh, seq_lo, seq_hi, tid, xa, xb, ba_, bb_, true, tb, hh, seq_lo, seq_hi);
    lru_dir<1>(lds, z, LP, agg, PFB, c, hh, seq_lo, seq_hi, tid, xb, xa, bb_, ba_, false, n_tb, n_hh, n_lo, n_hi);
    const LAS float* Y = (const LAS float*)(lds + LR_Y);
    for (int p = tid; p < 128 * 16; p += NTHR) { const int t = p >> 4, pc = p & 15, pcr = (pc + 2 * (t >> 5)) & 15; const LAS float* yr = Y + t * LR_YP + pcr * 8;
        v4u ow; ow.x = pk2(yr[0], yr[1]); ow.y = pk2(yr[2], yr[3]); ow.z = pk2(yr[4], yr[5]); ow.w = pk2(yr[6], yr[7]);
        *(v4u*)(LL + (size_t)(tb + t) * 512 + hh * 128 + pc * 8) = ow; }
    __syncthreads();
}

__device__ __forceinline__ void lru_light(LAS unsigned char* lds, int c, const bf16* z, bf16* mix, const float* agg, const bf16* LL, const bf16* PFB, int tid) {
    asm volatile("" : "+v"(tid));
    int s0, ns; seq_of_chunk(c, s0, ns);
    LAS float* car = (LAS float*)lds;
    {
      const float* ag0 = agg + 2 * tid; const float* ag1 = agg + 1024 + 2 * tid;
      float H0 = 0.f, H1 = 0.f; int cc = s0, cd = s0 + ns - 1;
      for (; cc + 32 <= c; cc += 32) { v2f v[32];
#pragma unroll
          for (int k = 0; k < 32; ++k) v[k] = *(const v2f*)(ag0 + (size_t)(cc + k) * 2048);
#pragma unroll
          for (int k = 0; k < 32; ++k) H0 = v[k][0] * H0 + v[k][1]; }
      for (; cc + 8 <= c; cc += 8) { v2f v[8];
#pragma unroll
          for (int k = 0; k < 8; ++k) v[k] = *(const v2f*)(ag0 + (size_t)(cc + k) * 2048);
#pragma unroll
          for (int k = 0; k < 8; ++k) H0 = v[k][0] * H0 + v[k][1]; }
      for (; cc < c; ++cc) { const v2f v = *(const v2f*)(ag0 + (size_t)cc * 2048); H0 = v[0] * H0 + v[1]; }
      for (; cd - 32 >= c; cd -= 32) { v2f v[32];
#pragma unroll
          for (int k = 0; k < 32; ++k) v[k] = *(const v2f*)(ag1 + (size_t)(cd - k) * 2048);
#pragma unroll
          for (int k = 0; k < 32; ++k) H1 = v[k][0] * H1 + v[k][1]; }
      for (; cd - 8 >= c; cd -= 8) { v2f v[8];
#pragma unroll
          for (int k = 0; k < 8; ++k) v[k] = *(const v2f*)(ag1 + (size_t)(cd - k) * 2048);
#pragma unroll
          for (int k = 0; k < 8; ++k) H1 = v[k][0] * H1 + v[k][1]; }
      for (; cd > c; --cd) { const v2f v = *(const v2f*)(ag1 + (size_t)cd * 2048); H1 = v[0] * H1 + v[1]; }
      car[tid] = H0; car[512 + tid] = H1; }
    __syncthreads();
    const int tb = c * 128;
#pragma unroll 4
    for (int p = tid; p < 128 * 64; p += NTHR) { const int t = p >> 6, c8 = (p & 63) * 8; const size_t ro = (size_t)(tb + t) * 512 + c8;
        const v4u lv = *(const v4u*)(LL + ro), fv = *(const v4u*)(PFB + ro), bv = *(const v4u*)(PFB + (size_t)MTOK * 512 + ro);
        const v4u gv = *(const v4u*)(z + (size_t)(tb + t) * NZ + ZGL + c8);
        float o[8];
#pragma unroll
        for (int e = 0; e < 4; ++e) {
            o[2 * e] = (bflo(lv[e]) + bflo(fv[e]) * car[c8 + 2 * e] + bflo(bv[e]) * car[512 + c8 + 2 * e]) * silu(bflo(gv[e]));
            o[2 * e + 1] = (bfhi(lv[e]) + bfhi(fv[e]) * car[c8 + 2 * e + 1] + bfhi(bv[e]) * car[512 + c8 + 2 * e + 1]) * silu(bfhi(gv[e])); }
        v4u ow; ow.x = pk2(o[0], o[1]); ow.y = pk2(o[2], o[3]); ow.z = pk2(o[4], o[5]); ow.w = pk2(o[6], o[7]);
        *(v4u*)(mix + (size_t)(tb + t) * DMOD + 1536 + c8) = ow; }
    __syncthreads();
}

#define XB_TMO      128
#define XB_XCNT(j)  (256  + 64 * (j))
#define XB_XSUB(j)  (1280 + 64 * (j))
#define XB_XGEN(j)  (2304 + 64 * (j))
#define XB_TOP      3328
#define XB_TOPGEN   3392
#define XCD_BAR_WORDS 3456
#define XB_SPIN_CAP (1u << 18)

__device__ __forceinline__ unsigned xb_ld(unsigned* p)              { return __hip_atomic_load(p, __ATOMIC_RELAXED, __HIP_MEMORY_SCOPE_AGENT); }
__device__ __forceinline__ unsigned xb_add(unsigned* p, unsigned v) { return __hip_atomic_fetch_add(p, v, __ATOMIC_RELAXED, __HIP_MEMORY_SCOPE_AGENT); }
__device__ __forceinline__ unsigned xb_xcc_id() { return (unsigned)__builtin_amdgcn_s_getreg((3 << 11) | 20) & 0xFu; }
#define XB_SPIN(cond, bar) do { unsigned _sp = 0; while (cond) { __builtin_amdgcn_s_sleep(1); \
    if ((++_sp & 255u) == 0u) { if (xb_ld(&(bar)[XB_TMO])) break; if (_sp > XB_SPIN_CAP) { atomicAdd(&(bar)[XB_TMO], 1u); break; } } } } while (0)

struct XcdBarrier {
    unsigned* bar; unsigned x;
    volatile LAS unsigned* st;
};

__device__ __forceinline__ XcdBarrier xcd_barrier_post(unsigned* bar, volatile LAS unsigned* st) {
    XcdBarrier b; b.bar = bar; b.x = xb_xcc_id(); b.st = st;
    if (threadIdx.x == 0) (void)xb_add(&bar[XB_XCNT(b.x)], 1u);
    return b;
}
__device__ __forceinline__ void xcd_barrier_complete(unsigned* bar, unsigned x, unsigned& nloc, unsigned& nx) {
    const unsigned G = gridDim.x * gridDim.y * gridDim.z;
    unsigned sum, cnt, mine, sp = 0u;
    for (;;) {
        sum = 0u; cnt = 0u; mine = 0u;
#pragma unroll
        for (unsigned j = 0; j < 16; ++j) { const unsigned c = xb_ld(&bar[XB_XCNT(j)]); sum += c; cnt += (c > 0u) ? 1u : 0u; mine = (j == x) ? c : mine; }
        if (sum == G) break;
        __builtin_amdgcn_s_sleep(1);
        if ((++sp & 255u) == 0u) { if (xb_ld(&bar[XB_TMO])) break; if (sp > XB_SPIN_CAP) { atomicAdd(&bar[XB_TMO], 1u); break; } }
    }
    nloc = mine > 0u ? mine : 1u; nx = cnt > 0u ? cnt : 1u;
}

__device__ __forceinline__ void xcd_barrier(const XcdBarrier& b) {
    asm volatile("s_waitcnt vmcnt(0)" ::: "memory");
    __syncthreads();
    if (threadIdx.x == 0) {
        unsigned* bar = b.bar;
        __builtin_amdgcn_s_waitcnt(0);
        unsigned nloc = b.st[0], nx = b.st[1];
        if (nloc == 0u) { xcd_barrier_complete(bar, b.x, nloc, nx); b.st[0] = nloc; b.st[1] = nx; }
        const unsigned old = xb_add(&bar[XB_XSUB(b.x)], 1u);
        const unsigned gen = old / nloc;
        if (old + 1u == (gen + 1u) * nloc) {
            __builtin_amdgcn_fence(__ATOMIC_RELEASE, "agent");
            asm volatile("s_waitcnt vmcnt(0)" ::: "memory");
            const unsigned og = xb_add(&bar[XB_TOP], 1u);
            const unsigned tg = og / nx;
            if (og + 1u == (tg + 1u) * nx) xb_add(&bar[XB_TOPGEN], 1u);
            else XB_SPIN(xb_ld(&bar[XB_TOPGEN]) == tg, bar);
            __builtin_amdgcn_fence(__ATOMIC_ACQUIRE, "agent");
            xb_add(&bar[XB_XGEN(b.x)], 1u);
            asm volatile("s_waitcnt vmcnt(0)" ::: "memory");
        } else {
            XB_SPIN(xb_ld(&bar[XB_XGEN(b.x)]) == gen, bar);
            __builtin_amdgcn_fence(__ATOMIC_ACQUIRE, "agent");
            asm volatile("s_waitcnt vmcnt(0)" ::: "memory");
        }
    }
    __syncthreads();
}

constexpr int RS_OFF = 131072;
__device__ __forceinline__ void rstd_stage(LAS unsigned char* lds, const pg8::StaticOrder& S, const float* ssq, int tid) {
    asm volatile("" : "+v"(tid));
    int last = -1;
    for (int i = 0; ; ++i) { pg8::Unit u; if (!S.next(i, u)) break;
        if (u.pm != last) { last = u.pm; if (tid < 256) ((LAS float*)(lds + RS_OFF))[((u.pm >> 3) & 3) * 256 + tid] = rsqrtf(ssq[u.pm * 256 + tid] * (1.f / DMOD) + 1e-6f); } }
    __syncthreads();
}

#ifndef PH_LO
#define PH_LO 0
#endif
__global__ void __launch_bounds__(NTHR, 2) fwd_megakernel(Params P) {
    extern __shared__ __attribute__((aligned(16))) unsigned char lds_raw[];
    LAS unsigned char* lds = (LAS unsigned char*)lds_raw;
    cg::grid_group grid = cg::this_grid();
    const int tid = threadIdx.x, G = gridDim.x;
    unsigned char* ws = P.ws;
    volatile LAS unsigned* MISC = (volatile LAS unsigned*)(lds + LDS_BYTES - 64);
    if (tid < 16) MISC[tid] = 0u;
    __syncthreads();
    (void)xcd_barrier_post((unsigned*)(ws + WS_CTL), MISC);
#define GRID_BAR() do { unsigned char* w_ = P.ws; asm volatile("" : "+s"(w_)); XcdBarrier b_; b_.bar = (unsigned*)(w_ + WS_CTL); b_.x = xb_xcc_id(); \
        b_.st = (volatile LAS unsigned*)(lds + LDS_BYTES - 64); xcd_barrier(b_); } while (0)
    float* ssq = (float*)(ws + WS_SSQ); float* agg = (float*)(ws + WS_AGG);
    bf16* hbA = (bf16*)(ws + WS_HBA); bf16* hbB = (bf16*)(ws + WS_HBB); bf16* mix = (bf16*)(ws + WS_MIX); bf16* pp = (bf16*)(ws + WS_PP); bf16* z = (bf16*)(ws + WS_Z);

#ifndef NO_P0
    p0_prologue(P, lds, tid, G);
#ifdef DUP_P0
    __syncthreads(); p0_prologue(P, lds, tid, G);
#endif
#endif
    if (P.ws == nullptr) grid.sync();
    GRID_BAR();
#ifdef DUP_SYNC
#pragma unroll 1
    for (int r = 0; r < 10; ++r) GRID_BAR();
#endif
#pragma unroll 1
    for (int l = 0; l < 2; ++l) {
        { pg8::Gemm g{hbA, (const bf16*)(ws + WS_WIN) + (size_t)l * NZ * DMOD, MTOK, NZ, DMOD}; pg8::StaticOrder S; S.init(MTOK, NZ, G, (int)blockIdx.x);
          rstd_stage(lds, S, ssq + (size_t)(2 * l) * MTOK, tid);
          pg8::EpiZ E{z, NZ, (const LAS float*)(lds + RS_OFF)};
#ifdef STAG_A
          { const unsigned long long t0 = __builtin_amdgcn_s_memrealtime(); const unsigned long long wt = (unsigned long long)((blockIdx.x >> 3) & 3) * STAG_A;
            while (__builtin_amdgcn_s_memrealtime() - t0 < wt) __builtin_amdgcn_s_sleep(32); }
#endif
          pg8::gemm_phase<pg8::EpiZ, pg8::StaticOrder, true, true>(lds, g, S, E);
#ifdef DUP_A
          pg8::gemm_phase<pg8::EpiZ, pg8::StaticOrder, true, true>(lds, g, S, E);
#endif
 }
        GRID_BAR();
#ifdef DUP_MIX
        for (int rep = 0; rep < 2; ++rep) {
#endif
        LruLayer LP{P.lru_conv_w + (size_t)l * 2 * 4 * 512, P.lru_conv_b + l * 1024, P.lru_b_a + l * 1024, P.lru_b_i + l * 1024, P.lru_L + l * 1024, (const bf16*)(ws + WS_WL) + (size_t)l * 16 * 16384};
        bf16* LL = hbB; bf16* PFB = hbB + (size_t)MTOK * 512;
#pragma unroll 1
        for (int step = 0; step < 2; ++step) {
            if ((step ^ ((blockIdx.x >> 3) & 1)) == 0) {
                { v4u xa[7], xb[7];
                  for (int it = blockIdx.x; it < NCHUNK * 4; it += G) lru_heavy(lds, it, (it + G < NCHUNK * 4) ? it + G : -1, xa, xb, z, LP, agg, LL, PFB, tid); }
            } else {
                conv_phase(z, mix, P.conv_w + (size_t)l * 3 * 512, G, tid);
                if (l == 0) { pb_convert(P, tid, G); tr_run(P, lds, tid, G, 1, TI_LATE); }
                __syncthreads();
            }
        }
        GRID_BAR();
        attn_build_tab(lds, P.rel_bias, tid);
        __syncthreads();
#pragma unroll 1
        for (int step = 0; step < 2; ++step) {
        if ((step ^ ((blockIdx.x >> 3) & 1)) == 0) {
#ifndef NO_ATTN
        if (G == 256) {
            const int xc = (blockIdx.x & 7) * 32 + (blockIdx.x >> 3);
#pragma unroll 1
            for (int r = 0; r < 4; ++r) attn_item<0>(lds, xc * 4 + r, z, mix, P.attn_sink + l * 8, tid);
        } else
        for (int it = blockIdx.x; it < NCHUNK * 4; it += G) attn_item<0>(lds, it, z, mix, P.attn_sink + l * 8, tid);
#ifdef DUP_ATTN
        { const int xc = (blockIdx.x & 7) * 32 + (blockIdx.x >> 3);
#pragma unroll 1
          for (int r = 0; r < 4; ++r) attn_item<DUP_ATTN - 1>(lds, xc * 4 + r, z, (bf16*)P.out, P.attn_sink + l * 8, tid); }
#endif
#endif
        } else {
        for (int it = blockIdx.x; it < NCHUNK; it += G) lru_light(lds, it, z, mix, agg, LL, PFB, tid);
#ifdef DUP_LIGHT
        for (int it = blockIdx.x; it < NCHUNK; it += G) lru_light(lds, it, z, mix, agg, LL, PFB, tid);
#endif
        __syncthreads();
        } }
        GRID_BAR();
#ifdef DUP_MIX
        }
#endif
#pragma unroll 1
        for (int step = 0; step < 2; ++step) {
            if ((step ^ ((blockIdx.x >> 3) & 1)) == 0) {
                pg8::Gemm g{mix, (const bf16*)(ws + WS_WOUT) + (size_t)l * DMOD * DMOD, MTOK, DMOD, DMOD}; pg8::StaticOrder S; S.init(MTOK, DMOD, G, (int)blockIdx.x);
#ifdef TIME_EPI
                unsigned tacc_ = 0u;
                pg8::EpiRes E{hbA, hbB, ssq + (size_t)(2 * l + 1) * MTOK, &tacc_};
                pg8::gemm_phase<pg8::EpiRes, pg8::StaticOrder, true, true>(lds, g, S, E);
                { const unsigned long long t0 = __builtin_amdgcn_s_memrealtime(); const unsigned long long wt = 8ull * tacc_; while (__builtin_amdgcn_s_memrealtime() - t0 < wt) __builtin_amdgcn_s_sleep(32); }
#else
                pg8::EpiRes E{hbA, hbB, ssq + (size_t)(2 * l + 1) * MTOK};
                pg8::gemm_phase<pg8::EpiRes, pg8::StaticOrder, true, true>(lds, g, S, E);
#endif
            } else {
                pg8::Gemm g{(const bf16*)(ws + WS_PB) + (size_t)l * MTOK * PLE, (const bf16*)(ws + WS_WPROJ) + (size_t)l * DMOD * PLE, MTOK, DMOD, PLE}; pg8::StaticOrder S; S.init(MTOK, DMOD, G, (int)blockIdx.x);
                pg8::EpiZ E{pp, 0, nullptr};
                pg8::gemm_phase<pg8::EpiZ, pg8::StaticOrder, true, true>(lds, g, S, E);
            }
        }
        GRID_BAR();
        { pg8::Gemm g{hbB, (const bf16*)(ws + WS_WGATE) + (size_t)l * DMOD * DMOD, MTOK, DMOD, DMOD}; pg8::StaticOrder S; S.init(MTOK, DMOD, G, (int)blockIdx.x);
          rstd_stage(lds, S, ssq + (size_t)(2 * l + 1) * MTOK, tid);
          pg8::EpiGate E{(const LAS float*)(lds + RS_OFF), hbB, pp, hbA, ssq + (size_t)(2 * l + 2) * MTOK};
#ifndef NO_GD
          pg8::gemm_phase<pg8::EpiGate, pg8::StaticOrder, true, true>(lds, g, S, E);
#endif
 }
        GRID_BAR();
    }
    { const int lane = tid & 63, gw = blockIdx.x * NWAVES + (tid >> 6), NGW = G * NWAVES; const float* sf = ssq + (size_t)4 * MTOK;
      for (int row = gw; row < MTOK; row += NGW) { const float rs = rsqrtf(sf[row] * (1.f / DMOD) + 1e-6f); float* orow = P.out + (size_t)row * DMOD; const bf16* hrow = hbA + (size_t)row * DMOD;
#pragma unroll
          for (int j = 0; j < 4; ++j) { const int cidx = 8 * lane + 512 * j; const v4u hv = *(const v4u*)(hrow + cidx); const f32x4 g0 = *(const f32x4*)(P.final_norm + cidx), g1 = *(const f32x4*)(P.final_norm + cidx + 4);
              f32x4 v0, v1; v0[0] = bflo(hv.x) * rs * g0[0]; v0[1] = bfhi(hv.x) * rs * g0[1]; v0[2] = bflo(hv.y) * rs * g0[2]; v0[3] = bfhi(hv.y) * rs * g0[3];
              v1[0] = bflo(hv.z) * rs * g1[0]; v1[1] = bfhi(hv.z) * rs * g1[1]; v1[2] = bflo(hv.w) * rs * g1[2]; v1[3] = bfhi(hv.w) * rs * g1[3];
              *(f32x4*)(orow + cidx) = v0; *(f32x4*)(orow + cidx + 4) = v1; } } }
}

extern "C" void kernel_launch(void* const* d_in, const int* in_sizes, int n_in, void* d_out, int out_size, void* d_ws, size_t ws_size, hipStream_t stream) {
    static int grid_blocks = 0;
    if (!grid_blocks) {
        if (n_in != 21 || ws_size < WS_END) { fprintf(stderr, "kernel_launch: unexpected n_in %d / ws_size %zu\n", n_in, ws_size); grid_blocks = -1; return; }
        int dev = 0, cus = 0, per_cu = 0;
        (void)hipGetDevice(&dev);
        (void)hipDeviceGetAttribute(&cus, hipDeviceAttributeMultiprocessorCount, dev);
        (void)hipFuncSetAttribute((const void*)fwd_megakernel, hipFuncAttributeMaxDynamicSharedMemorySize, LDS_BYTES);
        (void)hipOccupancyMaxActiveBlocksPerMultiprocessor(&per_cu, (const void*)fwd_megakernel, NTHR, LDS_BYTES);
        if (per_cu < 1) { fprintf(stderr, "kernel_launch: occupancy query says %d blocks/CU\n", per_cu); per_cu = 1; }
        grid_blocks = cus;
    }
    if (grid_blocks < 0) return;
    (void)hipMemsetAsync((unsigned char*)d_ws + WS_CTL, 0, CTL_BYTES, stream);
    Params p{};
    const float** pf = (const float**)&p;
    for (int i = 0; i < 21; ++i) pf[i] = (const float*)d_in[i];
    p.out = (float*)d_out; p.ws = (unsigned char*)d_ws;
    void* args[] = {&p};
    hipError_t e = hipLaunchCooperativeKernel((void*)fwd_megakernel, dim3(grid_blocks), dim3(NTHR), args, LDS_BYTES, stream);
    if (e != hipSuccess) fprintf(stderr, "cooperative launch failed: %s (grid %d)\n", hipGetErrorString(e), grid_blocks);
}
```

```cpp
#include <hip/hip_runtime.h>
#include <hip/hip_cooperative_groups.h>
#include <cstdio>
#include <cstdint>
namespace cg = cooperative_groups;
namespace pg8 {
#define PG8_LAS __attribute__((address_space(3)))
typedef unsigned short bf16_t;
typedef short bf16x8 __attribute__((ext_vector_type(8)));
typedef float f32x4 __attribute__((ext_vector_type(4)));
typedef unsigned u32x4 __attribute__((ext_vector_type(4)));
constexpr int BM = 256, BK = 64, HALF = 128, HTB = HALF * BK * 2  , STAGE_BYTES = 8 * HTB, NXCD = 8, WGM = 8;

__host__ __device__ __forceinline__ int lds_byte(int r, int c) { const int st = (r >> 4) * 2 + (c >> 5), rr = r & 15, cc = c & 31, ob = rr * 64 + cc * 2; return st * 1024 + (ob ^ (((ob >> 9) & 1) << 5)); }
__host__ __device__ __forceinline__ void stage_rc(int b, int& R, int& C) { const int st = b / 1024, sb = b % 1024, swz = sb ^ (((sb >> 9) & 1) << 5); R = (st >> 1) * 16 + swz / 64; C = (st & 1) * 32 + (swz % 64) / 2; }
__host__ __device__ __forceinline__ int perm32(int rho) { const int n = rho >> 4, i = rho & 15; return 8 * (i >> 2) + 4 * n + (i & 3); }

struct Unit { int pm, pn; };
struct Gemm { const bf16_t* A; const bf16_t* Bt; int M, N, K; };

struct StaticOrder {
    int nM, nN, nwg, G, c;
    __host__ __device__ void init(int M, int N, int G_, int c_) { nM = M / BM; nN = N / BM; nwg = nM * nN; G = G_; c = c_; }
    __host__ __device__ bool next(int i, Unit& u) const {
        const long L = (long)i * G + c; if (L >= nwg) return false;
        int wgid = (int)L; { const int q = nwg / NXCD, r = nwg % NXCD, xcd = wgid % NXCD, off = wgid / NXCD; wgid = (xcd < r ? xcd * (q + 1) : r * (q + 1) + (xcd - r) * q) + off; }
        const int nig = WGM * nN, gid = wgid / nig, fm = gid * WGM, gsz = (nM - fm) < WGM ? (nM - fm) : WGM;
        u.pm = fm + ((wgid % nig) % gsz); u.pn = (wgid % nig) / gsz; return true;
    }
    __device__ __forceinline__ void a_ready(const Unit&) const {}
    __device__ __forceinline__ void done(const Unit&) const {}
};

__device__ __forceinline__ unsigned cvt_pk_bf16(float lo, float hi) { unsigned r; asm volatile("v_cvt_pk_bf16_f32 %0, %1, %2" : "=v"(r) : "v"(lo), "v"(hi)); return r; }
__device__ __forceinline__ float fast_sigmoid(float x) { return __builtin_amdgcn_rcpf(1.f + __expf(-x)); }
__device__ __forceinline__ float bf_lo(unsigned w) { return __builtin_bit_cast(float, w << 16); }
__device__ __forceinline__ float bf_hi(unsigned w) { return __builtin_bit_cast(float, w & 0xffff0000u); }
constexpr int DM = 2048;
constexpr float NEPS = 1e-6f;

struct EpiZ {
    static constexpr bool PERM = true, AFTER_DRAIN = false;
    bf16_t* O; int ldc; const PG8_LAS float* ssq;
    __device__ __forceinline__ void operator()(const f32x4 (&acc)[2][2][4][2], const Unit& u, int wr, int wc, int fr, int fq) const {
        const int row0 = u.pm * BM + wr * 64 + fr, col0 = u.pn * BM + wc * 32 + 8 * fq;
        float sq[2][4];
#pragma unroll
        for (int ai = 0; ai < 2; ++ai)
#pragma unroll
            for (int m = 0; m < 4; ++m) sq[ai][m] = ssq ? ssq[((u.pm >> 3) & 3) * 256 + wr * 64 + fr + ai * HALF + m * 16] : 1.f;
#pragma unroll
        for (int ai = 0; ai < 2; ++ai)
#pragma unroll
            for (int m = 0; m < 4; ++m) { const int row = row0 + ai * HALF + m * 16;
                const float sc = sq[ai][m];
                bf16_t* rowp = ldc ? O + (size_t)row * ldc + col0 : O + ((size_t)(u.pm * 8 + u.pn) * 256 + (row - u.pm * BM)) * 256 + (col0 - u.pn * BM);
#pragma unroll
                for (int bj = 0; bj < 2; ++bj) { const f32x4 v0 = acc[ai][bj][m][0] * sc, v1 = acc[ai][bj][m][1] * sc;
                    u32x4 w; w.x = cvt_pk_bf16(v0[0], v0[1]); w.y = cvt_pk_bf16(v0[2], v0[3]); w.z = cvt_pk_bf16(v1[0], v1[1]); w.w = cvt_pk_bf16(v1[2], v1[3]);
                    *(u32x4*)(rowp + bj * HALF) = w; } }
    }
};

struct EpiRes {
    static constexpr bool PERM = true, AFTER_DRAIN = false;
    const bf16_t* res; bf16_t* hb; float* ssq;
    __device__ __forceinline__ void operator()(const f32x4 (&acc)[2][2][4][2], const Unit& u, int wr, int wc, int fr, int fq) const {
#ifdef TIME_EPI
        const unsigned long long t0_ = __builtin_amdgcn_s_memrealtime();
#endif
        const int row0 = u.pm * BM + wr * 64 + fr, col0 = u.pn * BM + wc * 32 + 8 * fq;
#pragma unroll
        for (int ai = 0; ai < 2; ++ai)
#pragma unroll
            for (int m = 0; m < 4; ++m) { const int row = row0 + ai * HALF + m * 16;
                const bf16_t* sp = res + (size_t)row * DM + col0; bf16_t* hp = hb + (size_t)row * DM + col0; float s = 0.f;
#pragma unroll
                for (int bj = 0; bj < 2; ++bj) { const u32x4 rw = *(const u32x4*)(sp + bj * HALF);
                    f32x4 v0 = acc[ai][bj][m][0], v1 = acc[ai][bj][m][1];
                    v0[0] += bf_lo(rw.x); v0[1] += bf_hi(rw.x); v0[2] += bf_lo(rw.y); v0[3] += bf_hi(rw.y);
                    v1[0] += bf_lo(rw.z); v1[1] += bf_hi(rw.z); v1[2] += bf_lo(rw.w); v1[3] += bf_hi(rw.w);
                    u32x4 w; w.x = cvt_pk_bf16(v0[0], v0[1]); w.y = cvt_pk_bf16(v0[2], v0[3]); w.z = cvt_pk_bf16(v1[0], v1[1]); w.w = cvt_pk_bf16(v1[2], v1[3]);
                    *(u32x4*)(hp + bj * HALF) = w;
                    s += v0[0] * v0[0] + v0[1] * v0[1] + v0[2] * v0[2] + v0[3] * v0[3] + v1[0] * v1[0] + v1[1] * v1[1] + v1[2] * v1[2] + v1[3] * v1[3]; }
                s += __shfl_xor(s, 16); s += __shfl_xor(s, 32);
                if (fq == 0) atomicAdd(ssq + row, s); }
#ifdef TIME_EPI
#if TIME_EPI == 2
        asm volatile("s_waitcnt vmcnt(0)" ::: "memory");
#endif
        *tacc += (unsigned)(__builtin_amdgcn_s_memrealtime() - t0_);
#endif
    }
#ifdef TIME_EPI
    unsigned* tacc;
#endif
};

struct EpiResNoAtom {
    static constexpr bool PERM = true, AFTER_DRAIN = false;
    const bf16_t* res; bf16_t* hb; float* ssq;
    __device__ __forceinline__ void operator()(const f32x4 (&acc)[2][2][4][2], const Unit& u, int wr, int wc, int fr, int fq) const {
#ifdef TIME_EPI
        const unsigned long long t0_ = __builtin_amdgcn_s_memrealtime();
#endif
        const int row0 = u.pm * BM + wr * 64 + fr, col0 = u.pn * BM + wc * 32 + 8 * fq;
#pragma unroll
        for (int ai = 0; ai < 2; ++ai)
#pragma unroll
            for (int m = 0; m < 4; ++m) { const int row = row0 + ai * HALF + m * 16;
                const bf16_t* sp = res + (size_t)row * DM + col0; bf16_t* hp = hb + (size_t)row * DM + col0; float s = 0.f;
#pragma unroll
                for (int bj = 0; bj < 2; ++bj) { const u32x4 rw = *(const u32x4*)(sp + bj * HALF);
                    f32x4 v0 = acc[ai][bj][m][0], v1 = acc[ai][bj][m][1];
                    v0[0] += bf_lo(rw.x); v0[1] += bf_hi(rw.x); v0[2] += bf_lo(rw.y); v0[3] += bf_hi(rw.y);
                    v1[0] += bf_lo(rw.z); v1[1] += bf_hi(rw.z); v1[2] += bf_lo(rw.w); v1[3] += bf_hi(rw.w);
                    u32x4 w; w.x = cvt_pk_bf16(v0[0], v0[1]); w.y = cvt_pk_bf16(v0[2], v0[3]); w.z = cvt_pk_bf16(v1[0], v1[1]); w.w = cvt_pk_bf16(v1[2], v1[3]);
                    *(u32x4*)(hp + bj * HALF) = w;
                    s += v0[0] * v0[0] + v0[1] * v0[1] + v0[2] * v0[2] + v0[3] * v0[3] + v1[0] * v1[0] + v1[1] * v1[1] + v1[2] * v1[2] + v1[3] * v1[3]; }
                s += __shfl_xor(s, 16); s += __shfl_xor(s, 32);
                if (s == 12345.678f) ssq[row] = s; }
#ifdef TIME_EPI
#if TIME_EPI == 2
        asm volatile("s_waitcnt vmcnt(0)" ::: "memory");
#endif
        *tacc += (unsigned)(__builtin_amdgcn_s_memrealtime() - t0_);
#endif
    }
#ifdef TIME_EPI
    unsigned* tacc;
#endif
};

struct EpiGate {
    static constexpr bool PERM = true, AFTER_DRAIN = false;
    const PG8_LAS float* ssq_in; const bf16_t* res; const bf16_t* pp; bf16_t* hb; float* ssq_out;
    __device__ __forceinline__ void operator()(const f32x4 (&acc)[2][2][4][2], const Unit& u, int wr, int wc, int fr, int fq) const {
        const int row0 = u.pm * BM + wr * 64 + fr, col0 = u.pn * BM + wc * 32 + 8 * fq;
#pragma unroll
        for (int ai = 0; ai < 2; ++ai)
#pragma unroll
            for (int m = 0; m < 4; ++m) { const int row = row0 + ai * HALF + m * 16;
                const float sc = ssq_in[((u.pm >> 3) & 3) * 256 + (row - u.pm * BM)];
                const bf16_t* sp = res + (size_t)row * DM + col0; bf16_t* hp = hb + (size_t)row * DM + col0; const bf16_t* ppp = pp + ((size_t)(u.pm * 8 + u.pn) * 256 + (row - u.pm * BM)) * 256 + (col0 - u.pn * BM);   float s = 0.f;
#pragma unroll
                for (int bj = 0; bj < 2; ++bj) { const u32x4 rw = *(const u32x4*)(sp + bj * HALF); const u32x4 pw = *(const u32x4*)(ppp + bj * HALF);
                    const f32x4 a0 = acc[ai][bj][m][0] * sc, a1 = acc[ai][bj][m][1] * sc;
                    f32x4 v0, v1;
                    v0[0] = bf_lo(rw.x) + fast_sigmoid(a0[0]) * bf_lo(pw.x); v0[1] = bf_hi(rw.x) + fast_sigmoid(a0[1]) * bf_hi(pw.x);
                    v0[2] = bf_lo(rw.y) + fast_sigmoid(a0[2]) * bf_lo(pw.y); v0[3] = bf_hi(rw.y) + fast_sigmoid(a0[3]) * bf_hi(pw.y);
                    v1[0] = bf_lo(rw.z) + fast_sigmoid(a1[0]) * bf_lo(pw.z); v1[1] = bf_hi(rw.z) + fast_sigmoid(a1[1]) * bf_hi(pw.z);
                    v1[2] = bf_lo(rw.w) + fast_sigmoid(a1[2]) * bf_lo(pw.w); v1[3] = bf_hi(rw.w) + fast_sigmoid(a1[3]) * bf_hi(pw.w);
                    u32x4 w; w.x = cvt_pk_bf16(v0[0], v0[1]); w.y = cvt_pk_bf16(v0[2], v0[3]); w.z = cvt_pk_bf16(v1[0], v1[1]); w.w = cvt_pk_bf16(v1[2], v1[3]);
                    *(u32x4*)(hp + bj * HALF) = w;
                    s += v0[0] * v0[0] + v0[1] * v0[1] + v0[2] * v0[2] + v0[3] * v0[3] + v1[0] * v1[0] + v1[1] * v1[1] + v1[2] * v1[2] + v1[3] * v1[3]; }
                s += __shfl_xor(s, 16); s += __shfl_xor(s, 32);
                if (fq == 0) atomicAdd(ssq_out + row, s); }
    }
};

struct EpiNull {
    static constexpr bool PERM = true, AFTER_DRAIN = false;
    float* sink;
    __device__ __forceinline__ void operator()(const f32x4 (&acc)[2][2][4][2], const Unit& u, int wr, int wc, int fr, int fq) const {
        float s = 0.f;
#pragma unroll
        for (int ai = 0; ai < 2; ++ai)
#pragma unroll
            for (int bj = 0; bj < 2; ++bj)
#pragma unroll
                for (int m = 0; m < 4; ++m)
#pragma unroll
                    for (int n = 0; n < 2; ++n) s += acc[ai][bj][m][n][0] + acc[ai][bj][m][n][1] + acc[ai][bj][m][n][2] + acc[ai][bj][m][n][3];
        if (s == 12345.678f) sink[u.pm + wr + wc + fr + fq] = s;
    }
};
template <class Epi, class Sched, bool ALIGN_EPI = false, bool SP2 = false>
__device__ __forceinline__ void gemm_phase(PG8_LAS unsigned char* lds, const Gemm g, const Sched& S, const Epi& E) {
    int tid_ = threadIdx.x; asm volatile("" : "+v"(tid_));
    const int tid = tid_, wid = __builtin_amdgcn_readfirstlane(tid >> 6), lane = tid & 63, wr = wid >> 2, wc = wid & 3, fr = lane & 15, fq = lane >> 4;
    int K_ = g.K; asm volatile("" : "+s"(K_));
    const int K = K_, nt = K / BK;
    unsigned voffA[2], voffB[2];
#pragma unroll
    for (int i = 0; i < 2; ++i) { int R, C; stage_rc(tid * 16 + i * 8192, R, C); const int Rb = Epi::PERM ? ((R & ~31) + perm32(R & 31)) : R;
        voffA[i] = (unsigned)(R * K + C) * 2u; voffB[i] = (unsigned)(Rb * K + C) * 2u; }
    const size_t kstep = (size_t)(BK * 2);
    const size_t hstep = (size_t)HALF * K * 2;
    const size_t tstep = 2 * hstep;
    const unsigned ldsw = (unsigned)wid * 1024u;
    const int aoff = lds_byte(wr * 64 + fr, fq * 8), boff = lds_byte(wc * 32 + fr, fq * 8);
#define PG8_SA(b, h) (((b) * 2 + (h)) * HTB)
#define PG8_SB(b, h) ((4 + (b) * 2 + (h)) * HTB)
#define PG8_STAGE(bufoff, gbase, voff) do { _Pragma("unroll") for (int _i = 0; _i < 2; ++_i) \
        __builtin_amdgcn_global_load_lds((const unsigned*)((const char*)(gbase) + (voff)[_i]), (PG8_LAS unsigned*)(lds + (bufoff) + ldsw + _i * 8192), 16, 0, 0); } while (0)
#define PG8_LDA(dst, b, h) do { _Pragma("unroll") for (int m = 0; m < 4; ++m) _Pragma("unroll") for (int k = 0; k < 2; ++k) dst[m][k] = *(const PG8_LAS bf16x8*)(lds + PG8_SA(b, h) + aoff + m * 2048 + k * 1024); } while (0)
#define PG8_LDB(dst, b, h) do { _Pragma("unroll") for (int n = 0; n < 2; ++n) _Pragma("unroll") for (int k = 0; k < 2; ++k) dst[n][k] = *(const PG8_LAS bf16x8*)(lds + PG8_SB(b, h) + boff + n * 2048 + k * 1024); } while (0)
#define PG8_MMA(ai, bj, At, Bt) do { __builtin_amdgcn_s_setprio(1); _Pragma("unroll") for (int m = 0; m < 4; ++m) _Pragma("unroll") for (int n = 0; n < 2; ++n) _Pragma("unroll") for (int k = 0; k < 2; ++k) \
        acc[ai][bj][m][n] = __builtin_amdgcn_mfma_f32_16x16x32_bf16(Bt[n][k], At[m][k], acc[ai][bj][m][n], 0, 0, 0); __builtin_amdgcn_s_setprio(0); } while (0)
#define PG8_WAIT_V(n) asm volatile("s_waitcnt vmcnt(" #n ")" ::: "memory")
#define PG8_WAIT_L(n) asm volatile("s_waitcnt lgkmcnt(" #n ")" ::: "memory")
#define PG8_BAR __builtin_amdgcn_s_barrier()
#define PG8_SCHED __builtin_amdgcn_sched_barrier(0)
    Unit cur, nxt; int ui = 0;
    if (!S.next(0, cur)) return;
    f32x4 acc[2][2][4][2];
#pragma unroll
    for (int a = 0; a < 2; ++a)
#pragma unroll
        for (int b = 0; b < 2; ++b)
#pragma unroll
            for (int m = 0; m < 4; ++m)
#pragma unroll
                for (int n = 0; n < 2; ++n) acc[a][b][m][n] = (f32x4){0.f, 0.f, 0.f, 0.f};
    bf16x8 At[4][2], B0[2][2], B1[2][2];
    const char* cA = (const char*)g.A + (size_t)cur.pm * tstep; const char* cB = (const char*)g.Bt + (size_t)cur.pn * tstep;
    S.a_ready(cur);
    if constexpr (SP2) {
        PG8_STAGE(PG8_SB(0, 0), cB, voffB); PG8_STAGE(PG8_SB(0, 1), cB + hstep, voffB); PG8_STAGE(PG8_SA(0, 0), cA, voffA); PG8_STAGE(PG8_SA(0, 1), cA + hstep, voffA);
        if (wr == 1) PG8_BAR;
        PG8_WAIT_V(2); PG8_BAR;
        PG8_STAGE(PG8_SB(1, 0), cB + kstep, voffB); PG8_STAGE(PG8_SA(1, 0), cA + kstep, voffA); PG8_STAGE(PG8_SB(1, 1), cB + hstep + kstep, voffB);
        PG8_WAIT_V(6); PG8_BAR;
    } else {
        PG8_STAGE(PG8_SB(0, 0), cB, voffB); PG8_STAGE(PG8_SA(0, 0), cA, voffA); PG8_STAGE(PG8_SB(0, 1), cB + hstep, voffB); PG8_STAGE(PG8_SA(0, 1), cA + hstep, voffA);
        if (wr == 1) PG8_BAR;
        PG8_WAIT_V(4); PG8_BAR;
        PG8_STAGE(PG8_SB(1, 0), cB + kstep, voffB); PG8_STAGE(PG8_SA(1, 0), cA + kstep, voffA); PG8_STAGE(PG8_SB(1, 1), cB + hstep + kstep, voffB);
        PG8_WAIT_V(6); PG8_BAR;
    }
    for (;;) {
        const bool has_next = S.next(ui + 1, nxt);
        const char* nA = has_next ? (const char*)g.A + (size_t)nxt.pm * tstep : cA; const char* nB = has_next ? (const char*)g.Bt + (size_t)nxt.pn * tstep : cB;
        for (int t = 0; t < nt; t += 2) {
            const bool last = (t == nt - 2);
            const char* a1 = cA + (size_t)(t + 1) * kstep;
            const char* a2 = last ? nA : cA + (size_t)(t + 2) * kstep; const char* b2 = last ? nB : cB + (size_t)(t + 2) * kstep;
            const char* a3 = a2 + kstep; const char* b3 = b2 + kstep;
            if (last && has_next) S.a_ready(nxt);
            if constexpr (SP2) {
            PG8_LDB(B0, 0, 0); PG8_LDB(B1, 0, 1); PG8_SCHED; PG8_LDA(At, 0, 0); PG8_STAGE(PG8_SA(1, 1), a1 + hstep, voffA);
            PG8_WAIT_V(8); PG8_WAIT_L(0); PG8_BAR; PG8_MMA(0, 0, At, B0); PG8_MMA(0, 1, At, B1); PG8_BAR; PG8_SCHED;
            PG8_LDA(At, 0, 1); PG8_STAGE(PG8_SB(0, 0), b2, voffB); PG8_STAGE(PG8_SB(0, 1), b2 + hstep, voffB); PG8_STAGE(PG8_SA(0, 0), a2, voffA);
            PG8_WAIT_V(8); PG8_WAIT_L(0); PG8_BAR; PG8_MMA(1, 0, At, B0); PG8_MMA(1, 1, At, B1); PG8_BAR; PG8_SCHED;
            PG8_LDB(B0, 1, 0); PG8_LDB(B1, 1, 1); PG8_SCHED; PG8_LDA(At, 1, 0); PG8_STAGE(PG8_SA(0, 1), a2 + hstep, voffA);
            PG8_WAIT_V(8); PG8_WAIT_L(0); PG8_BAR; PG8_MMA(0, 0, At, B0); PG8_MMA(0, 1, At, B1); PG8_BAR; PG8_SCHED;
            PG8_LDA(At, 1, 1); PG8_STAGE(PG8_SB(1, 0), b3, voffB); PG8_STAGE(PG8_SB(1, 1), b3 + hstep, voffB); PG8_STAGE(PG8_SA(1, 0), a3, voffA);
            PG8_WAIT_V(8); PG8_WAIT_L(0); PG8_BAR; PG8_MMA(1, 0, At, B0); PG8_MMA(1, 1, At, B1); PG8_BAR; PG8_SCHED;
            } else {
            PG8_LDB(B0, 0, 0); PG8_SCHED; PG8_LDA(At, 0, 0); PG8_STAGE(PG8_SA(1, 1), a1 + hstep, voffA);
            PG8_WAIT_L(8); PG8_BAR; PG8_WAIT_L(0); PG8_MMA(0, 0, At, B0); PG8_BAR; PG8_SCHED;
            PG8_LDB(B1, 0, 1); PG8_STAGE(PG8_SB(0, 0), b2, voffB);
            PG8_BAR; PG8_WAIT_L(0); PG8_MMA(0, 1, At, B1); PG8_BAR;
            PG8_LDA(At, 0, 1); PG8_STAGE(PG8_SA(0, 0), a2, voffA);
            PG8_BAR; PG8_WAIT_L(0); PG8_MMA(1, 0, At, B0); PG8_BAR; PG8_SCHED;
            PG8_STAGE(PG8_SB(0, 1), b2 + hstep, voffB);
            PG8_WAIT_V(6); PG8_BAR; PG8_MMA(1, 1, At, B1); PG8_BAR;
            PG8_LDB(B0, 1, 0); PG8_SCHED; PG8_LDA(At, 1, 0); PG8_STAGE(PG8_SA(0, 1), a2 + hstep, voffA);
            PG8_WAIT_L(8); PG8_BAR; PG8_WAIT_L(0); PG8_MMA(0, 0, At, B0); PG8_BAR; PG8_SCHED;
            PG8_LDB(B1, 1, 1); PG8_STAGE(PG8_SB(1, 0), b3, voffB);
            PG8_BAR; PG8_WAIT_L(0); PG8_MMA(0, 1, At, B1); PG8_BAR;
            PG8_LDA(At, 1, 1); PG8_STAGE(PG8_SA(1, 0), a3, voffA);
            PG8_BAR; PG8_WAIT_L(0); PG8_MMA(1, 0, At, B0); PG8_BAR; PG8_SCHED;
            PG8_STAGE(PG8_SB(1, 1), b3 + hstep, voffB);
            PG8_WAIT_V(6); PG8_BAR; PG8_MMA(1, 1, At, B1); PG8_BAR;
            }
        }
        if constexpr (ALIGN_EPI) { if (wr == 0) PG8_BAR; }
        if constexpr (!Epi::AFTER_DRAIN) { E(acc, cur, wr, wc, fr, fq); S.done(cur); }
        if (!has_next) break;
#pragma unroll
        for (int a = 0; a < 2; ++a)
#pragma unroll
            for (int b = 0; b < 2; ++b)
#pragma unroll
                for (int m = 0; m < 4; ++m)
#pragma unroll
                    for (int n = 0; n < 2; ++n) acc[a][b][m][n] = (f32x4){0.f, 0.f, 0.f, 0.f};
        cur = nxt; cA = nA; cB = nB; ++ui;
        if constexpr (ALIGN_EPI) { if (wr == 1) PG8_BAR; }
    }
    PG8_WAIT_V(0);
    if constexpr (!ALIGN_EPI) { if (wr == 0) PG8_BAR; }
    PG8_BAR;
    if constexpr (Epi::AFTER_DRAIN) { E.fused(acc, cur, wr, wc, fr, fq, lds, wid, lane); S.done(cur); }
#undef PG8_SA
#undef PG8_SB
#undef PG8_STAGE
#undef PG8_LDA
#undef PG8_LDB
#undef PG8_MMA
#undef PG8_WAIT_V
#undef PG8_WAIT_L
#undef PG8_BAR
#undef PG8_SCHED
}
}
#define LAS __attribute__((address_space(3)))
typedef unsigned short bf16;
typedef unsigned v4u __attribute__((ext_vector_type(4)));
typedef unsigned v2u __attribute__((ext_vector_type(2)));
typedef float v2f __attribute__((ext_vector_type(2)));
typedef float f32x4 __attribute__((ext_vector_type(4)));
typedef float f32x16 __attribute__((ext_vector_type(16)));
typedef short bf16x8 __attribute__((ext_vector_type(8)));
typedef short s16x4 __attribute__((ext_vector_type(4)));
constexpr int MTOK = 32768, DMOD = 2048, NZ = 5632, PLE = 256, NCHUNK = MTOK / 128;
constexpr int ZQ = 0, ZK = 1024, ZV = 1280, ZGA = 1536, ZCB = 2560, ZCC = 3072, ZCX = 3584, ZGC = 4096, ZXL = 4608, ZGL = 5120;
constexpr float LOG2E = 1.4426950408889634f;
constexpr int NWAVES = 8, NTHR = 512;
constexpr int LDS_BYTES = 163840;
constexpr size_t MiB = 1u << 20;
constexpr size_t WS_SSQ = 0;
constexpr size_t WS_AGG = 1 * MiB;
constexpr size_t WS_WL = 3 * MiB;
constexpr size_t WS_WPROJ = 4 * MiB;
constexpr size_t WS_CTL = 6 * MiB, CTL_BYTES = 16384;
constexpr size_t WS_WIN = 8 * MiB;
constexpr size_t WS_WOUT = 52 * MiB;
constexpr size_t WS_WGATE = 68 * MiB;
constexpr size_t WS_PB = 84 * MiB;
constexpr size_t WS_HBA = 116 * MiB;
constexpr size_t WS_HBB = 244 * MiB;
constexpr size_t WS_MIX = 372 * MiB;
constexpr size_t WS_PP = 500 * MiB;
constexpr size_t WS_Z = 628 * MiB;
constexpr size_t WS_END = 980 * MiB;

struct Params {
    const float *x_prompt, *x_sample, *p_prompt, *p_sample, *norm_mix, *w_in, *w_out, *rel_bias, *attn_sink, *conv_w, *lru_conv_w, *lru_conv_b,
                *lru_w_a, *lru_b_a, *lru_w_i, *lru_b_i, *lru_L, *ple_norm, *ple_w_gate, *ple_w_proj, *final_norm;
    float* out; unsigned char* ws;
};

__device__ __forceinline__ unsigned f2bf(float f) { unsigned u = __builtin_bit_cast(unsigned, f); return (u + 0x7fffu + ((u >> 16) & 1u)) >> 16; }
__device__ __forceinline__ unsigned pk2(float lo, float hi) { unsigned r; asm("v_cvt_pk_bf16_f32 %0, %1, %2" : "=v"(r) : "v"(lo), "v"(hi)); return r; }
__device__ __forceinline__ float bflo(unsigned w) { return __builtin_bit_cast(float, w << 16); }
__device__ __forceinline__ float bfhi(unsigned w) { return __builtin_bit_cast(float, w & 0xffff0000u); }
__device__ __forceinline__ float bf1(bf16 v) { return __builtin_bit_cast(float, (unsigned)v << 16); }
__device__ __forceinline__ float sigm(float x) { return __builtin_amdgcn_rcpf(1.f + __expf(-x)); }
__device__ __forceinline__ float silu(float x) { return x * sigm(x); }
__device__ __forceinline__ float wave_sum(float v) {
#pragma unroll
    for (int o = 1; o < 64; o <<= 1) v += __shfl_xor(v, o);
    return v;
}
__device__ __forceinline__ void seq_of_chunk(int c, int& s0, int& ns) { if (c < 128) { s0 = c & ~63; ns = 64; } else { s0 = c & ~15; ns = 16; } }

struct TrDesc { const float* W; bf16* WT; const float* ks; int K, N, k0, n0; };
__device__ __forceinline__ void tr_load(const TrDesc& d, int lane, f32x4 (&v)[16]) {
    const float* p = d.W + (size_t)(d.k0 + (lane >> 4)) * d.N + d.n0 + 4 * (lane & 15);
#pragma unroll
    for (int i = 0; i < 16; ++i) v[i] = *(const f32x4*)(p + (size_t)(4 * i) * d.N);
}
__device__ __forceinline__ void tr_store(const TrDesc& d, int lane, const f32x4 (&v)[16], LAS float* scr) {
#pragma unroll
    for (int i = 0; i < 16; ++i) { const int kk = 4 * i + (lane >> 4); const float sc = d.ks ? d.ks[d.k0 + kk] : 1.f; LAS float* q = scr + kk * 65 + 4 * (lane & 15);
        q[0] = v[i][0] * sc; q[1] = v[i][1] * sc; q[2] = v[i][2] * sc; q[3] = v[i][3] * sc; }
    asm volatile("s_waitcnt lgkmcnt(0)" ::: "memory");
    const int c = lane & 7;
#pragma unroll
    for (int j = 0; j < 8; ++j) { const int n = (lane >> 3) + 8 * j; const LAS float* s = scr + (8 * c) * 65 + n;
        v4u o; o.x = pk2(s[0 * 65], s[1 * 65]); o.y = pk2(s[2 * 65], s[3 * 65]); o.z = pk2(s[4 * 65], s[5 * 65]); o.w = pk2(s[6 * 65], s[7 * 65]);
        *(v4u*)(d.WT + (size_t)(d.n0 + n) * d.K + d.k0 + 8 * c) = o; }
    asm volatile("s_waitcnt lgkmcnt(0)" ::: "memory");
}
constexpr int TI_IN = (DMOD / 64) * (NZ / 64), TI_SQ = (DMOD / 64) * (DMOD / 64), TI_PR = (PLE / 64) * (DMOD / 64), TI_L1 = 4, TI_L = 16 * TI_L1;
constexpr int TI_LAYER = TI_IN + 2 * TI_SQ + TI_PR + TI_L;
constexpr int TI_EARLY = TI_IN + TI_L, TI_LATE0 = 2 * TI_SQ + TI_PR, TI_LATE = TI_LATE0 + TI_LAYER;
__device__ __forceinline__ TrDesc tr_decode(const Params& P, int late, int it) {
    unsigned char* ws = P.ws; TrDesc d; int l, r;
    if (!late) { l = 0; r = it < TI_IN ? it : it + 2 * TI_SQ + TI_PR; }
    else if (it < TI_LATE0) { l = 0; r = TI_IN + it; }
    else { l = 1; r = it - TI_LATE0; }
    if (r < TI_IN) { d.W = P.w_in + (size_t)l * DMOD * NZ; d.K = DMOD; d.N = NZ; d.WT = (bf16*)(ws + WS_WIN) + (size_t)l * NZ * DMOD; d.ks = P.norm_mix + l * DMOD; }
    else if ((r -= TI_IN) < TI_SQ) { d.W = P.w_out + (size_t)l * DMOD * DMOD; d.K = DMOD; d.N = DMOD; d.WT = (bf16*)(ws + WS_WOUT) + (size_t)l * DMOD * DMOD; d.ks = nullptr; }
    else if ((r -= TI_SQ) < TI_SQ) { d.W = P.ple_w_gate + (size_t)l * DMOD * DMOD; d.K = DMOD; d.N = DMOD; d.WT = (bf16*)(ws + WS_WGATE) + (size_t)l * DMOD * DMOD; d.ks = P.ple_norm + l * DMOD; }
    else if ((r -= TI_SQ) < TI_PR) { d.W = P.ple_w_proj + (size_t)l * PLE * DMOD; d.K = PLE; d.N = DMOD; d.WT = (bf16*)(ws + WS_WPROJ) + (size_t)l * DMOD * PLE; d.ks = nullptr; }
    else { r -= TI_PR; const int mat = r / TI_L1; r = r % TI_L1;
        const int dir = mat >> 3, which = (mat >> 2) & 1, h = mat & 3;
        d.W = (which ? P.lru_w_i : P.lru_w_a) + ((size_t)((l * 2 + dir) * 4 + h)) * 128 * 128; d.K = 128; d.N = 128;
        d.WT = (bf16*)(ws + WS_WL) + ((size_t)(((l * 2 + dir) * 2 + which) * 4 + h)) * 128 * 128; d.ks = nullptr; }
    const int nblk = d.N / 64; d.k0 = 64 * (r / nblk); d.n0 = 64 * (r % nblk);
    return d;
}

__device__ __forceinline__ void tr_run(const Params& P, LAS unsigned char* lds, int tid, int G, int late, int nitems) {
    asm volatile("" : "+v"(tid));
    const int lane = tid & 63, wave = tid >> 6, gw = blockIdx.x * NWAVES + wave, NGW = G * NWAVES;
    LAS float* scr = (LAS float*)(lds + wave * 16640);
    int it = gw; TrDesc d; f32x4 va[16];
    if (it < nitems) { d = tr_decode(P, late, it); tr_load(d, lane, va); }
    while (it < nitems) {
        const int nx = it + NGW; TrDesc dn = d; f32x4 vb[16];
        if (nx < nitems) { dn = tr_decode(P, late, nx); tr_load(dn, lane, vb); }
        tr_store(d, lane, va, scr);
        it = nx; d = dn;
#pragma unroll
        for (int i = 0; i < 16; ++i) va[i] = vb[i];
    }
}

__device__ __forceinline__ void p0_prologue(const Params& P, LAS unsigned char* lds, int tid, int G) {
    asm volatile("" : "+v"(tid));
    const int lane = tid & 63, wave = tid >> 6;
    const int gw = blockIdx.x * NWAVES + wave, NGW = G * NWAVES;
    const long gt = (long)blockIdx.x * NTHR + tid, NGT = (long)G * NTHR;
    unsigned char* ws = P.ws;
    { float* ssq = (float*)(ws + WS_SSQ); for (long i = gt; i < 4L * MTOK; i += NGT) ssq[MTOK + i] = 0.f; }
    tr_run(P, lds, tid, G, 0, TI_EARLY);
    { bf16* hbA = (bf16*)(ws + WS_HBA); float* ssq = (float*)(ws + WS_SSQ);
      for (int row = gw; row < MTOK; row += NGW) {
          const float* xr = (row < 16384 ? P.x_prompt + (size_t)row * DMOD : P.x_sample + (size_t)(row - 16384) * DMOD);
          float s = 0.f;
#pragma unroll
          for (int j = 0; j < 8; ++j) { const f32x4 v = *(const f32x4*)(xr + 4 * lane + 256 * j); s += v[0] * v[0] + v[1] * v[1] + v[2] * v[2] + v[3] * v[3];
              v2u o; o.x = pk2(v[0], v[1]); o.y = pk2(v[2], v[3]); *(v2u*)(hbA + (size_t)row * DMOD + 4 * lane + 256 * j) = o; }
          s = wave_sum(s); if (lane == 0) ssq[row] = s; } }
}

__device__ __forceinline__ void pb_convert(const Params& P, int tid, int G) {
    asm volatile("" : "+v"(tid));
    const long gt = (long)blockIdx.x * NTHR + tid, NGT = (long)G * NTHR;
    unsigned char* ws = P.ws;
    { bf16* pb = (bf16*)(ws + WS_PB);
      for (long i = gt; i < 2L * MTOK * PLE / 4; i += NGT) { const long e = i * 4; const int l = (int)(e / ((long)MTOK * PLE)); const long r = e % ((long)MTOK * PLE);
          const float* src = (r < 16384L * PLE) ? P.p_prompt + (size_t)l * 16384 * PLE + r : P.p_sample + (size_t)l * 16384 * PLE + (r - 16384L * PLE);
          const f32x4 v = *(const f32x4*)src; v2u o; o.x = pk2(v[0], v[1]); o.y = pk2(v[2], v[3]); *(v2u*)(pb + e) = o; } }
}

__device__ __forceinline__ int t5_bucket(int rel) {
    const int n = rel < 0 ? -rel : rel;
    int b = n < 8 ? n : 8 + (n >= 12) + (n >= 16) + (n >= 23) + (n >= 32) + (n >= 46) + (n >= 64) + (n >= 91);
    return b + (rel > 0 ? 16 : 0);
}
constexpr float AT_SHIFT = 40.f;
constexpr int AT_KP = 272, AT_VP = 320, AT_KB = 64 * AT_KP, AT_VB = 64 * AT_VP, AT_V0 = 2 * AT_KB, AT_TAB = AT_V0 + 2 * AT_VB, AT_TW = 384;

__device__ __forceinline__ void attn_build_tab(LAS unsigned char* lds, const float* rel_bias, int tid) {
    asm volatile("" : "+v"(tid));
    LAS float* tab = (LAS float*)(lds + AT_TAB);
    for (int i = tid; i < 8 * AT_TW; i += NTHR) { const int hd = i / AT_TW, rel = i % AT_TW - 192;
        tab[i] = (rel >= -128 && rel <= 128) ? rel_bias[t5_bucket(rel) * 8 + hd] * LOG2E - AT_SHIFT : -1.0e30f; }
}

template <int VAR>
__device__ __forceinline__ void attn_item(LAS unsigned char* lds, int item, const bf16* z, bf16* mix, const float* sink, int tid) {
    asm volatile("" : "+v"(tid));
    const int c = item >> 2, kvh = (item >> 1) & 1, qhalf = item & 1;
    int s0, ns; seq_of_chunk(c, s0, ns);
    const int w = tid >> 6, lane = tid & 63, ql = lane & 31, h = lane >> 5;
    const int head = kvh * 4 + (w >> 1);
    const int tb = c * 128, tq = tb + qhalf * 64 + (w & 1) * 32 + ql;
    const int seq_lo = s0 * 128, seq_hi = (s0 + ns) * 128, kwin0 = tb - 128 + qhalf * 64;
    int j_lo = 0, j_hi = 4;
    while (kwin0 + 64 * j_lo < seq_lo) ++j_lo;
    while (kwin0 + 64 * j_hi + 64 > seq_hi) --j_hi;
    v4u stg[4];
    const int pkey = tid >> 4, pc = tid & 15;
    auto prefetch = [&](int j) {
        const bf16* base = z + (size_t)(kwin0 + 64 * j + pkey) * NZ + kvh * 128 + pc * 8;
        stg[0] = *(const v4u*)(base + ZK); stg[1] = *(const v4u*)(base + ZK + (size_t)32 * NZ);
        stg[2] = *(const v4u*)(base + ZV); stg[3] = *(const v4u*)(base + ZV + (size_t)32 * NZ);
    };
    if (VAR != 1) prefetch(j_lo);
    bf16x8 qf[8];
    {
      const int erow_ = lane >> 4, ech_ = lane & 15, tq0_ = tb + qhalf * 64 + (w & 1) * 32; LAS unsigned char* qst = lds + (AT_TAB + 8 * AT_TW * 4) + w * (32 * 272);
      v4u qv[8];
#pragma unroll
      for (int i = 0; i < 8; ++i) qv[i] = *(const v4u*)(z + (size_t)(tq0_ + 4 * i + erow_) * NZ + ZQ + head * 128 + ech_ * 8);
#pragma unroll
      for (int i = 0; i < 8; ++i) *(LAS v4u*)(qst + (4 * i + erow_) * 272 + ech_ * 16) = qv[i];
#pragma unroll
      for (int ks = 0; ks < 8; ++ks) qf[ks] = *(const LAS bf16x8*)(qst + ql * 272 + (16 * ks + 8 * h) * 2); }
    float lsum = (h == 0) ? __builtin_amdgcn_exp2f(sink[head] * LOG2E - AT_SHIFT) : 0.f;
    f32x16 O[4];
#pragma unroll
    for (int dt = 0; dt < 4; ++dt)
#pragma unroll
        for (int i = 0; i < 16; ++i) O[dt][i] = 0.f;
    const LAS float* tabh = (const LAS float*)(lds + AT_TAB) + head * AT_TW;
    const float c1 = 0.08838834764831845f * LOG2E;
    const int g4 = lane >> 4, q4 = (lane & 15) >> 2, p4 = lane & 3;
    const int tq0g = tb + qhalf * 64 + (w & 1) * 32;
    v4u gv[8];
    for (int j = j_lo; j <= j_hi; ++j) {
        LAS unsigned char* Kb = lds + (j & 1) * AT_KB; LAS unsigned char* Vb = lds + AT_V0 + (j & 1) * AT_VB;
        if (VAR != 1) {
        *(LAS v4u*)(Kb + pkey * AT_KP + pc * 16) = stg[0]; *(LAS v4u*)(Kb + (pkey + 32) * AT_KP + pc * 16) = stg[1];
        *(LAS v4u*)(Vb + pkey * AT_VP + pc * 16) = stg[2]; *(LAS v4u*)(Vb + (pkey + 32) * AT_VP + pc * 16) = stg[3];
        if (j < j_hi) prefetch(j + 1);
        }
        __syncthreads();
        if (j == j_hi) {
#pragma unroll
            for (int i = 0; i < 8; ++i) gv[i] = *(const v4u*)(z + (size_t)(tq0g + 4 * i + (lane >> 4)) * NZ + ZGA + head * 128 + (lane & 15) * 8);
        }
        f32x16 s[2];
#pragma unroll
        for (int kt = 0; kt < 2; ++kt) {
#pragma unroll
            for (int i = 0; i < 16; ++i) s[kt][i] = 0.f;
#pragma unroll
            for (int ks = 0; ks < 8; ++ks) { const bf16x8 kf = *(const LAS bf16x8*)(Kb + (kt * 32 + ql) * AT_KP + (16 * ks + 8 * h) * 2);
                s[kt] = __builtin_amdgcn_mfma_f32_32x32x16_bf16(kf, qf[ks], s[kt], 0, 0, 0); }
        }
        float ps = 0.f;
#pragma unroll
        for (int kt = 0; kt < 2; ++kt) { const LAS float* tp = tabh + ((kwin0 + 64 * j + 32 * kt + 4 * h) - tq + 192);
#pragma unroll
            for (int i = 0; i < 16; ++i) { float p; asm("v_exp_f32_e64 %0, %1 clamp" : "=v"(p) : "v"(s[kt][i] * c1 + tp[(i & 3) + 8 * (i >> 2)])); s[kt][i] = p; ps += p; } }
        lsum += ps;
#pragma unroll
        for (int kt = 0; kt < 2; ++kt)
#pragma unroll
            for (int s2 = 0; s2 < 2; ++s2) {
                v4u pw; pw.x = pk2(s[kt][8 * s2 + 0], s[kt][8 * s2 + 1]); pw.y = pk2(s[kt][8 * s2 + 2], s[kt][8 * s2 + 3]);
                pw.z = pk2(s[kt][8 * s2 + 4], s[kt][8 * s2 + 5]); pw.w = pk2(s[kt][8 * s2 + 6], s[kt][8 * s2 + 7]);
                const bf16x8 pf = __builtin_bit_cast(bf16x8, pw);
                const LAS unsigned char* vrow = Vb + (32 * kt + 16 * s2 + 4 * h + q4) * AT_VP + (16 * (g4 & 1) + 4 * p4) * 2;
#pragma unroll
                for (int dt = 0; dt < 4; ++dt) {
                    const s16x4 lo = __builtin_amdgcn_ds_read_tr16_b64_v4i16((LAS s16x4*)(vrow + dt * 64));
                    const s16x4 hi = __builtin_amdgcn_ds_read_tr16_b64_v4i16((LAS s16x4*)(vrow + dt * 64 + 8 * AT_VP));
                    const bf16x8 vf = __builtin_shufflevector(lo, hi, 0, 1, 2, 3, 4, 5, 6, 7);
                    O[dt] = __builtin_amdgcn_mfma_f32_32x32x16_bf16(vf, pf, O[dt], 0, 0, 0);
                }
            }
    }
    const float ltot = lsum + __shfl_xor(lsum, 32), inv = 1.f / ltot;
    const int erow = lane >> 4, ech = lane & 15, tq0 = tb + qhalf * 64 + (w & 1) * 32;
    __syncthreads();
    LAS unsigned char* ost = lds + w * (32 * 272);
#pragma unroll
    for (int dt = 0; dt < 4; ++dt)
#pragma unroll
        for (int rg = 0; rg < 4; ++rg) { v2u ow; ow.x = pk2(O[dt][4 * rg + 0] * inv, O[dt][4 * rg + 1] * inv); ow.y = pk2(O[dt][4 * rg + 2] * inv, O[dt][4 * rg + 3] * inv);
            *(LAS v2u*)(ost + ql * 272 + (32 * dt + 8 * rg + 4 * h) * 2) = ow; }
    if (VAR != 3) {
#pragma unroll
        for (int i = 0; i < 8; ++i) { const v4u ov = *(const LAS v4u*)(ost + (4 * i + erow) * 272 + ech * 16); const v4u g = gv[i];
            v4u r; r.x = pk2(bflo(ov.x) * silu(bflo(g.x)), bfhi(ov.x) * silu(bfhi(g.x))); r.y = pk2(bflo(ov.y) * silu(bflo(g.y)), bfhi(ov.y) * silu(bfhi(g.y)));
            r.z = pk2(bflo(ov.z) * silu(bflo(g.z)), bfhi(ov.z) * silu(bfhi(g.z))); r.w = pk2(bflo(ov.w) * silu(bflo(g.w)), bfhi(ov.w) * silu(bfhi(g.w)));
            *(v4u*)(mix + (size_t)(tq0 + 4 * i + erow) * DMOD + head * 128 + ech * 8) = r; }
    }
    __syncthreads();
}

__device__ __forceinline__ void conv_phase(const bf16* z, bf16* mix, const float* cw  , int G, int tid) {
    asm volatile("" : "+v"(tid));
    const long NW = (long)MTOK * 64;
#pragma unroll 2
    for (long i = (long)blockIdx.x * NTHR + tid; i < NW; i += (long)G * NTHR) {
        const int t = (int)(i >> 6), cg8 = (int)(i & 63) * 8;
        int s0, ns; seq_of_chunk(t >> 7, s0, ns);
        const bool hasp = t > s0 * 128, hasn = t + 1 < (s0 + ns) * 128;
        const bf16* zr = z + (size_t)t * NZ;
        const v4u cb = *(const v4u*)(zr + ZCB + cg8), gc = *(const v4u*)(zr + ZGC + cg8);
        const v4u c1 = *(const v4u*)(zr + ZCC + cg8), x1 = *(const v4u*)(zr + ZCX + cg8);
        v4u c0 = {0, 0, 0, 0}, x0 = {0, 0, 0, 0}, c2 = {0, 0, 0, 0}, x2 = {0, 0, 0, 0};
        if (hasp) { c0 = *(const v4u*)(zr - NZ + ZCC + cg8); x0 = *(const v4u*)(zr - NZ + ZCX + cg8); }
        if (hasn) { c2 = *(const v4u*)(zr + NZ + ZCC + cg8); x2 = *(const v4u*)(zr + NZ + ZCX + cg8); }
        float o[8];
#pragma unroll
        for (int e = 0; e < 4; ++e) {
#pragma unroll
            for (int hh = 0; hh < 2; ++hh) { const int ch = cg8 + 2 * e + hh;
                const float a0 = hh ? bfhi(c0[e]) * bfhi(x0[e]) : bflo(c0[e]) * bflo(x0[e]);
                const float a1 = hh ? bfhi(c1[e]) * bfhi(x1[e]) : bflo(c1[e]) * bflo(x1[e]);
                const float a2 = hh ? bfhi(c2[e]) * bfhi(x2[e]) : bflo(c2[e]) * bflo(x2[e]);
                const float cv = cw[ch] * a0 + cw[512 + ch] * a1 + cw[1024 + ch] * a2;
                const float b = hh ? bfhi(cb[e]) : bflo(cb[e]), g = hh ? bfhi(gc[e]) : bflo(gc[e]);
                o[2 * e + hh] = b * cv * silu(g); } }
        v4u ow; ow.x = pk2(o[0], o[1]); ow.y = pk2(o[2], o[3]); ow.z = pk2(o[4], o[5]); ow.w = pk2(o[6], o[7]);
        *(v4u*)(mix + (size_t)t * DMOD + 1024 + cg8) = ow;
    }
}

constexpr int LR_XC = 0, LR_XCP = 272, LR_PB = 128 * LR_XCP, LR_Y = 2 * 128 * LR_XCP, LR_YP = 132;
struct LruLayer { const float *cw, *cb, *ba, *bi, *L; const bf16* WL; };
template <int DIR>
__device__ __forceinline__ void lru_load(v4u (&xr)[7], const bf16* z, int tb, int hh, int seq_lo, int seq_hi, int tid) {
    const int pc = tid & 15, base = tb + 4 * (tid >> 4) + (DIR ? 0 : -3);
#pragma unroll
    for (int k = 0; k < 7; ++k) { const int tok = base + k; const int tc = tok < seq_lo ? seq_lo : (tok >= seq_hi ? seq_hi - 1 : tok);
        xr[k] = *(const v4u*)(z + (size_t)tc * NZ + ZXL + hh * 128 + pc * 8); }
}
template <int DIR>
__device__ __forceinline__ void lru_dir(LAS unsigned char* lds, const bf16* z, const LruLayer& LP, float* agg, bf16* PFB, int c, int hh, int seq_lo, int seq_hi, int tid,
                                        v4u (&xr)[7], v4u (&xnx)[7], bool pf, int pf_tb, int pf_hh, int pf_lo, int pf_hi) {
    const int w = tid >> 6, lane = tid & 63, tb = c * 128;
    const int chl = 16 * w + (lane & 15), chg = hh * 128 + chl, q = lane >> 4;
    LAS float* Y = (LAS float*)(lds + LR_Y);
    const float nba = -LOG2E * LP.ba[DIR * 512 + chg], nbi = -LOG2E * LP.bi[DIR * 512 + chg];
    const float c8 = -8.f * LOG2E * log1pf(__expf(-LP.L[DIR * 512 + chg]));
    bf16x8 bA[4], bI[4];
    { const bf16* wa = LP.WL + ((size_t)((DIR * 2 + 0) * 4 + hh)) * 16384 + (size_t)chl * 128 + 8 * q;
      const bf16* wi = LP.WL + ((size_t)((DIR * 2 + 1) * 4 + hh)) * 16384 + (size_t)chl * 128 + 8 * q;
#pragma unroll
      for (int ks = 0; ks < 4; ++ks) { bA[ks] = *(const bf16x8*)(wa + 32 * ks); bI[ks] = *(const bf16x8*)(wi + 32 * ks); } }
    { const int pc = tid & 15, tg = tid >> 4;
      const float* cb = LP.cb + DIR * 512 + hh * 128 + pc * 8; const f32x4 c0 = *(const f32x4*)cb, c1 = *(const f32x4*)(cb + 4);
      f32x4 w0[4], w1[4];
#pragma unroll
      for (int k = 0; k < 4; ++k) { const float* wk = LP.cw + (DIR * 4 + k) * 512 + hh * 128 + pc * 8; w0[k] = *(const f32x4*)wk; w1[k] = *(const f32x4*)(wk + 4); }
      const int base = tb + 4 * tg + (DIR ? 0 : -3);
#pragma unroll
      for (int i = 0; i < 4; ++i) { f32x4 a0 = c0, a1 = c1; const int t = 4 * tg + i;
#pragma unroll
          for (int k = 0; k < 4; ++k) { const int tok = base + i + k; const bool ok = tok >= seq_lo && tok < seq_hi; v4u xv = xr[i + k];
              if (!ok) xv = (v4u){0u, 0u, 0u, 0u};
              a0[0] += w0[k][0] * bflo(xv[0]); a0[1] += w0[k][1] * bfhi(xv[0]); a0[2] += w0[k][2] * bflo(xv[1]); a0[3] += w0[k][3] * bfhi(xv[1]);
              a1[0] += w1[k][0] * bflo(xv[2]); a1[1] += w1[k][1] * bfhi(xv[2]); a1[2] += w1[k][2] * bflo(xv[3]); a1[3] += w1[k][3] * bfhi(xv[3]); }
          v4u o; o.x = pk2(a0[0], a0[1]); o.y = pk2(a0[2], a0[3]); o.z = pk2(a1[0], a1[1]); o.w = pk2(a1[2], a1[3]);
          const int s = DIR ? 127 - t : t, row = 16 * ((s & 31) >> 2) + 4 * (s >> 5) + (s & 3);
          *(LAS v4u*)(lds + LR_XC + row * LR_XCP + pc * 16) = o; } }
    __syncthreads();
    f32x4 ar[8], ai[8];
#pragma unroll
    for (int mt = 0; mt < 8; ++mt) { ar[mt] = (f32x4){0.f, 0.f, 0.f, 0.f}; ai[mt] = (f32x4){0.f, 0.f, 0.f, 0.f}; }
#pragma unroll
    for (int ks = 0; ks < 4; ++ks) {
#pragma unroll
        for (int mt = 0; mt < 8; ++mt) { const bf16x8 af = *(const LAS bf16x8*)(lds + LR_XC + (16 * mt + (lane & 15)) * LR_XCP + (32 * ks + 8 * q) * 2);
            ar[mt] = __builtin_amdgcn_mfma_f32_16x16x32_bf16(af, bA[ks], ar[mt], 0, 0, 0);
            ai[mt] = __builtin_amdgcn_mfma_f32_16x16x32_bf16(af, bI[ks], ai[mt], 0, 0, 0); } }
    if (pf) lru_load<1 - DIR>(xnx, z, pf_tb, pf_hh, pf_lo, pf_hi, tid);
    float Al = 1.f, Bl = 0.f;
    const LAS unsigned char* xcp = lds + LR_XC + (4 * q) * LR_XCP + chl * 2;
#pragma unroll
    for (int mt = 0; mt < 8; ++mt)
#pragma unroll
        for (int r = 0; r < 4; ++r) {
            const float er = __builtin_amdgcn_exp2f(__builtin_fmaf(ar[mt][r], -LOG2E, nba)), ei = __builtin_amdgcn_exp2f(__builtin_fmaf(ai[mt][r], -LOG2E, nbi));
            const float dr = 1.f + er, di = 1.f + ei, R = __builtin_amdgcn_rcpf(dr * di);
            const float av = __builtin_amdgcn_exp2f(c8 * (R * di));
            const float xcv = bf1(*(const LAS bf16*)(xcp + (16 * mt + r) * LR_XCP));
            const float uv = __builtin_amdgcn_sqrtf(fmaxf(__builtin_fmaf(-av, av, 1.f), 0.f)) * (R * dr) * xcv;
            ar[mt][r] = av; ai[mt][r] = uv; Bl = __builtin_fmaf(av, Bl, uv); Al *= av; }
    float A4 = Al, B4 = Bl;
    { const float Ap = __shfl_up(A4, 16), Bp = __shfl_up(B4, 16); if (q >= 1) { B4 = A4 * Bp + B4; A4 = A4 * Ap; } }
    { const float Ap = __shfl_up(A4, 32), Bp = __shfl_up(B4, 32); if (q >= 2) { B4 = A4 * Bp + B4; A4 = A4 * Ap; } }
    float Ae = __shfl_up(A4, 16), Be = __shfl_up(B4, 16); if (q == 0) { Ae = 1.f; Be = 0.f; }
    const float At = __shfl(A4, 48 + (lane & 15)), Bt = __shfl(B4, 48 + (lane & 15));
    if (q == 0) { float* ag = agg + (size_t)c * 2048 + (size_t)DIR * 1024 + 2 * chg; ag[0] = At; ag[1] = Bt; }
    { float hcur = Be, pcur = Ae;
      const int tq0 = DIR ? 127 - 32 * q : 32 * q, rot = (chl + 16 * (DIR ? 3 - q : q)) & 127;
      LAS float* yp = Y + tq0 * LR_YP + rot; LAS unsigned char* pp_ = lds + LR_PB + tq0 * LR_XCP + rot * 2;
#pragma unroll
      for (int mt = 0; mt < 8; ++mt)
#pragma unroll
          for (int r = 0; r < 4; ++r) { hcur = __builtin_fmaf(ar[mt][r], hcur, ai[mt][r]); pcur *= ar[mt][r];
              const int dt_ = DIR ? -(4 * mt + r) : (4 * mt + r);
              if (DIR == 0) yp[dt_ * LR_YP] = hcur; else yp[dt_ * LR_YP] += hcur;
              *(LAS bf16*)(pp_ + dt_ * LR_XCP) = (bf16)(pk2(pcur, 0.f) & 0xffffu); } }
    __syncthreads();
    { bf16* dst = PFB + (size_t)DIR * MTOK * 512;
      for (int p = tid; p < 128 * 16; p += NTHR) { const int t = p >> 4, pc = p & 15, pcr = (pc + 2 * (t >> 5)) & 15;
          *(v4u*)(dst + (size_t)(tb + t) * 512 + hh * 128 + pc * 8) = *(const LAS v4u*)(lds + LR_PB + t * LR_XCP + pcr * 16); } }
}

__device__ __forceinline__ void lru_heavy(LAS unsigned char* lds, int item, int next_item, v4u (&xa)[7], v4u (&xb)[7], const bf16* z, const LruLayer& LP, float* agg, bf16* LL, bf16* PFB  , int tid) {
    asm volatile("" : "+v"(tid));
    const int c = item >> 2, hh = item & 3;
    int s0, ns; seq_of_chunk(c, s0, ns);
    const int tb = c * 128, seq_lo = s0 * 128, seq_hi = (s0 + ns) * 128;
    int n_tb = 0, n_hh = 0, n_lo = 0, n_hi = 1;
    if (next_item >= 0) { const int nc = next_item >> 2; int t0_, t1_; seq_of_chunk(nc, t0_, t1_); n_tb = nc * 128; n_hh = next_item & 3; n_lo = t0_ * 128; n_hi = (t0_ + t1_) * 128; }
    lru_load<0>(xa, z, tb, hh, seq_lo, seq_hi, tid);
    lru_dir<0>(lds, z, LP, agg, PFB, c, hh, seq_lo, seq_hi, tid, xa, xb, true, tb, hh, seq_lo, seq_hi);
    lru_dir<1>(lds, z, LP, agg, PFB, c, hh, seq_lo, seq_hi, tid, xb, xa, false, n_tb, n_hh, n_lo, n_hi);
    const LAS float* Y = (const LAS float*)(lds + LR_Y);
    for (int p = tid; p < 128 * 16; p += NTHR) { const int t = p >> 4, pc = p & 15, pcr = (pc + 2 * (t >> 5)) & 15; const LAS float* yr = Y + t * LR_YP + pcr * 8;
        v4u ow; ow.x = pk2(yr[0], yr[1]); ow.y = pk2(yr[2], yr[3]); ow.z = pk2(yr[4], yr[5]); ow.w = pk2(yr[6], yr[7]);
        *(v4u*)(LL + (size_t)(tb + t) * 512 + hh * 128 + pc * 8) = ow; }
    __syncthreads();
}

__device__ __forceinline__ void lru_light(LAS unsigned char* lds, int c, const bf16* z, bf16* mix, const float* agg, const bf16* LL, const bf16* PFB, int tid) {
    asm volatile("" : "+v"(tid));
    int s0, ns; seq_of_chunk(c, s0, ns);
    LAS float* car = (LAS float*)lds;
    {
      const float* ag0 = agg + 2 * tid; const float* ag1 = agg + 1024 + 2 * tid;
      float H0 = 0.f, H1 = 0.f; int cc = s0, cd = s0 + ns - 1;
      for (; cc + 16 <= c; cc += 16) { v2f v[16];
#pragma unroll
          for (int k = 0; k < 16; ++k) v[k] = *(const v2f*)(ag0 + (size_t)(cc + k) * 2048);
#pragma unroll
          for (int k = 0; k < 16; ++k) H0 = v[k][0] * H0 + v[k][1]; }
      for (; cc < c; ++cc) { const v2f v = *(const v2f*)(ag0 + (size_t)cc * 2048); H0 = v[0] * H0 + v[1]; }
      for (; cd - 16 >= c; cd -= 16) { v2f v[16];
#pragma unroll
          for (int k = 0; k < 16; ++k) v[k] = *(const v2f*)(ag1 + (size_t)(cd - k) * 2048);
#pragma unroll
          for (int k = 0; k < 16; ++k) H1 = v[k][0] * H1 + v[k][1]; }
      for (; cd > c; --cd) { const v2f v = *(const v2f*)(ag1 + (size_t)cd * 2048); H1 = v[0] * H1 + v[1]; }
      car[tid] = H0; car[512 + tid] = H1; }
    __syncthreads();
    const int tb = c * 128;
#pragma unroll 4
    for (int p = tid; p < 128 * 64; p += NTHR) { const int t = p >> 6, c8 = (p & 63) * 8; const size_t ro = (size_t)(tb + t) * 512 + c8;
        const v4u lv = *(const v4u*)(LL + ro), fv = *(const v4u*)(PFB + ro), bv = *(const v4u*)(PFB + (size_t)MTOK * 512 + ro);
        const v4u gv = *(const v4u*)(z + (size_t)(tb + t) * NZ + ZGL + c8);
        float o[8];
#pragma unroll
        for (int e = 0; e < 4; ++e) {
            o[2 * e] = (bflo(lv[e]) + bflo(fv[e]) * car[c8 + 2 * e] + bflo(bv[e]) * car[512 + c8 + 2 * e]) * silu(bflo(gv[e]));
            o[2 * e + 1] = (bfhi(lv[e]) + bfhi(fv[e]) * car[c8 + 2 * e + 1] + bfhi(bv[e]) * car[512 + c8 + 2 * e + 1]) * silu(bfhi(gv[e])); }
        v4u ow; ow.x = pk2(o[0], o[1]); ow.y = pk2(o[2], o[3]); ow.z = pk2(o[4], o[5]); ow.w = pk2(o[6], o[7]);
        *(v4u*)(mix + (size_t)(tb + t) * DMOD + 1536 + c8) = ow; }
    __syncthreads();
}

#define XB_TMO      128
#define XB_XCNT(j)  (256  + 64 * (j))
#define XB_XSUB(j)  (1280 + 64 * (j))
#define XB_XGEN(j)  (2304 + 64 * (j))
#define XB_TOP      3328
#define XB_TOPGEN   3392
#define XCD_BAR_WORDS 3456
#define XB_SPIN_CAP (1u << 18)

__device__ __forceinline__ unsigned xb_ld(unsigned* p)              { return __hip_atomic_load(p, __ATOMIC_RELAXED, __HIP_MEMORY_SCOPE_AGENT); }
__device__ __forceinline__ unsigned xb_add(unsigned* p, unsigned v) { return __hip_atomic_fetch_add(p, v, __ATOMIC_RELAXED, __HIP_MEMORY_SCOPE_AGENT); }
__device__ __forceinline__ unsigned xb_xcc_id() { return (unsigned)__builtin_amdgcn_s_getreg((3 << 11) | 20) & 0xFu; }
#define XB_SPIN(cond, bar) do { unsigned _sp = 0; while (cond) { __builtin_amdgcn_s_sleep(1); \
    if ((++_sp & 255u) == 0u) { if (xb_ld(&(bar)[XB_TMO])) break; if (_sp > XB_SPIN_CAP) { atomicAdd(&(bar)[XB_TMO], 1u); break; } } } } while (0)

struct XcdBarrier {
    unsigned* bar; unsigned x;
    volatile LAS unsigned* st;
};

__device__ __forceinline__ XcdBarrier xcd_barrier_post(unsigned* bar, volatile LAS unsigned* st) {
    XcdBarrier b; b.bar = bar; b.x = xb_xcc_id(); b.st = st;
    if (threadIdx.x == 0) (void)xb_add(&bar[XB_XCNT(b.x)], 1u);
    return b;
}
__device__ __forceinline__ void xcd_barrier_complete(unsigned* bar, unsigned x, unsigned& nloc, unsigned& nx) {
    const unsigned G = gridDim.x * gridDim.y * gridDim.z;
    unsigned sum, cnt, mine, sp = 0u;
    for (;;) {
        sum = 0u; cnt = 0u; mine = 0u;
#pragma unroll
        for (unsigned j = 0; j < 16; ++j) { const unsigned c = xb_ld(&bar[XB_XCNT(j)]); sum += c; cnt += (c > 0u) ? 1u : 0u; mine = (j == x) ? c : mine; }
        if (sum == G) break;
        __builtin_amdgcn_s_sleep(1);
        if ((++sp & 255u) == 0u) { if (xb_ld(&bar[XB_TMO])) break; if (sp > XB_SPIN_CAP) { atomicAdd(&bar[XB_TMO], 1u); break; } }
    }
    nloc = mine > 0u ? mine : 1u; nx = cnt > 0u ? cnt : 1u;
}

__device__ __forceinline__ void xcd_barrier(const XcdBarrier& b) {
    asm volatile("s_waitcnt vmcnt(0)" ::: "memory");
    __syncthreads();
    if (threadIdx.x == 0) {
        unsigned* bar = b.bar;
        __builtin_amdgcn_s_waitcnt(0);
        unsigned nloc = b.st[0], nx = b.st[1];
        if (nloc == 0u) { xcd_barrier_complete(bar, b.x, nloc, nx); b.st[0] = nloc; b.st[1] = nx; }
        const unsigned old = xb_add(&bar[XB_XSUB(b.x)], 1u);
        const unsigned gen = old / nloc;
        if (old + 1u == (gen + 1u) * nloc) {
            __builtin_amdgcn_fence(__ATOMIC_RELEASE, "agent");
            asm volatile("s_waitcnt vmcnt(0)" ::: "memory");
            const unsigned og = xb_add(&bar[XB_TOP], 1u);
            const unsigned tg = og / nx;
            if (og + 1u == (tg + 1u) * nx) xb_add(&bar[XB_TOPGEN], 1u);
            else XB_SPIN(xb_ld(&bar[XB_TOPGEN]) == tg, bar);
            __builtin_amdgcn_fence(__ATOMIC_ACQUIRE, "agent");
            xb_add(&bar[XB_XGEN(b.x)], 1u);
            asm volatile("s_waitcnt vmcnt(0)" ::: "memory");
        } else {
            XB_SPIN(xb_ld(&bar[XB_XGEN(b.x)]) == gen, bar);
            __builtin_amdgcn_fence(__ATOMIC_ACQUIRE, "agent");
            asm volatile("s_waitcnt vmcnt(0)" ::: "memory");
        }
    }
    __syncthreads();
}

constexpr int RS_OFF = 131072;
__device__ __forceinline__ void rstd_stage(LAS unsigned char* lds, const pg8::StaticOrder& S, const float* ssq, int tid) {
    asm volatile("" : "+v"(tid));
    int last = -1;
    for (int i = 0; ; ++i) { pg8::Unit u; if (!S.next(i, u)) break;
        if (u.pm != last) { last = u.pm; if (tid < 256) ((LAS float*)(lds + RS_OFF))[((u.pm >> 3) & 3) * 256 + tid] = rsqrtf(ssq[u.pm * 256 + tid] * (1.f / DMOD) + 1e-6f); } }
    __syncthreads();
}

#ifndef PH_LO
#define PH_LO 0
#endif
__global__ void __launch_bounds__(NTHR, 2) fwd_megakernel(Params P) {
    extern __shared__ __attribute__((aligned(16))) unsigned char lds_raw[];
    LAS unsigned char* lds = (LAS unsigned char*)lds_raw;
    cg::grid_group grid = cg::this_grid();
    const int tid = threadIdx.x, G = gridDim.x;
    unsigned char* ws = P.ws;
    volatile LAS unsigned* MISC = (volatile LAS unsigned*)(lds + LDS_BYTES - 64);
    if (tid < 16) MISC[tid] = 0u;
    __syncthreads();
    (void)xcd_barrier_post((unsigned*)(ws + WS_CTL), MISC);
#define GRID_BAR() do { unsigned char* w_ = P.ws; asm volatile("" : "+s"(w_)); XcdBarrier b_; b_.bar = (unsigned*)(w_ + WS_CTL); b_.x = xb_xcc_id(); \
        b_.st = (volatile LAS unsigned*)(lds + LDS_BYTES - 64); xcd_barrier(b_); } while (0)
    float* ssq = (float*)(ws + WS_SSQ); float* agg = (float*)(ws + WS_AGG);
    bf16* hbA = (bf16*)(ws + WS_HBA); bf16* hbB = (bf16*)(ws + WS_HBB); bf16* mix = (bf16*)(ws + WS_MIX); bf16* pp = (bf16*)(ws + WS_PP); bf16* z = (bf16*)(ws + WS_Z);

#ifndef NO_P0
    p0_prologue(P, lds, tid, G);
#ifdef DUP_P0
    __syncthreads(); p0_prologue(P, lds, tid, G);
#endif
#endif
    if (P.ws == nullptr) grid.sync();
    GRID_BAR();
#ifdef DUP_SYNC
#pragma unroll 1
    for (int r = 0; r < 10; ++r) GRID_BAR();
#endif
#pragma unroll 1
    for (int l = 0; l < 2; ++l) {
        { pg8::Gemm g{hbA, (const bf16*)(ws + WS_WIN) + (size_t)l * NZ * DMOD, MTOK, NZ, DMOD}; pg8::StaticOrder S; S.init(MTOK, NZ, G, (int)blockIdx.x);
          rstd_stage(lds, S, ssq + (size_t)(2 * l) * MTOK, tid);
          pg8::EpiZ E{z, NZ, (const LAS float*)(lds + RS_OFF)};
#ifdef STAG_A
          { const unsigned long long t0 = __builtin_amdgcn_s_memrealtime(); const unsigned long long wt = (unsigned long long)((blockIdx.x >> 3) & 3) * STAG_A;
            while (__builtin_amdgcn_s_memrealtime() - t0 < wt) __builtin_amdgcn_s_sleep(32); }
#endif
          pg8::gemm_phase<pg8::EpiZ, pg8::StaticOrder, true, true>(lds, g, S, E);
#ifdef DUP_A
          pg8::gemm_phase<pg8::EpiZ, pg8::StaticOrder, true, true>(lds, g, S, E);
#endif
 }
        GRID_BAR();
#ifdef DUP_MIX
        for (int rep = 0; rep < 2; ++rep) {
#endif
        LruLayer LP{P.lru_conv_w + (size_t)l * 2 * 4 * 512, P.lru_conv_b + l * 1024, P.lru_b_a + l * 1024, P.lru_b_i + l * 1024, P.lru_L + l * 1024, (const bf16*)(ws + WS_WL) + (size_t)l * 16 * 16384};
        bf16* LL = hbB; bf16* PFB = hbB + (size_t)MTOK * 512;
#pragma unroll 1
        for (int step = 0; step < 2; ++step) {
            if ((step ^ ((blockIdx.x >> 3) & 1)) == 0) {
                { v4u xa[7], xb[7];
                  for (int it = blockIdx.x; it < NCHUNK * 4; it += G) lru_heavy(lds, it, (it + G < NCHUNK * 4) ? it + G : -1, xa, xb, z, LP, agg, LL, PFB, tid); }
            } else {
                conv_phase(z, mix, P.conv_w + (size_t)l * 3 * 512, G, tid);
                if (l == 0) { pb_convert(P, tid, G); tr_run(P, lds, tid, G, 1, TI_LATE); }
                __syncthreads();
            }
        }
        GRID_BAR();
        attn_build_tab(lds, P.rel_bias, tid);
        __syncthreads();
#pragma unroll 1
        for (int step = 0; step < 2; ++step) {
        if ((step ^ ((blockIdx.x >> 3) & 1)) == 0) {
#ifndef NO_ATTN
        if (G == 256) {
            const int xc = (blockIdx.x & 7) * 32 + (blockIdx.x >> 3);
#pragma unroll 1
            for (int r = 0; r < 4; ++r) attn_item<0>(lds, xc * 4 + r, z, mix, P.attn_sink + l * 8, tid);
        } else
        for (int it = blockIdx.x; it < NCHUNK * 4; it += G) attn_item<0>(lds, it, z, mix, P.attn_sink + l * 8, tid);
#ifdef DUP_ATTN
        { const int xc = (blockIdx.x & 7) * 32 + (blockIdx.x >> 3);
#pragma unroll 1
          for (int r = 0; r < 4; ++r) attn_item<DUP_ATTN - 1>(lds, xc * 4 + r, z, (bf16*)P.out, P.attn_sink + l * 8, tid); }
#endif
#endif
        } else {
        for (int it = blockIdx.x; it < NCHUNK; it += G) lru_light(lds, it, z, mix, agg, LL, PFB, tid);
#ifdef DUP_LIGHT
        for (int it = blockIdx.x; it < NCHUNK; it += G) lru_light(lds, it, z, mix, agg, LL, PFB, tid);
#endif
        __syncthreads();
        } }
        GRID_BAR();
#ifdef DUP_MIX
        }
#endif
#pragma unroll 1
        for (int step = 0; step < 2; ++step) {
            if ((step ^ ((blockIdx.x >> 3) & 1)) == 0) {
                pg8::Gemm g{mix, (const bf16*)(ws + WS_WOUT) + (size_t)l * DMOD * DMOD, MTOK, DMOD, DMOD}; pg8::StaticOrder S; S.init(MTOK, DMOD, G, (int)blockIdx.x);
#ifdef TIME_EPI
                unsigned tacc_ = 0u;
                pg8::EpiRes E{hbA, hbB, ssq + (size_t)(2 * l + 1) * MTOK, &tacc_};
                pg8::gemm_phase<pg8::EpiRes, pg8::StaticOrder, true, true>(lds, g, S, E);
                { const unsigned long long t0 = __builtin_amdgcn_s_memrealtime(); const unsigned long long wt = 8ull * tacc_; while (__builtin_amdgcn_s_memrealtime() - t0 < wt) __builtin_amdgcn_s_sleep(32); }
#else
                pg8::EpiRes E{hbA, hbB, ssq + (size_t)(2 * l + 1) * MTOK};
                pg8::gemm_phase<pg8::EpiRes, pg8::StaticOrder, true, true>(lds, g, S, E);
#endif
            } else {
                pg8::Gemm g{(const bf16*)(ws + WS_PB) + (size_t)l * MTOK * PLE, (const bf16*)(ws + WS_WPROJ) + (size_t)l * DMOD * PLE, MTOK, DMOD, PLE}; pg8::StaticOrder S; S.init(MTOK, DMOD, G, (int)blockIdx.x);
                pg8::EpiZ E{pp, 0, nullptr};
                pg8::gemm_phase<pg8::EpiZ, pg8::StaticOrder, true, true>(lds, g, S, E);
            }
        }
        GRID_BAR();
        { pg8::Gemm g{hbB, (const bf16*)(ws + WS_WGATE) + (size_t)l * DMOD * DMOD, MTOK, DMOD, DMOD}; pg8::StaticOrder S; S.init(MTOK, DMOD, G, (int)blockIdx.x);
          rstd_stage(lds, S, ssq + (size_t)(2 * l + 1) * MTOK, tid);
          pg8::EpiGate E{(const LAS float*)(lds + RS_OFF), hbB, pp, hbA, ssq + (size_t)(2 * l + 2) * MTOK};
#ifndef NO_GD
          pg8::gemm_phase<pg8::EpiGate, pg8::StaticOrder, true, true>(lds, g, S, E);
#endif
 }
        GRID_BAR();
    }
    { const int lane = tid & 63, gw = blockIdx.x * NWAVES + (tid >> 6), NGW = G * NWAVES; const float* sf = ssq + (size_t)4 * MTOK;
      for (int row = gw; row < MTOK; row += NGW) { const float rs = rsqrtf(sf[row] * (1.f / DMOD) + 1e-6f); float* orow = P.out + (size_t)row * DMOD; const bf16* hrow = hbA + (size_t)row * DMOD;
#pragma unroll
          for (int j = 0; j < 4; ++j) { const int cidx = 8 * lane + 512 * j; const v4u hv = *(const v4u*)(hrow + cidx); const f32x4 g0 = *(const f32x4*)(P.final_norm + cidx), g1 = *(const f32x4*)(P.final_norm + cidx + 4);
              f32x4 v0, v1; v0[0] = bflo(hv.x) * rs * g0[0]; v0[1] = bfhi(hv.x) * rs * g0[1]; v0[2] = bflo(hv.y) * rs * g0[2]; v0[3] = bfhi(hv.y) * rs * g0[3];
              v1[0] = bflo(hv.z) * rs * g1[0]; v1[1] = bfhi(hv.z) * rs * g1[1]; v1[2] = bflo(hv.w) * rs * g1[2]; v1[3] = bfhi(hv.w) * rs * g1[3];
              *(f32x4*)(orow + cidx) = v0; *(f32x4*)(orow + cidx + 4) = v1; } } }
}

extern "C" void kernel_launch(void* const* d_in, const int* in_sizes, int n_in, void* d_out, int out_size, void* d_ws, size_t ws_size, hipStream_t stream) {
    static int grid_blocks = 0;
    if (!grid_blocks) {
        if (n_in != 21 || ws_size < WS_END) { fprintf(stderr, "kernel_launch: unexpected n_in %d / ws_size %zu\n", n_in, ws_size); grid_blocks = -1; return; }
        int dev = 0, cus = 0, per_cu = 0;
        (void)hipGetDevice(&dev);
        (void)hipDeviceGetAttribute(&cus, hipDeviceAttributeMultiprocessorCount, dev);
        (void)hipFuncSetAttribute((const void*)fwd_megakernel, hipFuncAttributeMaxDynamicSharedMemorySize, LDS_BYTES);
        (void)hipOccupancyMaxActiveBlocksPerMultiprocessor(&per_cu, (const void*)fwd_megakernel, NTHR, LDS_BYTES);
        if (per_cu < 1) { fprintf(stderr, "kernel_launch: occupancy query says %d blocks/CU\n", per_cu); per_cu = 1; }
        grid_blocks = cus;
    }
    if (grid_blocks < 0) return;
    (void)hipMemsetAsync((unsigned char*)d_ws + WS_CTL, 0, CTL_BYTES, stream);
    Params p{};
    const float** pf = (const float**)&p;
    for (int i = 0; i < 21; ++i) pf[i] = (const float*)d_in[i];
    p.out = (float*)d_out; p.ws = (unsigned char*)d_ws;
    void* args[] = {&p};
    hipError_t e = hipLaunchCooperativeKernel((void*)fwd_megakernel, dim3(grid_blocks), dim3(NTHR), args, LDS_BYTES, stream);
    if (e != hipSuccess) fprintf(stderr, "cooperative launch failed: %s (grid %d)\n", hipGetErrorString(e), grid_blocks);
}
```

```cpp
#include <hip/hip_runtime.h>
#include <hip/hip_cooperative_groups.h>
#include <cstdio>
#include <cstdint>
namespace cg = cooperative_groups;
namespace pg8 {
#define PG8_LAS __attribute__((address_space(3)))
typedef unsigned short bf16_t;
typedef short bf16x8 __attribute__((ext_vector_type(8)));
typedef float f32x4 __attribute__((ext_vector_type(4)));
typedef unsigned u32x4 __attribute__((ext_vector_type(4)));
constexpr int BM = 256, BK = 64, HALF = 128, HTB = HALF * BK * 2  , STAGE_BYTES = 8 * HTB, NXCD = 8, WGM = 8;

__host__ __device__ __forceinline__ int lds_byte(int r, int c) { const int st = (r >> 4) * 2 + (c >> 5), rr = r & 15, cc = c & 31, ob = rr * 64 + cc * 2; return st * 1024 + (ob ^ (((ob >> 9) & 1) << 5)); }
__host__ __device__ __forceinline__ void stage_rc(int b, int& R, int& C) { const int st = b / 1024, sb = b % 1024, swz = sb ^ (((sb >> 9) & 1) << 5); R = (st >> 1) * 16 + swz / 64; C = (st & 1) * 32 + (swz % 64) / 2; }
__host__ __device__ __forceinline__ int perm32(int rho) { const int n = rho >> 4, i = rho & 15; return 8 * (i >> 2) + 4 * n + (i & 3); }

struct Unit { int pm, pn; };
struct Gemm { const bf16_t* A; const bf16_t* Bt; int M, N, K; };

struct StaticOrder {
    int nM, nN, nwg, G, c;
    __host__ __device__ void init(int M, int N, int G_, int c_) { nM = M / BM; nN = N / BM; nwg = nM * nN; G = G_; c = c_; }
    __host__ __device__ bool next(int i, Unit& u) const {
        const long L = (long)i * G + c; if (L >= nwg) return false;
        int wgid = (int)L; { const int q = nwg / NXCD, r = nwg % NXCD, xcd = wgid % NXCD, off = wgid / NXCD; wgid = (xcd < r ? xcd * (q + 1) : r * (q + 1) + (xcd - r) * q) + off; }
        const int nig = WGM * nN, gid = wgid / nig, fm = gid * WGM, gsz = (nM - fm) < WGM ? (nM - fm) : WGM;
        u.pm = fm + ((wgid % nig) % gsz); u.pn = (wgid % nig) / gsz; return true;
    }
    __device__ __forceinline__ void a_ready(const Unit&) const {}
    __device__ __forceinline__ void done(const Unit&) const {}
};

__device__ __forceinline__ unsigned cvt_pk_bf16(float lo, float hi) { unsigned r; asm volatile("v_cvt_pk_bf16_f32 %0, %1, %2" : "=v"(r) : "v"(lo), "v"(hi)); return r; }
__device__ __forceinline__ float fast_sigmoid(float x) { return __builtin_amdgcn_rcpf(1.f + __expf(-x)); }
__device__ __forceinline__ float bf_lo(unsigned w) { return __builtin_bit_cast(float, w << 16); }
__device__ __forceinline__ float bf_hi(unsigned w) { return __builtin_bit_cast(float, w & 0xffff0000u); }
constexpr int DM = 2048;
constexpr float NEPS = 1e-6f;

struct EpiZ {
    static constexpr bool PERM = true, AFTER_DRAIN = false;
    bf16_t* O; int ldc; const PG8_LAS float* ssq;
    __device__ __forceinline__ void operator()(const f32x4 (&acc)[2][2][4][2], const Unit& u, int wr, int wc, int fr, int fq) const {
        const int row0 = u.pm * BM + wr * 64 + fr, col0 = u.pn * BM + wc * 32 + 8 * fq;
        float sq[2][4];
#pragma unroll
        for (int ai = 0; ai < 2; ++ai)
#pragma unroll
            for (int m = 0; m < 4; ++m) sq[ai][m] = ssq ? ssq[((u.pm >> 3) & 3) * 256 + wr * 64 + fr + ai * HALF + m * 16] : 1.f;
#pragma unroll
        for (int ai = 0; ai < 2; ++ai)
#pragma unroll
            for (int m = 0; m < 4; ++m) { const int row = row0 + ai * HALF + m * 16;
                const float sc = sq[ai][m];
                bf16_t* rowp = ldc ? O + (size_t)row * ldc + col0 : O + ((size_t)(u.pm * 8 + u.pn) * 256 + (row - u.pm * BM)) * 256 + (col0 - u.pn * BM);
#pragma unroll
                for (int bj = 0; bj < 2; ++bj) { const f32x4 v0 = acc[ai][bj][m][0] * sc, v1 = acc[ai][bj][m][1] * sc;
                    u32x4 w; w.x = cvt_pk_bf16(v0[0], v0[1]); w.y = cvt_pk_bf16(v0[2], v0[3]); w.z = cvt_pk_bf16(v1[0], v1[1]); w.w = cvt_pk_bf16(v1[2], v1[3]);
                    *(u32x4*)(rowp + bj * HALF) = w; } }
    }
};

struct EpiRes {
    static constexpr bool PERM = true, AFTER_DRAIN = false;
    const bf16_t* res; bf16_t* hb; float* ssq;
    __device__ __forceinline__ void operator()(const f32x4 (&acc)[2][2][4][2], const Unit& u, int wr, int wc, int fr, int fq) const {
#ifdef TIME_EPI
        const unsigned long long t0_ = __builtin_amdgcn_s_memrealtime();
#endif
        const int row0 = u.pm * BM + wr * 64 + fr, col0 = u.pn * BM + wc * 32 + 8 * fq;
#pragma unroll
        for (int ai = 0; ai < 2; ++ai)
#pragma unroll
            for (int m = 0; m < 4; ++m) { const int row = row0 + ai * HALF + m * 16;
                const bf16_t* sp = res + (size_t)row * DM + col0; bf16_t* hp = hb + (size_t)row * DM + col0; float s = 0.f;
#pragma unroll
                for (int bj = 0; bj < 2; ++bj) { const u32x4 rw = *(const u32x4*)(sp + bj * HALF);
                    f32x4 v0 = acc[ai][bj][m][0], v1 = acc[ai][bj][m][1];
                    v0[0] += bf_lo(rw.x); v0[1] += bf_hi(rw.x); v0[2] += bf_lo(rw.y); v0[3] += bf_hi(rw.y);
                    v1[0] += bf_lo(rw.z); v1[1] += bf_hi(rw.z); v1[2] += bf_lo(rw.w); v1[3] += bf_hi(rw.w);
                    u32x4 w; w.x = cvt_pk_bf16(v0[0], v0[1]); w.y = cvt_pk_bf16(v0[2], v0[3]); w.z = cvt_pk_bf16(v1[0], v1[1]); w.w = cvt_pk_bf16(v1[2], v1[3]);
                    *(u32x4*)(hp + bj * HALF) = w;
                    s += v0[0] * v0[0] + v0[1] * v0[1] + v0[2] * v0[2] + v0[3] * v0[3] + v1[0] * v1[0] + v1[1] * v1[1] + v1[2] * v1[2] + v1[3] * v1[3]; }
                s += __shfl_xor(s, 16); s += __shfl_xor(s, 32);
                if (fq == 0) atomicAdd(ssq + row, s); }
#ifdef TIME_EPI
#if TIME_EPI == 2
        asm volatile("s_waitcnt vmcnt(0)" ::: "memory");
#endif
        *tacc += (unsigned)(__builtin_amdgcn_s_memrealtime() - t0_);
#endif
    }
#ifdef TIME_EPI
    unsigned* tacc;
#endif
};

struct EpiResNoAtom {
    static constexpr bool PERM = true, AFTER_DRAIN = false;
    const bf16_t* res; bf16_t* hb; float* ssq;
    __device__ __forceinline__ void operator()(const f32x4 (&acc)[2][2][4][2], const Unit& u, int wr, int wc, int fr, int fq) const {
#ifdef TIME_EPI
        const unsigned long long t0_ = __builtin_amdgcn_s_memrealtime();
#endif
        const int row0 = u.pm * BM + wr * 64 + fr, col0 = u.pn * BM + wc * 32 + 8 * fq;
#pragma unroll
        for (int ai = 0; ai < 2; ++ai)
#pragma unroll
            for (int m = 0; m < 4; ++m) { const int row = row0 + ai * HALF + m * 16;
                const bf16_t* sp = res + (size_t)row * DM + col0; bf16_t* hp = hb + (size_t)row * DM + col0; float s = 0.f;
#pragma unroll
                for (int bj = 0; bj < 2; ++bj) { const u32x4 rw = *(const u32x4*)(sp + bj * HALF);
                    f32x4 v0 = acc[ai][bj][m][0], v1 = acc[ai][bj][m][1];
                    v0[0] += bf_lo(rw.x); v0[1] += bf_hi(rw.x); v0[2] += bf_lo(rw.y); v0[3] += bf_hi(rw.y);
                    v1[0] += bf_lo(rw.z); v1[1] += bf_hi(rw.z); v1[2] += bf_lo(rw.w); v1[3] += bf_hi(rw.w);
                    u32x4 w; w.x = cvt_pk_bf16(v0[0], v0[1]); w.y = cvt_pk_bf16(v0[2], v0[3]); w.z = cvt_pk_bf16(v1[0], v1[1]); w.w = cvt_pk_bf16(v1[2], v1[3]);
                    *(u32x4*)(hp + bj * HALF) = w;
                    s += v0[0] * v0[0] + v0[1] * v0[1] + v0[2] * v0[2] + v0[3] * v0[3] + v1[0] * v1[0] + v1[1] * v1[1] + v1[2] * v1[2] + v1[3] * v1[3]; }
                s += __shfl_xor(s, 16); s += __shfl_xor(s, 32);
                if (s == 12345.678f) ssq[row] = s; }
#ifdef TIME_EPI
#if TIME_EPI == 2
        asm volatile("s_waitcnt vmcnt(0)" ::: "memory");
#endif
        *tacc += (unsigned)(__builtin_amdgcn_s_memrealtime() - t0_);
#endif
    }
#ifdef TIME_EPI
    unsigned* tacc;
#endif
};

struct EpiGate {
    static constexpr bool PERM = true, AFTER_DRAIN = false;
    const PG8_LAS float* ssq_in; const bf16_t* res; const bf16_t* pp; bf16_t* hb; float* ssq_out;
    __device__ __forceinline__ void operator()(const f32x4 (&acc)[2][2][4][2], const Unit& u, int wr, int wc, int fr, int fq) const {
        const int row0 = u.pm * BM + wr * 64 + fr, col0 = u.pn * BM + wc * 32 + 8 * fq;
#pragma unroll
        for (int ai = 0; ai < 2; ++ai)
#pragma unroll
            for (int m = 0; m < 4; ++m) { const int row = row0 + ai * HALF + m * 16;
                const float sc = ssq_in[((u.pm >> 3) & 3) * 256 + (row - u.pm * BM)];
                const bf16_t* sp = res + (size_t)row * DM + col0; bf16_t* hp = hb + (size_t)row * DM + col0; const bf16_t* ppp = pp + ((size_t)(u.pm * 8 + u.pn) * 256 + (row - u.pm * BM)) * 256 + (col0 - u.pn * BM);   float s = 0.f;
#pragma unroll
                for (int bj = 0; bj < 2; ++bj) { const u32x4 rw = *(const u32x4*)(sp + bj * HALF); const u32x4 pw = *(const u32x4*)(ppp + bj * HALF);
                    const f32x4 a0 = acc[ai][bj][m][0] * sc, a1 = acc[ai][bj][m][1] * sc;
                    f32x4 v0, v1;
                    v0[0] = bf_lo(rw.x) + fast_sigmoid(a0[0]) * bf_lo(pw.x); v0[1] = bf_hi(rw.x) + fast_sigmoid(a0[1]) * bf_hi(pw.x);
                    v0[2] = bf_lo(rw.y) + fast_sigmoid(a0[2]) * bf_lo(pw.y); v0[3] = bf_hi(rw.y) + fast_sigmoid(a0[3]) * bf_hi(pw.y);
                    v1[0] = bf_lo(rw.z) + fast_sigmoid(a1[0]) * bf_lo(pw.z); v1[1] = bf_hi(rw.z) + fast_sigmoid(a1[1]) * bf_hi(pw.z);
                    v1[2] = bf_lo(rw.w) + fast_sigmoid(a1[2]) * bf_lo(pw.w); v1[3] = bf_hi(rw.w) + fast_sigmoid(a1[3]) * bf_hi(pw.w);
                    u32x4 w; w.x = cvt_pk_bf16(v0[0], v0[1]); w.y = cvt_pk_bf16(v0[2], v0[3]); w.z = cvt_pk_bf16(v1[0], v1[1]); w.w = cvt_pk_bf16(v1[2], v1[3]);
                    *(u32x4*)(hp + bj * HALF) = w;
                    s += v0[0] * v0[0] + v0[1] * v0[1] + v0[2] * v0[2] + v0[3] * v0[3] + v1[0] * v1[0] + v1[1] * v1[1] + v1[2] * v1[2] + v1[3] * v1[3]; }
                s += __shfl_xor(s, 16); s += __shfl_xor(s, 32);
                if (fq == 0) atomicAdd(ssq_out + row, s); }
    }
};

struct EpiNull {
    static constexpr bool PERM = true, AFTER_DRAIN = false;
    float* sink;
    __device__ __forceinline__ void operator()(const f32x4 (&acc)[2][2][4][2], const Unit& u, int wr, int wc, int fr, int fq) const {
        float s = 0.f;
#pragma unroll
        for (int ai = 0; ai < 2; ++ai)
#pragma unroll
            for (int bj = 0; bj < 2; ++bj)
#pragma unroll
                for (int m = 0; m < 4; ++m)
#pragma unroll
                    for (int n = 0; n < 2; ++n) s += acc[ai][bj][m][n][0] + acc[ai][bj][m][n][1] + acc[ai][bj][m][n][2] + acc[ai][bj][m][n][3];
        if (s == 12345.678f) sink[u.pm + wr + wc + fr + fq] = s;
    }
};
template <class Epi, class Sched, bool ALIGN_EPI = false, bool SP2 = false>
__device__ __forceinline__ void gemm_phase(PG8_LAS unsigned char* lds, const Gemm g, const Sched& S, const Epi& E) {
    int tid_ = threadIdx.x; asm volatile("" : "+v"(tid_));
    const int tid = tid_, wid = __builtin_amdgcn_readfirstlane(tid >> 6), lane = tid & 63, wr = wid >> 2, wc = wid & 3, fr = lane & 15, fq = lane >> 4;
    int K_ = g.K; asm volatile("" : "+s"(K_));
    const int K = K_, nt = K / BK;
    unsigned voffA[2], voffB[2];
#pragma unroll
    for (int i = 0; i < 2; ++i) { int R, C; stage_rc(tid * 16 + i * 8192, R, C); const int Rb = Epi::PERM ? ((R & ~31) + perm32(R & 31)) : R;
        voffA[i] = (unsigned)(R * K + C) * 2u; voffB[i] = (unsigned)(Rb * K + C) * 2u; }
    const size_t kstep = (size_t)(BK * 2);
    const size_t hstep = (size_t)HALF * K * 2;
    const size_t tstep = 2 * hstep;
    const unsigned ldsw = (unsigned)wid * 1024u;
    const int aoff = lds_byte(wr * 64 + fr, fq * 8), boff = lds_byte(wc * 32 + fr, fq * 8);
#define PG8_SA(b, h) (((b) * 2 + (h)) * HTB)
#define PG8_SB(b, h) ((4 + (b) * 2 + (h)) * HTB)
#define PG8_STAGE(bufoff, gbase, voff) do { _Pragma("unroll") for (int _i = 0; _i < 2; ++_i) \
        __builtin_amdgcn_global_load_lds((const unsigned*)((const char*)(gbase) + (voff)[_i]), (PG8_LAS unsigned*)(lds + (bufoff) + ldsw + _i * 8192), 16, 0, 0); } while (0)
#define PG8_LDA(dst, b, h) do { _Pragma("unroll") for (int m = 0; m < 4; ++m) _Pragma("unroll") for (int k = 0; k < 2; ++k) dst[m][k] = *(const PG8_LAS bf16x8*)(lds + PG8_SA(b, h) + aoff + m * 2048 + k * 1024); } while (0)
#define PG8_LDB(dst, b, h) do { _Pragma("unroll") for (int n = 0; n < 2; ++n) _Pragma("unroll") for (int k = 0; k < 2; ++k) dst[n][k] = *(const PG8_LAS bf16x8*)(lds + PG8_SB(b, h) + boff + n * 2048 + k * 1024); } while (0)
#define PG8_MMA(ai, bj, At, Bt) do { __builtin_amdgcn_s_setprio(1); _Pragma("unroll") for (int m = 0; m < 4; ++m) _Pragma("unroll") for (int n = 0; n < 2; ++n) _Pragma("unroll") for (int k = 0; k < 2; ++k) \
        acc[ai][bj][m][n] = __builtin_amdgcn_mfma_f32_16x16x32_bf16(Bt[n][k], At[m][k], acc[ai][bj][m][n], 0, 0, 0); __builtin_amdgcn_s_setprio(0); } while (0)
#define PG8_WAIT_V(n) asm volatile("s_waitcnt vmcnt(" #n ")" ::: "memory")
#define PG8_WAIT_L(n) asm volatile("s_waitcnt lgkmcnt(" #n ")" ::: "memory")
#define PG8_BAR __builtin_amdgcn_s_barrier()
#define PG8_SCHED __builtin_amdgcn_sched_barrier(0)
    Unit cur, nxt; int ui = 0;
    if (!S.next(0, cur)) return;
    f32x4 acc[2][2][4][2];
#pragma unroll
    for (int a = 0; a < 2; ++a)
#pragma unroll
        for (int b = 0; b < 2; ++b)
#pragma unroll
            for (int m = 0; m < 4; ++m)
#pragma unroll
                for (int n = 0; n < 2; ++n) acc[a][b][m][n] = (f32x4){0.f, 0.f, 0.f, 0.f};
    bf16x8 At[4][2], B0[2][2], B1[2][2];
    const char* cA = (const char*)g.A + (size_t)cur.pm * tstep; const char* cB = (const char*)g.Bt + (size_t)cur.pn * tstep;
    S.a_ready(cur);
    if constexpr (SP2) {
        PG8_STAGE(PG8_SB(0, 0), cB, voffB); PG8_STAGE(PG8_SB(0, 1), cB + hstep, voffB); PG8_STAGE(PG8_SA(0, 0), cA, voffA); PG8_STAGE(PG8_SA(0, 1), cA + hstep, voffA);
        if (wr == 1) PG8_BAR;
        PG8_WAIT_V(2); PG8_BAR;
        PG8_STAGE(PG8_SB(1, 0), cB + kstep, voffB); PG8_STAGE(PG8_SA(1, 0), cA + kstep, voffA); PG8_STAGE(PG8_SB(1, 1), cB + hstep + kstep, voffB);
        PG8_WAIT_V(6); PG8_BAR;
    } else {
        PG8_STAGE(PG8_SB(0, 0), cB, voffB); PG8_STAGE(PG8_SA(0, 0), cA, voffA); PG8_STAGE(PG8_SB(0, 1), cB + hstep, voffB); PG8_STAGE(PG8_SA(0, 1), cA + hstep, voffA);
        if (wr == 1) PG8_BAR;
        PG8_WAIT_V(4); PG8_BAR;
        PG8_STAGE(PG8_SB(1, 0), cB + kstep, voffB); PG8_STAGE(PG8_SA(1, 0), cA + kstep, voffA); PG8_STAGE(PG8_SB(1, 1), cB + hstep + kstep, voffB);
        PG8_WAIT_V(6); PG8_BAR;
    }
    for (;;) {
        const bool has_next = S.next(ui + 1, nxt);
        const char* nA = has_next ? (const char*)g.A + (size_t)nxt.pm * tstep : cA; const char* nB = has_next ? (const char*)g.Bt + (size_t)nxt.pn * tstep : cB;
        for (int t = 0; t < nt; t += 2) {
            const bool last = (t == nt - 2);
            const char* a1 = cA + (size_t)(t + 1) * kstep;
            const char* a2 = last ? nA : cA + (size_t)(t + 2) * kstep; const char* b2 = last ? nB : cB + (size_t)(t + 2) * kstep;
            const char* a3 = a2 + kstep; const char* b3 = b2 + kstep;
            if (last && has_next) S.a_ready(nxt);
            if constexpr (SP2) {
            PG8_LDB(B0, 0, 0); PG8_LDB(B1, 0, 1); PG8_SCHED; PG8_LDA(At, 0, 0); PG8_STAGE(PG8_SA(1, 1), a1 + hstep, voffA);
            PG8_WAIT_V(8); PG8_WAIT_L(0); PG8_BAR; PG8_MMA(0, 0, At, B0); PG8_MMA(0, 1, At, B1); PG8_BAR; PG8_SCHED;
            PG8_LDA(At, 0, 1); PG8_STAGE(PG8_SB(0, 0), b2, voffB); PG8_STAGE(PG8_SB(0, 1), b2 + hstep, voffB); PG8_STAGE(PG8_SA(0, 0), a2, voffA);
            PG8_WAIT_V(8); PG8_WAIT_L(0); PG8_BAR; PG8_MMA(1, 0, At, B0); PG8_MMA(1, 1, At, B1); PG8_BAR; PG8_SCHED;
            PG8_LDB(B0, 1, 0); PG8_LDB(B1, 1, 1); PG8_SCHED; PG8_LDA(At, 1, 0); PG8_STAGE(PG8_SA(0, 1), a2 + hstep, voffA);
            PG8_WAIT_V(8); PG8_WAIT_L(0); PG8_BAR; PG8_MMA(0, 0, At, B0); PG8_MMA(0, 1, At, B1); PG8_BAR; PG8_SCHED;
            PG8_LDA(At, 1, 1); PG8_STAGE(PG8_SB(1, 0), b3, voffB); PG8_STAGE(PG8_SB(1, 1), b3 + hstep, voffB); PG8_STAGE(PG8_SA(1, 0), a3, voffA);
            PG8_WAIT_V(8); PG8_WAIT_L(0); PG8_BAR; PG8_MMA(1, 0, At, B0); PG8_MMA(1, 1, At, B1); PG8_BAR; PG8_SCHED;
            } else {
            PG8_LDB(B0, 0, 0); PG8_SCHED; PG8_LDA(At, 0, 0); PG8_STAGE(PG8_SA(1, 1), a1 + hstep, voffA);
            PG8_WAIT_L(8); PG8_BAR; PG8_WAIT_L(0); PG8_MMA(0, 0, At, B0); PG8_BAR; PG8_SCHED;
            PG8_LDB(B1, 0, 1); PG8_STAGE(PG8_SB(0, 0), b2, voffB);
            PG8_BAR; PG8_WAIT_L(0); PG8_MMA(0, 1, At, B1); PG8_BAR;
            PG8_LDA(At, 0, 1); PG8_STAGE(PG8_SA(0, 0), a2, voffA);
            PG8_BAR; PG8_WAIT_L(0); PG8_MMA(1, 0, At, B0); PG8_BAR; PG8_SCHED;
            PG8_STAGE(PG8_SB(0, 1), b2 + hstep, voffB);
            PG8_WAIT_V(6); PG8_BAR; PG8_MMA(1, 1, At, B1); PG8_BAR;
            PG8_LDB(B0, 1, 0); PG8_SCHED; PG8_LDA(At, 1, 0); PG8_STAGE(PG8_SA(0, 1), a2 + hstep, voffA);
            PG8_WAIT_L(8); PG8_BAR; PG8_WAIT_L(0); PG8_MMA(0, 0, At, B0); PG8_BAR; PG8_SCHED;
            PG8_LDB(B1, 1, 1); PG8_STAGE(PG8_SB(1, 0), b3, voffB);
            PG8_BAR; PG8_WAIT_L(0); PG8_MMA(0, 1, At, B1); PG8_BAR;
            PG8_LDA(At, 1, 1); PG8_STAGE(PG8_SA(1, 0), a3, voffA);
            PG8_BAR; PG8_WAIT_L(0); PG8_MMA(1, 0, At, B0); PG8_BAR; PG8_SCHED;
            PG8_STAGE(PG8_SB(1, 1), b3 + hstep, voffB);
            PG8_WAIT_V(6); PG8_BAR; PG8_MMA(1, 1, At, B1); PG8_BAR;
            }
        }
        if constexpr (ALIGN_EPI) { if (wr == 0) PG8_BAR; }
        if constexpr (!Epi::AFTER_DRAIN) { E(acc, cur, wr, wc, fr, fq); S.done(cur); }
        if (!has_next) break;
#pragma unroll
        for (int a = 0; a < 2; ++a)
#pragma unroll
            for (int b = 0; b < 2; ++b)
#pragma unroll
                for (int m = 0; m < 4; ++m)
#pragma unroll
                    for (int n = 0; n < 2; ++n) acc[a][b][m][n] = (f32x4){0.f, 0.f, 0.f, 0.f};
        cur = nxt; cA = nA; cB = nB; ++ui;
        if constexpr (ALIGN_EPI) { if (wr == 1) PG8_BAR; }
    }
    PG8_WAIT_V(0);
    if constexpr (!ALIGN_EPI) { if (wr == 0) PG8_BAR; }
    PG8_BAR;
    if constexpr (Epi::AFTER_DRAIN) { E.fused(acc, cur, wr, wc, fr, fq, lds, wid, lane); S.done(cur); }
#undef PG8_SA
#undef PG8_SB
#undef PG8_STAGE
#undef PG8_LDA
#undef PG8_LDB
#undef PG8_MMA
#undef PG8_WAIT_V
#undef PG8_WAIT_L
#undef PG8_BAR
#undef PG8_SCHED
}
}
#define LAS __attribute__((address_space(3)))
typedef unsigned short bf16;
typedef unsigned v4u __attribute__((ext_vector_type(4)));
typedef unsigned v2u __attribute__((ext_vector_type(2)));
typedef float v2f __attribute__((ext_vector_type(2)));
typedef float f32x4 __attribute__((ext_vector_type(4)));
typedef float f32x16 __attribute__((ext_vector_type(16)));
typedef short bf16x8 __attribute__((ext_vector_type(8)));
typedef short s16x4 __attribute__((ext_vector_type(4)));
constexpr int MTOK = 32768, DMOD = 2048, NZ = 5632, PLE = 256, NCHUNK = MTOK / 128;
constexpr int ZQ = 0, ZK = 1024, ZV = 1280, ZGA = 1536, ZCB = 2560, ZCC = 3072, ZCX = 3584, ZGC = 4096, ZXL = 4608, ZGL = 5120;
constexpr float LOG2E = 1.4426950408889634f;
constexpr int NWAVES = 8, NTHR = 512;
constexpr int LDS_BYTES = 163840;
constexpr size_t MiB = 1u << 20;
constexpr size_t WS_SSQ = 0;
constexpr size_t WS_AGG = 1 * MiB;
constexpr size_t WS_WL = 3 * MiB;
constexpr size_t WS_WPROJ = 4 * MiB;
constexpr size_t WS_CTL = 6 * MiB, CTL_BYTES = 16384;
constexpr size_t WS_WIN = 8 * MiB;
constexpr size_t WS_WOUT = 52 * MiB;
constexpr size_t WS_WGATE = 68 * MiB;
constexpr size_t WS_PB = 84 * MiB;
constexpr size_t WS_HBA = 116 * MiB;
constexpr size_t WS_HBB = 244 * MiB;
constexpr size_t WS_MIX = 372 * MiB;
constexpr size_t WS_PP = 500 * MiB;
constexpr size_t WS_Z = 628 * MiB;
constexpr size_t WS_END = 980 * MiB;

struct Params {
    const float *x_prompt, *x_sample, *p_prompt, *p_sample, *norm_mix, *w_in, *w_out, *rel_bias, *attn_sink, *conv_w, *lru_conv_w, *lru_conv_b,
                *lru_w_a, *lru_b_a, *lru_w_i, *lru_b_i, *lru_L, *ple_norm, *ple_w_gate, *ple_w_proj, *final_norm;
    float* out; unsigned char* ws;
};

__device__ __forceinline__ unsigned f2bf(float f) { unsigned u = __builtin_bit_cast(unsigned, f); return (u + 0x7fffu + ((u >> 16) & 1u)) >> 16; }
__device__ __forceinline__ unsigned pk2(float lo, float hi) { unsigned r; asm("v_cvt_pk_bf16_f32 %0, %1, %2" : "=v"(r) : "v"(lo), "v"(hi)); return r; }
__device__ __forceinline__ float bflo(unsigned w) { return __builtin_bit_cast(float, w << 16); }
__device__ __forceinline__ float bfhi(unsigned w) { return __builtin_bit_cast(float, w & 0xffff0000u); }
__device__ __forceinline__ float bf1(bf16 v) { return __builtin_bit_cast(float, (unsigned)v << 16); }
__device__ __forceinline__ float sigm(float x) { return __builtin_amdgcn_rcpf(1.f + __expf(-x)); }
__device__ __forceinline__ float silu(float x) { return x * sigm(x); }
__device__ __forceinline__ float wave_sum(float v) {
#pragma unroll
    for (int o = 1; o < 64; o <<= 1) v += __shfl_xor(v, o);
    return v;
}
__device__ __forceinline__ void seq_of_chunk(int c, int& s0, int& ns) { if (c < 128) { s0 = c & ~63; ns = 64; } else { s0 = c & ~15; ns = 16; } }

struct TrDesc { const float* W; bf16* WT; const float* ks; int K, N, k0, n0; };
__device__ __forceinline__ void tr_load(const TrDesc& d, int lane, f32x4 (&v)[16]) {
    const float* p = d.W + (size_t)(d.k0 + (lane >> 4)) * d.N + d.n0 + 4 * (lane & 15);
#pragma unroll
    for (int i = 0; i < 16; ++i) v[i] = *(const f32x4*)(p + (size_t)(4 * i) * d.N);
}
__device__ __forceinline__ void tr_store(const TrDesc& d, int lane, const f32x4 (&v)[16], LAS float* scr) {
#pragma unroll
    for (int i = 0; i < 16; ++i) { const int kk = 4 * i + (lane >> 4); const float sc = d.ks ? d.ks[d.k0 + kk] : 1.f; LAS float* q = scr + kk * 65 + 4 * (lane & 15);
        q[0] = v[i][0] * sc; q[1] = v[i][1] * sc; q[2] = v[i][2] * sc; q[3] = v[i][3] * sc; }
    asm volatile("s_waitcnt lgkmcnt(0)" ::: "memory");
    const int c = lane & 7;
#pragma unroll
    for (int j = 0; j < 8; ++j) { const int n = (lane >> 3) + 8 * j; const LAS float* s = scr + (8 * c) * 65 + n;
        v4u o; o.x = pk2(s[0 * 65], s[1 * 65]); o.y = pk2(s[2 * 65], s[3 * 65]); o.z = pk2(s[4 * 65], s[5 * 65]); o.w = pk2(s[6 * 65], s[7 * 65]);
        *(v4u*)(d.WT + (size_t)(d.n0 + n) * d.K + d.k0 + 8 * c) = o; }
    asm volatile("s_waitcnt lgkmcnt(0)" ::: "memory");
}
constexpr int TI_IN = (DMOD / 64) * (NZ / 64), TI_SQ = (DMOD / 64) * (DMOD / 64), TI_PR = (PLE / 64) * (DMOD / 64), TI_L1 = 4, TI_L = 16 * TI_L1;
constexpr int TI_LAYER = TI_IN + 2 * TI_SQ + TI_PR + TI_L;
constexpr int TI_EARLY = TI_IN + TI_L, TI_LATE0 = 2 * TI_SQ + TI_PR, TI_LATE = TI_LATE0 + TI_LAYER;
__device__ __forceinline__ TrDesc tr_decode(const Params& P, int late, int it) {
    unsigned char* ws = P.ws; TrDesc d; int l, r;
    if (!late) { l = 0; r = it < TI_IN ? it : it + 2 * TI_SQ + TI_PR; }
    else if (it < TI_LATE0) { l = 0; r = TI_IN + it; }
    else { l = 1; r = it - TI_LATE0; }
    if (r < TI_IN) { d.W = P.w_in + (size_t)l * DMOD * NZ; d.K = DMOD; d.N = NZ; d.WT = (bf16*)(ws + WS_WIN) + (size_t)l * NZ * DMOD; d.ks = P.norm_mix + l * DMOD; }
    else if ((r -= TI_IN) < TI_SQ) { d.W = P.w_out + (size_t)l * DMOD * DMOD; d.K = DMOD; d.N = DMOD; d.WT = (bf16*)(ws + WS_WOUT) + (size_t)l * DMOD * DMOD; d.ks = nullptr; }
    else if ((r -= TI_SQ) < TI_SQ) { d.W = P.ple_w_gate + (size_t)l * DMOD * DMOD; d.K = DMOD; d.N = DMOD; d.WT = (bf16*)(ws + WS_WGATE) + (size_t)l * DMOD * DMOD; d.ks = P.ple_norm + l * DMOD; }
    else if ((r -= TI_SQ) < TI_PR) { d.W = P.ple_w_proj + (size_t)l * PLE * DMOD; d.K = PLE; d.N = DMOD; d.WT = (bf16*)(ws + WS_WPROJ) + (size_t)l * DMOD * PLE; d.ks = nullptr; }
    else { r -= TI_PR; const int mat = r / TI_L1; r = r % TI_L1;
        const int dir = mat >> 3, which = (mat >> 2) & 1, h = mat & 3;
        d.W = (which ? P.lru_w_i : P.lru_w_a) + ((size_t)((l * 2 + dir) * 4 + h)) * 128 * 128; d.K = 128; d.N = 128;
        d.WT = (bf16*)(ws + WS_WL) + ((size_t)(((l * 2 + dir) * 2 + which) * 4 + h)) * 128 * 128; d.ks = nullptr; }
    const int nblk = d.N / 64; d.k0 = 64 * (r / nblk); d.n0 = 64 * (r % nblk);
    return d;
}

__device__ __forceinline__ void tr_run(const Params& P, LAS unsigned char* lds, int tid, int G, int late, int nitems) {
    asm volatile("" : "+v"(tid));
    const int lane = tid & 63, wave = tid >> 6, gw = blockIdx.x * NWAVES + wave, NGW = G * NWAVES;
    LAS float* scr = (LAS float*)(lds + wave * 16640);
    int it = gw; TrDesc d; f32x4 va[16];
    if (it < nitems) { d = tr_decode(P, late, it); tr_load(d, lane, va); }
    while (it < nitems) {
        const int nx = it + NGW; TrDesc dn = d; f32x4 vb[16];
        if (nx < nitems) { dn = tr_decode(P, late, nx); tr_load(dn, lane, vb); }
        tr_store(d, lane, va, scr);
        it = nx; d = dn;
#pragma unroll
        for (int i = 0; i < 16; ++i) va[i] = vb[i];
    }
}

__device__ __forceinline__ void p0_prologue(const Params& P, LAS unsigned char* lds, int tid, int G) {
    asm volatile("" : "+v"(tid));
    const int lane = tid & 63, wave = tid >> 6;
    const int gw = blockIdx.x * NWAVES + wave, NGW = G * NWAVES;
    const long gt = (long)blockIdx.x * NTHR + tid, NGT = (long)G * NTHR;
    unsigned char* ws = P.ws;
    { float* ssq = (float*)(ws + WS_SSQ); for (long i = gt; i < 4L * MTOK; i += NGT) ssq[MTOK + i] = 0.f; }
    tr_run(P, lds, tid, G, 0, TI_EARLY);
    { bf16* hbA = (bf16*)(ws + WS_HBA); float* ssq = (float*)(ws + WS_SSQ);
      for (int row = gw; row < MTOK; row += NGW) {
          const float* xr = (row < 16384 ? P.x_prompt + (size_t)row * DMOD : P.x_sample + (size_t)(row - 16384) * DMOD);
          float s = 0.f;
#pragma unroll
          for (int j = 0; j < 8; ++j) { const f32x4 v = *(const f32x4*)(xr + 4 * lane + 256 * j); s += v[0] * v[0] + v[1] * v[1] + v[2] * v[2] + v[3] * v[3];
              v2u o; o.x = pk2(v[0], v[1]); o.y = pk2(v[2], v[3]); *(v2u*)(hbA + (size_t)row * DMOD + 4 * lane + 256 * j) = o; }
          s = wave_sum(s); if (lane == 0) ssq[row] = s; } }
}

__device__ __forceinline__ void pb_convert(const Params& P, int tid, int G) {
    asm volatile("" : "+v"(tid));
    const long gt = (long)blockIdx.x * NTHR + tid, NGT = (long)G * NTHR;
    unsigned char* ws = P.ws;
    { bf16* pb = (bf16*)(ws + WS_PB);
      for (long i = gt; i < 2L * MTOK * PLE / 4; i += NGT) { const long e = i * 4; const int l = (int)(e / ((long)MTOK * PLE)); const long r = e % ((long)MTOK * PLE);
          const float* src = (r < 16384L * PLE) ? P.p_prompt + (size_t)l * 16384 * PLE + r : P.p_sample + (size_t)l * 16384 * PLE + (r - 16384L * PLE);
          const f32x4 v = *(const f32x4*)src; v2u o; o.x = pk2(v[0], v[1]); o.y = pk2(v[2], v[3]); *(v2u*)(pb + e) = o; } }
}

__device__ __forceinline__ int t5_bucket(int rel) {
    const int n = rel < 0 ? -rel : rel;
    int b = n < 8 ? n : 8 + (n >= 12) + (n >= 16) + (n >= 23) + (n >= 32) + (n >= 46) + (n >= 64) + (n >= 91);
    return b + (rel > 0 ? 16 : 0);
}
constexpr float AT_SHIFT = 40.f;
constexpr int AT_KP = 272, AT_VP = 320, AT_KB = 64 * AT_KP, AT_VB = 64 * AT_VP, AT_V0 = 2 * AT_KB, AT_TAB = AT_V0 + 2 * AT_VB, AT_TW = 384;

__device__ __forceinline__ void attn_build_tab(LAS unsigned char* lds, const float* rel_bias, int tid) {
    asm volatile("" : "+v"(tid));
    LAS float* tab = (LAS float*)(lds + AT_TAB);
    for (int i = tid; i < 8 * AT_TW; i += NTHR) { const int hd = i / AT_TW, rel = i % AT_TW - 192;
        tab[i] = (rel >= -128 && rel <= 128) ? rel_bias[t5_bucket(rel) * 8 + hd] * LOG2E - AT_SHIFT : -1.0e30f; }
}

template <int VAR>
__device__ __forceinline__ void attn_item(LAS unsigned char* lds, int item, const bf16* z, bf16* mix, const float* sink, int tid) {
    asm volatile("" : "+v"(tid));
    const int c = item >> 2, kvh = (item >> 1) & 1, qhalf = item & 1;
    int s0, ns; seq_of_chunk(c, s0, ns);
    const int w = tid >> 6, lane = tid & 63, ql = lane & 31, h = lane >> 5;
    const int head = kvh * 4 + (w >> 1);
    const int tb = c * 128, tq = tb + qhalf * 64 + (w & 1) * 32 + ql;
    const int seq_lo = s0 * 128, seq_hi = (s0 + ns) * 128, kwin0 = tb - 128 + qhalf * 64;
    int j_lo = 0, j_hi = 4;
    while (kwin0 + 64 * j_lo < seq_lo) ++j_lo;
    while (kwin0 + 64 * j_hi + 64 > seq_hi) --j_hi;
    v4u stg[4];
    const int pkey = tid >> 4, pc = tid & 15;
    auto prefetch = [&](int j) {
        const bf16* base = z + (size_t)(kwin0 + 64 * j + pkey) * NZ + kvh * 128 + pc * 8;
        stg[0] = *(const v4u*)(base + ZK); stg[1] = *(const v4u*)(base + ZK + (size_t)32 * NZ);
        stg[2] = *(const v4u*)(base + ZV); stg[3] = *(const v4u*)(base + ZV + (size_t)32 * NZ);
    };
    if (VAR != 1) prefetch(j_lo);
    bf16x8 qf[8];
    {
      const int erow_ = lane >> 4, ech_ = lane & 15, tq0_ = tb + qhalf * 64 + (w & 1) * 32; LAS unsigned char* qst = lds + (AT_TAB + 8 * AT_TW * 4) + w * (32 * 272);
      v4u qv[8];
#pragma unroll
      for (int i = 0; i < 8; ++i) qv[i] = *(const v4u*)(z + (size_t)(tq0_ + 4 * i + erow_) * NZ + ZQ + head * 128 + ech_ * 8);
#pragma unroll
      for (int i = 0; i < 8; ++i) *(LAS v4u*)(qst + (4 * i + erow_) * 272 + ech_ * 16) = qv[i];
#pragma unroll
      for (int ks = 0; ks < 8; ++ks) qf[ks] = *(const LAS bf16x8*)(qst + ql * 272 + (16 * ks + 8 * h) * 2); }
    float lsum = (h == 0) ? __builtin_amdgcn_exp2f(sink[head] * LOG2E - AT_SHIFT) : 0.f;
    f32x16 O[4];
#pragma unroll
    for (int dt = 0; dt < 4; ++dt)
#pragma unroll
        for (int i = 0; i < 16; ++i) O[dt][i] = 0.f;
    const LAS float* tabh = (const LAS float*)(lds + AT_TAB) + head * AT_TW;
    const float c1 = 0.08838834764831845f * LOG2E;
    const int g4 = lane >> 4, q4 = (lane & 15) >> 2, p4 = lane & 3;
    const int tq0g = tb + qhalf * 64 + (w & 1) * 32;
    v4u gv[8];
    for (int j = j_lo; j <= j_hi; ++j) {
        LAS unsigned char* Kb = lds + (j & 1) * AT_KB; LAS unsigned char* Vb = lds + AT_V0 + (j & 1) * AT_VB;
        if (VAR != 1) {
        *(LAS v4u*)(Kb + pkey * AT_KP + pc * 16) = stg[0]; *(LAS v4u*)(Kb + (pkey + 32) * AT_KP + pc * 16) = stg[1];
        *(LAS v4u*)(Vb + pkey * AT_VP + pc * 16) = stg[2]; *(LAS v4u*)(Vb + (pkey + 32) * AT_VP + pc * 16) = stg[3];
        if (j < j_hi) prefetch(j + 1);
        }
        __syncthreads();
        if (j == j_hi) {
#pragma unroll
            for (int i = 0; i < 8; ++i) gv[i] = *(const v4u*)(z + (size_t)(tq0g + 4 * i + (lane >> 4)) * NZ + ZGA + head * 128 + (lane & 15) * 8);
        }
        f32x16 s[2];
#pragma unroll
        for (int kt = 0; kt < 2; ++kt) {
#pragma unroll
            for (int i = 0; i < 16; ++i) s[kt][i] = 0.f;
#pragma unroll
            for (int ks = 0; ks < 8; ++ks) { const bf16x8 kf = *(const LAS bf16x8*)(Kb + (kt * 32 + ql) * AT_KP + (16 * ks + 8 * h) * 2);
                s[kt] = __builtin_amdgcn_mfma_f32_32x32x16_bf16(kf, qf[ks], s[kt], 0, 0, 0); }
        }
        float ps = 0.f;
#pragma unroll
        for (int kt = 0; kt < 2; ++kt) { const LAS float* tp = tabh + ((kwin0 + 64 * j + 32 * kt + 4 * h) - tq + 192);
#pragma unroll
            for (int i = 0; i < 16; ++i) { float p; asm("v_exp_f32_e64 %0, %1 clamp" : "=v"(p) : "v"(s[kt][i] * c1 + tp[(i & 3) + 8 * (i >> 2)])); s[kt][i] = p; ps += p; } }
        lsum += ps;
#pragma unroll
        for (int kt = 0; kt < 2; ++kt)
#pragma unroll
            for (int s2 = 0; s2 < 2; ++s2) {
                v4u pw; pw.x = pk2(s[kt][8 * s2 + 0], s[kt][8 * s2 + 1]); pw.y = pk2(s[kt][8 * s2 + 2], s[kt][8 * s2 + 3]);
                pw.z = pk2(s[kt][8 * s2 + 4], s[kt][8 * s2 + 5]); pw.w = pk2(s[kt][8 * s2 + 6], s[kt][8 * s2 + 7]);
                const bf16x8 pf = __builtin_bit_cast(bf16x8, pw);
                const LAS unsigned char* vrow = Vb + (32 * kt + 16 * s2 + 4 * h + q4) * AT_VP + (16 * (g4 & 1) + 4 * p4) * 2;
#pragma unroll
                for (int dt = 0; dt < 4; ++dt) {
                    const s16x4 lo = __builtin_amdgcn_ds_read_tr16_b64_v4i16((LAS s16x4*)(vrow + dt * 64));
                    const s16x4 hi = __builtin_amdgcn_ds_read_tr16_b64_v4i16((LAS s16x4*)(vrow + dt * 64 + 8 * AT_VP));
                    const bf16x8 vf = __builtin_shufflevector(lo, hi, 0, 1, 2, 3, 4, 5, 6, 7);
                    O[dt] = __builtin_amdgcn_mfma_f32_32x32x16_bf16(vf, pf, O[dt], 0, 0, 0);
                }
            }
    }
    const float ltot = lsum + __shfl_xor(lsum, 32), inv = 1.f / ltot;
    const int erow = lane >> 4, ech = lane & 15, tq0 = tb + qhalf * 64 + (w & 1) * 32;
    __syncthreads();
    LAS unsigned char* ost = lds + (AT_TAB + 8 * AT_TW * 4) + w * (32 * 272);
#pragma unroll
    for (int dt = 0; dt < 4; ++dt)
#pragma unroll
        for (int rg = 0; rg < 4; ++rg) { v2u ow; ow.x = pk2(O[dt][4 * rg + 0] * inv, O[dt][4 * rg + 1] * inv); ow.y = pk2(O[dt][4 * rg + 2] * inv, O[dt][4 * rg + 3] * inv);
            *(LAS v2u*)(ost + ql * 272 + (32 * dt + 8 * rg + 4 * h) * 2) = ow; }
    if (VAR != 3) {
#pragma unroll
        for (int i = 0; i < 8; ++i) { const v4u ov = *(const LAS v4u*)(ost + (4 * i + erow) * 272 + ech * 16); const v4u g = gv[i];
            v4u r; r.x = pk2(bflo(ov.x) * silu(bflo(g.x)), bfhi(ov.x) * silu(bfhi(g.x))); r.y = pk2(bflo(ov.y) * silu(bflo(g.y)), bfhi(ov.y) * silu(bfhi(g.y)));
            r.z = pk2(bflo(ov.z) * silu(bflo(g.z)), bfhi(ov.z) * silu(bfhi(g.z))); r.w = pk2(bflo(ov.w) * silu(bflo(g.w)), bfhi(ov.w) * silu(bfhi(g.w)));
            *(v4u*)(mix + (size_t)(tq0 + 4 * i + erow) * DMOD + head * 128 + ech * 8) = r; }
    }
}

__device__ __forceinline__ void conv_phase(const bf16* z, bf16* mix, const float* cw  , int G, int tid) {
    asm volatile("" : "+v"(tid));
    const long NW = (long)MTOK * 64;
#pragma unroll 2
    for (long i = (long)blockIdx.x * NTHR + tid; i < NW; i += (long)G * NTHR) {
        const int t = (int)(i >> 6), cg8 = (int)(i & 63) * 8;
        int s0, ns; seq_of_chunk(t >> 7, s0, ns);
        const bool hasp = t > s0 * 128, hasn = t + 1 < (s0 + ns) * 128;
        const bf16* zr = z + (size_t)t * NZ;
        const v4u cb = *(const v4u*)(zr + ZCB + cg8), gc = *(const v4u*)(zr + ZGC + cg8);
        const v4u c1 = *(const v4u*)(zr + ZCC + cg8), x1 = *(const v4u*)(zr + ZCX + cg8);
        v4u c0 = {0, 0, 0, 0}, x0 = {0, 0, 0, 0}, c2 = {0, 0, 0, 0}, x2 = {0, 0, 0, 0};
        if (hasp) { c0 = *(const v4u*)(zr - NZ + ZCC + cg8); x0 = *(const v4u*)(zr - NZ + ZCX + cg8); }
        if (hasn) { c2 = *(const v4u*)(zr + NZ + ZCC + cg8); x2 = *(const v4u*)(zr + NZ + ZCX + cg8); }
        float o[8];
#pragma unroll
        for (int e = 0; e < 4; ++e) {
#pragma unroll
            for (int hh = 0; hh < 2; ++hh) { const int ch = cg8 + 2 * e + hh;
                const float a0 = hh ? bfhi(c0[e]) * bfhi(x0[e]) : bflo(c0[e]) * bflo(x0[e]);
                const float a1 = hh ? bfhi(c1[e]) * bfhi(x1[e]) : bflo(c1[e]) * bflo(x1[e]);
                const float a2 = hh ? bfhi(c2[e]) * bfhi(x2[e]) : bflo(c2[e]) * bflo(x2[e]);
                const float cv = cw[ch] * a0 + cw[512 + ch] * a1 + cw[1024 + ch] * a2;
                const float b = hh ? bfhi(cb[e]) : bflo(cb[e]), g = hh ? bfhi(gc[e]) : bflo(gc[e]);
                o[2 * e + hh] = b * cv * silu(g); } }
        v4u ow; ow.x = pk2(o[0], o[1]); ow.y = pk2(o[2], o[3]); ow.z = pk2(o[4], o[5]); ow.w = pk2(o[6], o[7]);
        *(v4u*)(mix + (size_t)t * DMOD + 1024 + cg8) = ow;
    }
}

constexpr int LR_XC = 0, LR_XCP = 272, LR_PB = 128 * LR_XCP, LR_Y = 2 * 128 * LR_XCP, LR_YP = 132;
struct LruLayer { const float *cw, *cb, *ba, *bi, *L; const bf16* WL; };
template <int DIR>
__device__ __forceinline__ void lru_load(v4u (&xr)[7], const bf16* z, int tb, int hh, int seq_lo, int seq_hi, int tid) {
    const int pc = tid & 15, base = tb + 4 * (tid >> 4) + (DIR ? 0 : -3);
#pragma unroll
    for (int k = 0; k < 7; ++k) { const int tok = base + k; const int tc = tok < seq_lo ? seq_lo : (tok >= seq_hi ? seq_hi - 1 : tok);
        xr[k] = *(const v4u*)(z + (size_t)tc * NZ + ZXL + hh * 128 + pc * 8); }
}
template <int DIR>
__device__ __forceinline__ void lru_dir(LAS unsigned char* lds, const bf16* z, const LruLayer& LP, float* agg, bf16* PFB, int c, int hh, int seq_lo, int seq_hi, int tid,
                                        v4u (&xr)[7], v4u (&xnx)[7], bool pf, int pf_tb, int pf_hh, int pf_lo, int pf_hi) {
    const int w = tid >> 6, lane = tid & 63, tb = c * 128;
    const int chl = 16 * w + (lane & 15), chg = hh * 128 + chl, q = lane >> 4;
    LAS float* Y = (LAS float*)(lds + LR_Y);
    const float nba = -LOG2E * LP.ba[DIR * 512 + chg], nbi = -LOG2E * LP.bi[DIR * 512 + chg];
    const float c8 = -8.f * LOG2E * log1pf(__expf(-LP.L[DIR * 512 + chg]));
    bf16x8 bA[4], bI[4];
    { const bf16* wa = LP.WL + ((size_t)((DIR * 2 + 0) * 4 + hh)) * 16384 + (size_t)chl * 128 + 8 * q;
      const bf16* wi = LP.WL + ((size_t)((DIR * 2 + 1) * 4 + hh)) * 16384 + (size_t)chl * 128 + 8 * q;
#pragma unroll
      for (int ks = 0; ks < 4; ++ks) { bA[ks] = *(const bf16x8*)(wa + 32 * ks); bI[ks] = *(const bf16x8*)(wi + 32 * ks); } }
    { const int pc = tid & 15, tg = tid >> 4;
      const float* cb = LP.cb + DIR * 512 + hh * 128 + pc * 8; const f32x4 c0 = *(const f32x4*)cb, c1 = *(const f32x4*)(cb + 4);
      f32x4 w0[4], w1[4];
#pragma unroll
      for (int k = 0; k < 4; ++k) { const float* wk = LP.cw + (DIR * 4 + k) * 512 + hh * 128 + pc * 8; w0[k] = *(const f32x4*)wk; w1[k] = *(const f32x4*)(wk + 4); }
      const int base = tb + 4 * tg + (DIR ? 0 : -3);
#pragma unroll
      for (int i = 0; i < 4; ++i) { f32x4 a0 = c0, a1 = c1; const int t = 4 * tg + i;
#pragma unroll
          for (int k = 0; k < 4; ++k) { const int tok = base + i + k; const bool ok = tok >= seq_lo && tok < seq_hi; v4u xv = xr[i + k];
              if (!ok) xv = (v4u){0u, 0u, 0u, 0u};
              a0[0] += w0[k][0] * bflo(xv[0]); a0[1] += w0[k][1] * bfhi(xv[0]); a0[2] += w0[k][2] * bflo(xv[1]); a0[3] += w0[k][3] * bfhi(xv[1]);
              a1[0] += w1[k][0] * bflo(xv[2]); a1[1] += w1[k][1] * bfhi(xv[2]); a1[2] += w1[k][2] * bflo(xv[3]); a1[3] += w1[k][3] * bfhi(xv[3]); }
          v4u o; o.x = pk2(a0[0], a0[1]); o.y = pk2(a0[2], a0[3]); o.z = pk2(a1[0], a1[1]); o.w = pk2(a1[2], a1[3]);
          const int s = DIR ? 127 - t : t, row = 16 * ((s & 31) >> 2) + 4 * (s >> 5) + (s & 3);
          *(LAS v4u*)(lds + LR_XC + row * LR_XCP + pc * 16) = o; } }
    __syncthreads();
    f32x4 ar[8], ai[8];
#pragma unroll
    for (int mt = 0; mt < 8; ++mt) { ar[mt] = (f32x4){0.f, 0.f, 0.f, 0.f}; ai[mt] = (f32x4){0.f, 0.f, 0.f, 0.f}; }
#pragma unroll
    for (int ks = 0; ks < 4; ++ks) {
#pragma unroll
        for (int mt = 0; mt < 8; ++mt) { const bf16x8 af = *(const LAS bf16x8*)(lds + LR_XC + (16 * mt + (lane & 15)) * LR_XCP + (32 * ks + 8 * q) * 2);
            ar[mt] = __builtin_amdgcn_mfma_f32_16x16x32_bf16(af, bA[ks], ar[mt], 0, 0, 0);
            ai[mt] = __builtin_amdgcn_mfma_f32_16x16x32_bf16(af, bI[ks], ai[mt], 0, 0, 0); } }
    if (pf) lru_load<1 - DIR>(xnx, z, pf_tb, pf_hh, pf_lo, pf_hi, tid);
    float Al = 1.f, Bl = 0.f;
    const LAS unsigned char* xcp = lds + LR_XC + (4 * q) * LR_XCP + chl * 2;
#pragma unroll
    for (int mt = 0; mt < 8; ++mt)
#pragma unroll
        for (int r = 0; r < 4; ++r) {
            const float er = __builtin_amdgcn_exp2f(__builtin_fmaf(ar[mt][r], -LOG2E, nba)), ei = __builtin_amdgcn_exp2f(__builtin_fmaf(ai[mt][r], -LOG2E, nbi));
            const float dr = 1.f + er, di = 1.f + ei, R = __builtin_amdgcn_rcpf(dr * di);
            const float av = __builtin_amdgcn_exp2f(c8 * (R * di));
            const float xcv = bf1(*(const LAS bf16*)(xcp + (16 * mt + r) * LR_XCP));
            const float uv = __builtin_amdgcn_sqrtf(fmaxf(__builtin_fmaf(-av, av, 1.f), 0.f)) * (R * dr) * xcv;
            ar[mt][r] = av; ai[mt][r] = uv; Bl = __builtin_fmaf(av, Bl, uv); Al *= av; }
    float A4 = Al, B4 = Bl;
    { const float Ap = __shfl_up(A4, 16), Bp = __shfl_up(B4, 16); if (q >= 1) { B4 = A4 * Bp + B4; A4 = A4 * Ap; } }
    { const float Ap = __shfl_up(A4, 32), Bp = __shfl_up(B4, 32); if (q >= 2) { B4 = A4 * Bp + B4; A4 = A4 * Ap; } }
    float Ae = __shfl_up(A4, 16), Be = __shfl_up(B4, 16); if (q == 0) { Ae = 1.f; Be = 0.f; }
    const float At = __shfl(A4, 48 + (lane & 15)), Bt = __shfl(B4, 48 + (lane & 15));
    if (q == 0) { float* ag = agg + (size_t)c * 2048 + (size_t)DIR * 1024 + 2 * chg; ag[0] = At; ag[1] = Bt; }
    { float hcur = Be, pcur = Ae;
      const int tq0 = DIR ? 127 - 32 * q : 32 * q, rot = (chl + 16 * (DIR ? 3 - q : q)) & 127;
      LAS float* yp = Y + tq0 * LR_YP + rot; LAS unsigned char* pp_ = lds + LR_PB + tq0 * LR_XCP + rot * 2;
#pragma unroll
      for (int mt = 0; mt < 8; ++mt)
#pragma unroll
          for (int r = 0; r < 4; ++r) { hcur = __builtin_fmaf(ar[mt][r], hcur, ai[mt][r]); pcur *= ar[mt][r];
              const int dt_ = DIR ? -(4 * mt + r) : (4 * mt + r);
              if (DIR == 0) yp[dt_ * LR_YP] = hcur; else yp[dt_ * LR_YP] += hcur;
              *(LAS bf16*)(pp_ + dt_ * LR_XCP) = (bf16)(pk2(pcur, 0.f) & 0xffffu); } }
    __syncthreads();
    { bf16* dst = PFB + (size_t)DIR * MTOK * 512;
      for (int p = tid; p < 128 * 16; p += NTHR) { const int t = p >> 4, pc = p & 15, pcr = (pc + 2 * (t >> 5)) & 15;
          *(v4u*)(dst + (size_t)(tb + t) * 512 + hh * 128 + pc * 8) = *(const LAS v4u*)(lds + LR_PB + t * LR_XCP + pcr * 16); } }
}

__device__ __forceinline__ void lru_heavy(LAS unsigned char* lds, int item, int next_item, v4u (&xa)[7], v4u (&xb)[7], const bf16* z, const LruLayer& LP, float* agg, bf16* LL, bf16* PFB  , int tid) {
    asm volatile("" : "+v"(tid));
    const int c = item >> 2, hh = item & 3;
    int s0, ns; seq_of_chunk(c, s0, ns);
    const int tb = c * 128, seq_lo = s0 * 128, seq_hi = (s0 + ns) * 128;
    int n_tb = 0, n_hh = 0, n_lo = 0, n_hi = 1;
    if (next_item >= 0) { const int nc = next_item >> 2; int t0_, t1_; seq_of_chunk(nc, t0_, t1_); n_tb = nc * 128; n_hh = next_item & 3; n_lo = t0_ * 128; n_hi = (t0_ + t1_) * 128; }
    lru_load<0>(xa, z, tb, hh, seq_lo, seq_hi, tid);
    lru_dir<0>(lds, z, LP, agg, PFB, c, hh, seq_lo, seq_hi, tid, xa, xb, true, tb, hh, seq_lo, seq_hi);
    lru_dir<1>(lds, z, LP, agg, PFB, c, hh, seq_lo, seq_hi, tid, xb, xa, false, n_tb, n_hh, n_lo, n_hi);
    const LAS float* Y = (const LAS float*)(lds + LR_Y);
    for (int p = tid; p < 128 * 16; p += NTHR) { const int t = p >> 4, pc = p & 15, pcr = (pc + 2 * (t >> 5)) & 15; const LAS float* yr = Y + t * LR_YP + pcr * 8;
        v4u ow; ow.x = pk2(yr[0], yr[1]); ow.y = pk2(yr[2], yr[3]); ow.z = pk2(yr[4], yr[5]); ow.w = pk2(yr[6], yr[7]);
        *(v4u*)(LL + (size_t)(tb + t) * 512 + hh * 128 + pc * 8) = ow; }
}

__device__ __forceinline__ void lru_light(LAS unsigned char* lds, int c, const bf16* z, bf16* mix, const float* agg, const bf16* LL, const bf16* PFB, int tid) {
    asm volatile("" : "+v"(tid));
    int s0, ns; seq_of_chunk(c, s0, ns);
    LAS float* car = (LAS float*)lds;
    {
      const float* ag0 = agg + 2 * tid; const float* ag1 = agg + 1024 + 2 * tid;
      float H0 = 0.f, H1 = 0.f; int cc = s0, cd = s0 + ns - 1;
      for (; cc + 16 <= c; cc += 16) { v2f v[16];
#pragma unroll
          for (int k = 0; k < 16; ++k) v[k] = *(const v2f*)(ag0 + (size_t)(cc + k) * 2048);
#pragma unroll
          for (int k = 0; k < 16; ++k) H0 = v[k][0] * H0 + v[k][1]; }
      for (; cc < c; ++cc) { const v2f v = *(const v2f*)(ag0 + (size_t)cc * 2048); H0 = v[0] * H0 + v[1]; }
      for (; cd - 16 >= c; cd -= 16) { v2f v[16];
#pragma unroll
          for (int k = 0; k < 16; ++k) v[k] = *(const v2f*)(ag1 + (size_t)(cd - k) * 2048);
#pragma unroll
          for (int k = 0; k < 16; ++k) H1 = v[k][0] * H1 + v[k][1]; }
      for (; cd > c; --cd) { const v2f v = *(const v2f*)(ag1 + (size_t)cd * 2048); H1 = v[0] * H1 + v[1]; }
      car[tid] = H0; car[512 + tid] = H1; }
    __syncthreads();
    const int tb = c * 128;
#pragma unroll 4
    for (int p = tid; p < 128 * 64; p += NTHR) { const int t = p >> 6, c8 = (p & 63) * 8; const size_t ro = (size_t)(tb + t) * 512 + c8;
        const v4u lv = *(const v4u*)(LL + ro), fv = *(const v4u*)(PFB + ro), bv = *(const v4u*)(PFB + (size_t)MTOK * 512 + ro);
        const v4u gv = *(const v4u*)(z + (size_t)(tb + t) * NZ + ZGL + c8);
        float o[8];
#pragma unroll
        for (int e = 0; e < 4; ++e) {
            o[2 * e] = (bflo(lv[e]) + bflo(fv[e]) * car[c8 + 2 * e] + bflo(bv[e]) * car[512 + c8 + 2 * e]) * silu(bflo(gv[e]));
            o[2 * e + 1] = (bfhi(lv[e]) + bfhi(fv[e]) * car[c8 + 2 * e + 1] + bfhi(bv[e]) * car[512 + c8 + 2 * e + 1]) * silu(bfhi(gv[e])); }
        v4u ow; ow.x = pk2(o[0], o[1]); ow.y = pk2(o[2], o[3]); ow.z = pk2(o[4], o[5]); ow.w = pk2(o[6], o[7]);
        *(v4u*)(mix + (size_t)(tb + t) * DMOD + 1536 + c8) = ow; }
    __syncthreads();
}

#define XB_TMO      128
#define XB_XCNT(j)  (256  + 64 * (j))
#define XB_XSUB(j)  (1280 + 64 * (j))
#define XB_XGEN(j)  (2304 + 64 * (j))
#define XB_TOP      3328
#define XB_TOPGEN   3392
#define XCD_BAR_WORDS 3456
#define XB_SPIN_CAP (1u << 18)

__device__ __forceinline__ unsigned xb_ld(unsigned* p)              { return __hip_atomic_load(p, __ATOMIC_RELAXED, __HIP_MEMORY_SCOPE_AGENT); }
__device__ __forceinline__ unsigned xb_add(unsigned* p, unsigned v) { return __hip_atomic_fetch_add(p, v, __ATOMIC_RELAXED, __HIP_MEMORY_SCOPE_AGENT); }
__device__ __forceinline__ unsigned xb_xcc_id() { return (unsigned)__builtin_amdgcn_s_getreg((3 << 11) | 20) & 0xFu; }
#define XB_SPIN(cond, bar) do { unsigned _sp = 0; while (cond) { __builtin_amdgcn_s_sleep(1); \
    if ((++_sp & 255u) == 0u) { if (xb_ld(&(bar)[XB_TMO])) break; if (_sp > XB_SPIN_CAP) { atomicAdd(&(bar)[XB_TMO], 1u); break; } } } } while (0)

struct XcdBarrier {
    unsigned* bar; unsigned x;
    volatile LAS unsigned* st;
};

__device__ __forceinline__ XcdBarrier xcd_barrier_post(unsigned* bar, volatile LAS unsigned* st) {
    XcdBarrier b; b.bar = bar; b.x = xb_xcc_id(); b.st = st;
    if (threadIdx.x == 0) (void)xb_add(&bar[XB_XCNT(b.x)], 1u);
    return b;
}
__device__ __forceinline__ void xcd_barrier_complete(unsigned* bar, unsigned x, unsigned& nloc, unsigned& nx) {
    const unsigned G = gridDim.x * gridDim.y * gridDim.z;
    unsigned sum, cnt, mine, sp = 0u;
    for (;;) {
        sum = 0u; cnt = 0u; mine = 0u;
#pragma unroll
        for (unsigned j = 0; j < 16; ++j) { const unsigned c = xb_ld(&bar[XB_XCNT(j)]); sum += c; cnt += (c > 0u) ? 1u : 0u; mine = (j == x) ? c : mine; }
        if (sum == G) break;
        __builtin_amdgcn_s_sleep(1);
        if ((++sp & 255u) == 0u) { if (xb_ld(&bar[XB_TMO])) break; if (sp > XB_SPIN_CAP) { atomicAdd(&bar[XB_TMO], 1u); break; } }
    }
    nloc = mine > 0u ? mine : 1u; nx = cnt > 0u ? cnt : 1u;
}

__device__ __forceinline__ void xcd_barrier(const XcdBarrier& b) {
    asm volatile("s_waitcnt vmcnt(0)" ::: "memory");
    __syncthreads();
    if (threadIdx.x == 0) {
        unsigned* bar = b.bar;
        __builtin_amdgcn_s_waitcnt(0);
        unsigned nloc = b.st[0], nx = b.st[1];
        if (nloc == 0u) { xcd_barrier_complete(bar, b.x, nloc, nx); b.st[0] = nloc; b.st[1] = nx; }
        const unsigned old = xb_add(&bar[XB_XSUB(b.x)], 1u);
        const unsigned gen = old / nloc;
        if (old + 1u == (gen + 1u) * nloc) {
            __builtin_amdgcn_fence(__ATOMIC_RELEASE, "agent");
            asm volatile("s_waitcnt vmcnt(0)" ::: "memory");
            const unsigned og = xb_add(&bar[XB_TOP], 1u);
            const unsigned tg = og / nx;
            if (og + 1u == (tg + 1u) * nx) xb_add(&bar[XB_TOPGEN], 1u);
            else XB_SPIN(xb_ld(&bar[XB_TOPGEN]) == tg, bar);
            __builtin_amdgcn_fence(__ATOMIC_ACQUIRE, "agent");
            xb_add(&bar[XB_XGEN(b.x)], 1u);
            asm volatile("s_waitcnt vmcnt(0)" ::: "memory");
        } else {
            XB_SPIN(xb_ld(&bar[XB_XGEN(b.x)]) == gen, bar);
            __builtin_amdgcn_fence(__ATOMIC_ACQUIRE, "agent");
            asm volatile("s_waitcnt vmcnt(0)" ::: "memory");
        }
    }
    __syncthreads();
}

constexpr int RS_OFF = 131072;
__device__ __forceinline__ void rstd_stage(LAS unsigned char* lds, const pg8::StaticOrder& S, const float* ssq, int tid) {
    asm volatile("" : "+v"(tid));
    int last = -1;
    for (int i = 0; ; ++i) { pg8::Unit u; if (!S.next(i, u)) break;
        if (u.pm != last) { last = u.pm; if (tid < 256) ((LAS float*)(lds + RS_OFF))[((u.pm >> 3) & 3) * 256 + tid] = rsqrtf(ssq[u.pm * 256 + tid] * (1.f / DMOD) + 1e-6f); } }
    __syncthreads();
}

#ifndef PH_LO
#define PH_LO 0
#endif
__global__ void __launch_bounds__(NTHR, 2) fwd_megakernel(Params P) {
    extern __shared__ __attribute__((aligned(16))) unsigned char lds_raw[];
    LAS unsigned char* lds = (LAS unsigned char*)lds_raw;
    cg::grid_group grid = cg::this_grid();
    const int tid = threadIdx.x, G = gridDim.x;
    unsigned char* ws = P.ws;
    volatile LAS unsigned* MISC = (volatile LAS unsigned*)(lds + LDS_BYTES - 64);
    if (tid < 16) MISC[tid] = 0u;
    __syncthreads();
    (void)xcd_barrier_post((unsigned*)(ws + WS_CTL), MISC);
#define GRID_BAR() do { unsigned char* w_ = P.ws; asm volatile("" : "+s"(w_)); XcdBarrier b_; b_.bar = (unsigned*)(w_ + WS_CTL); b_.x = xb_xcc_id(); \
        b_.st = (volatile LAS unsigned*)(lds + LDS_BYTES - 64); xcd_barrier(b_); } while (0)
    float* ssq = (float*)(ws + WS_SSQ); float* agg = (float*)(ws + WS_AGG);
    bf16* hbA = (bf16*)(ws + WS_HBA); bf16* hbB = (bf16*)(ws + WS_HBB); bf16* mix = (bf16*)(ws + WS_MIX); bf16* pp = (bf16*)(ws + WS_PP); bf16* z = (bf16*)(ws + WS_Z);

#ifndef NO_P0
    p0_prologue(P, lds, tid, G);
#ifdef DUP_P0
    __syncthreads(); p0_prologue(P, lds, tid, G);
#endif
#endif
    if (P.ws == nullptr) grid.sync();
    GRID_BAR();
#ifdef DUP_SYNC
#pragma unroll 1
    for (int r = 0; r < 10; ++r) GRID_BAR();
#endif
#pragma unroll 1
    for (int l = 0; l < 2; ++l) {
        { pg8::Gemm g{hbA, (const bf16*)(ws + WS_WIN) + (size_t)l * NZ * DMOD, MTOK, NZ, DMOD}; pg8::StaticOrder S; S.init(MTOK, NZ, G, (int)blockIdx.x);
          rstd_stage(lds, S, ssq + (size_t)(2 * l) * MTOK, tid);
          pg8::EpiZ E{z, NZ, (const LAS float*)(lds + RS_OFF)};
#ifdef STAG_A
          { const unsigned long long t0 = __builtin_amdgcn_s_memrealtime(); const unsigned long long wt = (unsigned long long)((blockIdx.x >> 3) & 3) * STAG_A;
            while (__builtin_amdgcn_s_memrealtime() - t0 < wt) __builtin_amdgcn_s_sleep(32); }
#endif
          pg8::gemm_phase<pg8::EpiZ, pg8::StaticOrder, true, true>(lds, g, S, E);
#ifdef DUP_A
          pg8::gemm_phase<pg8::EpiZ, pg8::StaticOrder, true, true>(lds, g, S, E);
#endif
 }
        GRID_BAR();
#ifdef DUP_MIX
        for (int rep = 0; rep < 2; ++rep) {
#endif
        LruLayer LP{P.lru_conv_w + (size_t)l * 2 * 4 * 512, P.lru_conv_b + l * 1024, P.lru_b_a + l * 1024, P.lru_b_i + l * 1024, P.lru_L + l * 1024, (const bf16*)(ws + WS_WL) + (size_t)l * 16 * 16384};
        bf16* LL = hbB; bf16* PFB = hbB + (size_t)MTOK * 512;
#pragma unroll 1
        for (int step = 0; step < 2; ++step) {
            if ((step ^ ((blockIdx.x >> 3) & 1)) == 0) {
                { v4u xa[7], xb[7];
                  for (int it = blockIdx.x; it < NCHUNK * 4; it += G) lru_heavy(lds, it, (it + G < NCHUNK * 4) ? it + G : -1, xa, xb, z, LP, agg, LL, PFB, tid); }
                __syncthreads();
            } else {
                conv_phase(z, mix, P.conv_w + (size_t)l * 3 * 512, G, tid);
                if (l == 0) { pb_convert(P, tid, G); tr_run(P, lds, tid, G, 1, TI_LATE); }
                __syncthreads();
            }
        }
        GRID_BAR();
        attn_build_tab(lds, P.rel_bias, tid);
        __syncthreads();
#pragma unroll 1
        for (int step = 0; step < 2; ++step) {
        if ((step ^ ((blockIdx.x >> 3) & 1)) == 0) {
#ifndef NO_ATTN
        if (G == 256) {
            const int xc = (blockIdx.x & 7) * 32 + (blockIdx.x >> 3);
#pragma unroll 1
            for (int r = 0; r < 4; ++r) attn_item<0>(lds, xc * 4 + r, z, mix, P.attn_sink + l * 8, tid);
        } else
        for (int it = blockIdx.x; it < NCHUNK * 4; it += G) attn_item<0>(lds, it, z, mix, P.attn_sink + l * 8, tid);
#ifdef DUP_ATTN
        { const int xc = (blockIdx.x & 7) * 32 + (blockIdx.x >> 3);
#pragma unroll 1
          for (int r = 0; r < 4; ++r) attn_item<DUP_ATTN - 1>(lds, xc * 4 + r, z, (bf16*)P.out, P.attn_sink + l * 8, tid); }
#endif
#endif
        } else {
        for (int it = blockIdx.x; it < NCHUNK; it += G) lru_light(lds, it, z, mix, agg, LL, PFB, tid);
#ifdef DUP_LIGHT
        for (int it = blockIdx.x; it < NCHUNK; it += G) lru_light(lds, it, z, mix, agg, LL, PFB, tid);
#endif
        __syncthreads();
        } }
        GRID_BAR();
#ifdef DUP_MIX
        }
#endif
#pragma unroll 1
        for (int step = 0; step < 2; ++step) {
            if ((step ^ ((blockIdx.x >> 3) & 1)) == 0) {
                pg8::Gemm g{mix, (const bf16*)(ws + WS_WOUT) + (size_t)l * DMOD * DMOD, MTOK, DMOD, DMOD}; pg8::StaticOrder S; S.init(MTOK, DMOD, G, (int)blockIdx.x);
#ifdef TIME_EPI
                unsigned tacc_ = 0u;
                pg8::EpiRes E{hbA, hbB, ssq + (size_t)(2 * l + 1) * MTOK, &tacc_};
                pg8::gemm_phase<pg8::EpiRes, pg8::StaticOrder, true, true>(lds, g, S, E);
                { const unsigned long long t0 = __builtin_amdgcn_s_memrealtime(); const unsigned long long wt = 8ull * tacc_; while (__builtin_amdgcn_s_memrealtime() - t0 < wt) __builtin_amdgcn_s_sleep(32); }
#else
                pg8::EpiRes E{hbA, hbB, ssq + (size_t)(2 * l + 1) * MTOK};
                pg8::gemm_phase<pg8::EpiRes, pg8::StaticOrder, true, true>(lds, g, S, E);
#endif
            } else {
                pg8::Gemm g{(const bf16*)(ws + WS_PB) + (size_t)l * MTOK * PLE, (const bf16*)(ws + WS_WPROJ) + (size_t)l * DMOD * PLE, MTOK, DMOD, PLE}; pg8::StaticOrder S; S.init(MTOK, DMOD, G, (int)blockIdx.x);
                pg8::EpiZ E{pp, 0, nullptr};
                pg8::gemm_phase<pg8::EpiZ, pg8::StaticOrder, true, true>(lds, g, S, E);
            }
        }
        GRID_BAR();
        { pg8::Gemm g{hbB, (const bf16*)(ws + WS_WGATE) + (size_t)l * DMOD * DMOD, MTOK, DMOD, DMOD}; pg8::StaticOrder S; S.init(MTOK, DMOD, G, (int)blockIdx.x);
          rstd_stage(lds, S, ssq + (size_t)(2 * l + 1) * MTOK, tid);
          pg8::EpiGate E{(const LAS float*)(lds + RS_OFF), hbB, pp, hbA, ssq + (size_t)(2 * l + 2) * MTOK};
#ifndef NO_GD
          pg8::gemm_phase<pg8::EpiGate, pg8::StaticOrder, true, true>(lds, g, S, E);
#endif
 }
        GRID_BAR();
    }
    { const int lane = tid & 63, gw = blockIdx.x * NWAVES + (tid >> 6), NGW = G * NWAVES; const float* sf = ssq + (size_t)4 * MTOK;
      for (int row = gw; row < MTOK; row += NGW) { const float rs = rsqrtf(sf[row] * (1.f / DMOD) + 1e-6f); float* orow = P.out + (size_t)row * DMOD; const bf16* hrow = hbA + (size_t)row * DMOD;
#pragma unroll
          for (int j = 0; j < 4; ++j) { const int cidx = 8 * lane + 512 * j; const v4u hv = *(const v4u*)(hrow + cidx); const f32x4 g0 = *(const f32x4*)(P.final_norm + cidx), g1 = *(const f32x4*)(P.final_norm + cidx + 4);
              f32x4 v0, v1; v0[0] = bflo(hv.x) * rs * g0[0]; v0[1] = bfhi(hv.x) * rs * g0[1]; v0[2] = bflo(hv.y) * rs * g0[2]; v0[3] = bfhi(hv.y) * rs * g0[3];
              v1[0] = bflo(hv.z) * rs * g1[0]; v1[1] = bfhi(hv.z) * rs * g1[1]; v1[2] = bflo(hv.w) * rs * g1[2]; v1[3] = bfhi(hv.w) * rs * g1[3];
              *(f32x4*)(orow + cidx) = v0; *(f32x4*)(orow + cidx + 4) = v1; } } }
}

extern "C" void kernel_launch(void* const* d_in, const int* in_sizes, int n_in, void* d_out, int out_size, void* d_ws, size_t ws_size, hipStream_t stream) {
    static int grid_blocks = 0;
    if (!grid_blocks) {
        if (n_in != 21 || ws_size < WS_END) { fprintf(stderr, "kernel_launch: unexpected n_in %d / ws_size %zu\n", n_in, ws_size); grid_blocks = -1; return; }
        int dev = 0, cus = 0, per_cu = 0;
        (void)hipGetDevice(&dev);
        (void)hipDeviceGetAttribute(&cus, hipDeviceAttributeMultiprocessorCount, dev);
        (void)hipFuncSetAttribute((const void*)fwd_megakernel, hipFuncAttributeMaxDynamicSharedMemorySize, LDS_BYTES);
        (void)hipOccupancyMaxActiveBlocksPerMultiprocessor(&per_cu, (const void*)fwd_megakernel, NTHR, LDS_BYTES);
        if (per_cu < 1) { fprintf(stderr, "kernel_launch: occupancy query says %d blocks/CU\n", per_cu); per_cu = 1; }
        grid_blocks = cus;
    }
    if (grid_blocks < 0) return;
    (void)hipMemsetAsync((unsigned char*)d_ws + WS_CTL, 0, CTL_BYTES, stream);
    Params p{};
    const float** pf = (const float**)&p;
    for (int i = 0; i < 21; ++i) pf[i] = (const float*)d_in[i];
    p.out = (float*)d_out; p.ws = (unsigned char*)d_ws;
    void* args[] = {&p};
    hipError_t e = hipLaunchCooperativeKernel((void*)fwd_megakernel, dim3(grid_blocks), dim3(NTHR), args, LDS_BYTES, stream);
    if (e != hipSuccess) fprintf(stderr, "cooperative launch failed: %s (grid %d)\n", hipGetErrorString(e), grid_blocks);
}
```
